# Optimizing an MI355X kernel written in HIP

```python
import math
import jax, jax.numpy as jnp
from jax import lax
import numpy as np

D_MODEL = 2048
BATCH = 4
SEQ = 2048
DEPTH = 1
DEC_BATCH = 128
DEC_SEQ = 4
PAST_LEN = 16384
PAGE_SIZE = 128

SSD_WIDTH = D_MODEL
SSD_HEAD_DIM = 64
SSD_HEADS = SSD_WIDTH // SSD_HEAD_DIM
SSD_GROUPS = 4
SSD_STATE = 128
SSD_CONV = 4
SSD_CHUNK = 128
SSD_CONV_DIM = SSD_WIDTH + 2 * SSD_GROUPS * SSD_STATE
CF_WIDTH = D_MODEL
CF_CONV = 31
D_MIX = SSD_WIDTH + CF_WIDTH
IN_PROJ_DIM = SSD_WIDTH + SSD_CONV_DIM + SSD_HEADS + 2 * CF_WIDTH
FFN_DIM = ((8 * D_MODEL // 3 + 127) // 128) * 128
FFN_CONV = 3
EPS = 1e-5

kernel_name = "hymba_ssd_conformer_convffn_step"


def rmsnorm(x, w):
    xf = x.astype(jnp.float32)
    r = lax.rsqrt(jnp.mean(xf * xf, axis=-1, keepdims=True) + EPS)
    return (xf * r).astype(x.dtype) * w


def layernorm(x, w, b):
    xf = x.astype(jnp.float32)
    mu = jnp.mean(xf, axis=-1, keepdims=True)
    var = jnp.mean(jnp.square(xf - mu), axis=-1, keepdims=True)
    return ((xf - mu) * lax.rsqrt(var + EPS)).astype(x.dtype) * w + b


def causal_dwconv(x, buf, w, b):
    k = w.shape[0]
    l = x.shape[1]
    xp = jnp.concatenate([buf.astype(x.dtype), x], axis=1)
    y = xp[:, 0:l] * w[0]
    for i in range(1, k):
        y = y + xp[:, i:i + l] * w[i]
    return y + b, xp[:, l:]


def ssd_scan(x, dt, A, B, C, h0):
    b, l = x.shape[0], x.shape[1]
    q = SSD_CHUNK if l % SSD_CHUNK == 0 else l
    c = l // q
    G, R, P, N = SSD_GROUPS, SSD_HEADS // SSD_GROUPS, SSD_HEAD_DIM, SSD_STATE
    xdt = (x * dt[..., None].astype(x.dtype)).reshape(b, c, q, G, R, P)
    dA = (dt.astype(jnp.float32) * A.astype(jnp.float32)).reshape(b, c, q, G, R)
    cs = jnp.cumsum(dA, axis=2)
    Bc = B.reshape(b, c, q, G, N)
    Cc = C.reshape(b, c, q, G, N)
    mask = jnp.tril(jnp.ones((q, q), dtype=bool))[:, :, None, None]
    seg = cs[:, :, :, None] - cs[:, :, None]
    Lmat = jnp.exp(jnp.where(mask, seg, -jnp.inf))
    CB = jnp.einsum('bcign,bcjgn->bcijg', Cc, Bc)
    M = CB[..., None] * Lmat
    y_diag = jnp.einsum('bcijgr,bcjgrp->bcigrp', M, xdt)
    decay = jnp.exp(cs[:, :, -1:] - cs)
    chunk_states = jnp.einsum('bcjgn,bcjgrp->bcgrpn', Bc,
                              xdt * decay[..., None]).astype(jnp.float32)
    chunk_decay = jnp.exp(cs[:, :, -1])

    def step(h, inp):
        dec, st = inp
        return h * dec[..., None, None] + st, h

    h_init = h0.reshape(b, G, R, P, N).astype(jnp.float32)
    h_final, h_prev = lax.scan(step, h_init,
                               (jnp.swapaxes(chunk_decay, 0, 1), jnp.swapaxes(chunk_states, 0, 1)))
    h_prev = jnp.swapaxes(h_prev, 0, 1)
    y_off = jnp.einsum('bcign,bcgrpn->bcigrp', Cc, h_prev) * jnp.exp(cs)[..., None]
    y = (y_diag + y_off).reshape(b, l, SSD_HEADS, P)
    return y.astype(x.dtype), h_final.reshape(b, SSD_HEADS, P, N).astype(h0.dtype)


def mixer(h, ssm0, ssd_buf0, cf_buf0, w_in, ssd_conv_w, ssd_conv_b, dt_bias, a_log, d_skip,
          ssd_norm_w, cf_conv_w, cf_conv_b, cf_ln_w, cf_ln_b, w_out):
    b, l = h.shape[0], h.shape[1]
    proj = h @ w_in
    s1 = SSD_WIDTH
    s2 = s1 + SSD_CONV_DIM
    s3 = s2 + SSD_HEADS
    s4 = s3 + CF_WIDTH
    z, xbc, dt, cf_a, cf_g = jnp.split(proj, [s1, s2, s3, s4], axis=-1)
    xbc, ssd_buf = causal_dwconv(xbc, ssd_buf0, ssd_conv_w, ssd_conv_b)
    xbc = jax.nn.silu(xbc)
    xs, Bm, Cm = jnp.split(xbc, [SSD_WIDTH, SSD_WIDTH + SSD_GROUPS * SSD_STATE], axis=-1)
    dt = jax.nn.softplus((dt + dt_bias).astype(jnp.float32))
    A = -jnp.exp(a_log.astype(jnp.float32))
    xh = xs.reshape(b, l, SSD_HEADS, SSD_HEAD_DIM)
    y, ssm = ssd_scan(xh, dt, A, Bm.reshape(b, l, SSD_GROUPS, SSD_STATE),
                      Cm.reshape(b, l, SSD_GROUPS, SSD_STATE), ssm0)
    y = y + d_skip[:, None] * xh
    y = rmsnorm(y.reshape(b, l, SSD_WIDTH) * jax.nn.silu(z), ssd_norm_w)
    u = cf_a * jax.nn.sigmoid(cf_g)
    u, cf_buf = causal_dwconv(u, cf_buf0, cf_conv_w, cf_conv_b)
    u = jax.nn.silu(layernorm(u, cf_ln_w, cf_ln_b))
    out = jnp.concatenate([y.astype(h.dtype), u], axis=-1) @ w_out
    return out, ssm, ssd_buf, cf_buf


def conv_ffn(h, buf0, w_up, conv_w, conv_b, w_down):
    u = h @ w_up
    u, buf = causal_dwconv(u, buf0, conv_w, conv_b)
    g, v = jnp.split(u, [FFN_DIM], axis=-1)
    return (jax.nn.silu(g) * v) @ w_down, buf


def setup_inputs(seed: int = 0) -> dict:
    key = jax.random.key(seed)
    ks = jax.random.split(key, 28)
    f32 = jnp.float32
    nrm = lambda k, shape, s: jax.random.normal(k, shape, f32) * s
    H = SSD_HEADS
    dt0 = jnp.exp(jax.random.uniform(ks[0], (DEPTH, H), f32, math.log(1e-3), math.log(1e-1)))
    return {
        "x_prompt": nrm(ks[1], (BATCH, SEQ, D_MODEL), 1.0),
        "x_sample": nrm(ks[2], (DEC_BATCH, DEC_SEQ, D_MODEL), 1.0),
        "state_ssm": nrm(ks[3], (DEPTH, DEC_BATCH, H, SSD_HEAD_DIM, SSD_STATE), 0.1),
        "state_ssd_conv": nrm(ks[4], (DEPTH, DEC_BATCH, SSD_CONV - 1, SSD_CONV_DIM), 1.0),
        "state_cf_conv": nrm(ks[5], (DEPTH, DEC_BATCH, CF_CONV - 1, CF_WIDTH), 0.5),
        "state_ffn_conv": nrm(ks[6], (DEPTH, DEC_BATCH, FFN_CONV - 1, 2 * FFN_DIM), 1.0),
        "norm_mix_w": 1.0 + nrm(ks[7], (DEPTH, D_MODEL), 0.02),
        "w_in": nrm(ks[8], (DEPTH, D_MODEL, IN_PROJ_DIM), D_MODEL ** -0.5),
        "ssd_conv_w": nrm(ks[9], (DEPTH, SSD_CONV, SSD_CONV_DIM), SSD_CONV ** -0.5),
        "ssd_conv_b": nrm(ks[10], (DEPTH, SSD_CONV_DIM), 0.02),
        "ssd_dt_bias": dt0 + jnp.log(-jnp.expm1(-dt0)),
        "ssd_a_log": jnp.log(jax.random.uniform(ks[11], (DEPTH, H), f32, 1.0, 16.0)),
        "ssd_d": 1.0 + nrm(ks[12], (DEPTH, H), 0.1),
        "ssd_norm_w": 1.0 + nrm(ks[13], (DEPTH, SSD_WIDTH), 0.02),
        "cf_conv_w": nrm(ks[14], (DEPTH, CF_CONV, CF_WIDTH), CF_CONV ** -0.5),
        "cf_conv_b": nrm(ks[15], (DEPTH, CF_WIDTH), 0.02),
        "cf_ln_w": 1.0 + nrm(ks[16], (DEPTH, CF_WIDTH), 0.02),
        "cf_ln_b": nrm(ks[17], (DEPTH, CF_WIDTH), 0.02),
        "w_out": nrm(ks[18], (DEPTH, D_MIX, D_MODEL), D_MIX ** -0.5),
        "norm_ffn_w": 1.0 + nrm(ks[19], (DEPTH, D_MODEL), 0.02),
        "w_up": nrm(ks[20], (DEPTH, D_MODEL, 2 * FFN_DIM), D_MODEL ** -0.5),
        "ffn_conv_w": nrm(ks[21], (DEPTH, FFN_CONV, 2 * FFN_DIM), FFN_CONV ** -0.5),
        "ffn_conv_b": nrm(ks[22], (DEPTH, 2 * FFN_DIM), 0.02),
        "w_down": nrm(ks[23], (DEPTH, FFN_DIM, D_MODEL), FFN_DIM ** -0.5),
        "norm_final_w": 1.0 + nrm(ks[24], (D_MODEL,), 0.02),
    }


def reference(x_prompt, x_sample, state_ssm, state_ssd_conv, state_cf_conv, state_ffn_conv,
              norm_mix_w, w_in, ssd_conv_w, ssd_conv_b, ssd_dt_bias, ssd_a_log, ssd_d, ssd_norm_w,
              cf_conv_w, cf_conv_b, cf_ln_w, cf_ln_b, w_out, norm_ffn_w, w_up, ffn_conv_w,
              ffn_conv_b, w_down, norm_final_w):
    bp = x_prompt.shape[0]
    dtp = x_prompt.dtype
    xp, xs = x_prompt, x_sample
    p_ssm_l, p_ssdc_l, p_cfc_l, p_ffc_l = [], [], [], []
    s_ssm_l, s_ssdc_l, s_cfc_l, s_ffc_l = [], [], [], []
    for i in range(DEPTH):
        mix_w = (w_in[i], ssd_conv_w[i], ssd_conv_b[i], ssd_dt_bias[i], ssd_a_log[i], ssd_d[i],
                 ssd_norm_w[i], cf_conv_w[i], cf_conv_b[i], cf_ln_w[i], cf_ln_b[i], w_out[i])
        ffn_w = (w_up[i], ffn_conv_w[i], ffn_conv_b[i], w_down[i])
        p_ssm0 = jnp.zeros((bp, SSD_HEADS, SSD_HEAD_DIM, SSD_STATE), dtp)
        p_ssdc0 = jnp.zeros((bp, SSD_CONV - 1, SSD_CONV_DIM), dtp)
        p_cfc0 = jnp.zeros((bp, CF_CONV - 1, CF_WIDTH), dtp)
        p_ffc0 = jnp.zeros((bp, FFN_CONV - 1, 2 * FFN_DIM), dtp)
        m, p_ssm, p_ssdc, p_cfc = mixer(rmsnorm(xp, norm_mix_w[i]), p_ssm0, p_ssdc0, p_cfc0, *mix_w)
        xp = xp + m
        f, p_ffc = conv_ffn(rmsnorm(xp, norm_ffn_w[i]), p_ffc0, *ffn_w)
        xp = xp + f
        m, s_ssm, s_ssdc, s_cfc = mixer(rmsnorm(xs, norm_mix_w[i]), state_ssm[i], state_ssd_conv[i],
                                        state_cf_conv[i], *mix_w)
        xs = xs + m
        f, s_ffc = conv_ffn(rmsnorm(xs, norm_ffn_w[i]), state_ffn_conv[i], *ffn_w)
        xs = xs + f
        p_ssm_l.append(p_ssm); p_ssdc_l.append(p_ssdc); p_cfc_l.append(p_cfc); p_ffc_l.append(p_ffc)
        s_ssm_l.append(s_ssm); s_ssdc_l.append(s_ssdc); s_cfc_l.append(s_cfc); s_ffc_l.append(s_ffc)
    y_prompt = rmsnorm(xp, norm_final_w)
    y_sample = rmsnorm(xs, norm_final_w)
    p_ssm = jnp.stack(p_ssm_l)
    p_ssd_conv = jnp.stack(p_ssdc_l)
    p_cf_conv = jnp.stack(p_cfc_l)
    p_ffn_conv = jnp.stack(p_ffc_l)
    s_ssm = jnp.stack(s_ssm_l)
    s_ssd_conv = jnp.stack(s_ssdc_l)
    s_cf_conv = jnp.stack(s_cfc_l)
    s_ffn_conv = jnp.stack(s_ffc_l)
    return (y_prompt, y_sample, p_ssm, p_ssd_conv, p_cf_conv, p_ffn_conv,
            s_ssm, s_ssd_conv, s_cf_conv, s_ffn_conv)
```

```cpp
#include <hip/hip_runtime.h>
#include <hip/hip_cooperative_groups.h>
#include <cstdio>
#include <cstdint>
namespace cg = cooperative_groups;

#ifndef MK_N_LAUNCHES
#define MK_N_LAUNCHES 1
#endif

#define LAS __attribute__((address_space(3)))
typedef unsigned short bf16_t;
typedef short bf16x8 __attribute__((ext_vector_type(8)));
typedef float f32x4 __attribute__((ext_vector_type(4)));
typedef float f32x2 __attribute__((ext_vector_type(2)));
typedef unsigned u32x4 __attribute__((ext_vector_type(4)));
typedef unsigned u32x2 __attribute__((ext_vector_type(2)));

constexpr int DM = 2048;
constexpr int MP = 8192, MS = 512, MT = MP + MS;
constexpr int SEQ = 2048, NB = 4, DB = 128, DSEQ = 4;
constexpr int NH = 32, HP = 64, NS = 128, NG = 4;
constexpr int XBCW = 3072;
constexpr int NPROJ = 9472;
constexpr int CZ = 0, CXBC = 2048, CCF = 5120, CDT = 9216;
constexpr int CUCF = 5120;
constexpr int DMIX = 4096, FF = 5504, FF2 = 11008;
constexpr float EPS = 1e-5f;

constexpr size_t O_Y = 0;
constexpr size_t O_PSSM = (size_t)MT * DM;
constexpr size_t O_PSSDC = O_PSSM + (size_t)NB * NH * HP * NS;
constexpr size_t O_PCFC = O_PSSDC + (size_t)NB * 3 * XBCW;
constexpr size_t O_PFFC = O_PCFC + (size_t)NB * 30 * DM;
constexpr size_t O_SSSM = O_PFFC + (size_t)NB * 2 * FF2;
constexpr size_t O_SSSDC = O_SSSM + (size_t)DB * NH * HP * NS;
constexpr size_t O_SCFC = O_SSSDC + (size_t)DB * 3 * XBCW;
constexpr size_t O_SFFC = O_SCFC + (size_t)DB * 30 * DM;
constexpr size_t O_END = O_SFFC + (size_t)DB * 2 * FF2;

constexpr size_t al256(size_t x) { return (x + 255) & ~(size_t)255; }
constexpr size_t WS_WIN = 0;
constexpr size_t WS_WOUT = WS_WIN + al256((size_t)NPROJ * DM * 2);
constexpr size_t WS_WUP = WS_WOUT + al256((size_t)DM * DMIX * 2);
constexpr size_t WS_WDN = WS_WUP + al256((size_t)FF2 * DM * 2);
constexpr size_t WS_XN = WS_WDN + al256((size_t)DM * FF * 2);
constexpr size_t WS_DT = WS_XN + al256((size_t)MT * DM * 2);
constexpr size_t WS_RA = WS_DT + al256((size_t)MT * NH * 4);
constexpr size_t WS_PROJ = WS_RA;
constexpr size_t WS_XBC = WS_PROJ + al256((size_t)MT * NPROJ * 2);
constexpr size_t WS_U = WS_RA;
constexpr size_t WS_RB = WS_XBC + al256((size_t)MT * XBCW * 2);
constexpr size_t WS_CONV = WS_RB;
constexpr size_t WS_MIX = WS_CONV + al256((size_t)MT * DM * 4);
constexpr size_t WS_ACT = WS_RB;
constexpr size_t WS_CTL = WS_MIX + al256((size_t)MT * DMIX * 2);
constexpr size_t CTL_BYTES = 131072;
constexpr size_t CTL_SSQ1 = 65536;
constexpr size_t WS_END = WS_CTL + CTL_BYTES;
static_assert((size_t)MT * FF2 * 2 <= WS_RB - WS_RA, "U overlay");
static_assert((size_t)MT * FF * 2 <= WS_END - WS_RB, "ACT overlay");

constexpr size_t WS_XT1 = WS_XN;
constexpr size_t OS_XT2 = 0, OS_BT = OS_XT2 + (size_t)MP * DM * 2, OS_CS = OS_BT + (size_t)64 * 512 * 128 * 2;
static_assert((size_t)MP * DM * 2 <= (size_t)MT * DM * 2 && OS_CS + (size_t)MP * NH * 4 <= (size_t)MT * DM * 4, "ssd scratch maps");
constexpr int LDS_BYTES = 147456;

__device__ __forceinline__ int ltid() { int t = threadIdx.x; asm volatile("" : "+v"(t)); return t; }
__device__ __forceinline__ float bf2f(unsigned h) { return __uint_as_float(h << 16); }
__device__ __forceinline__ unsigned f2bf(float f) { unsigned u = __float_as_uint(f); return (u + 0x7fffu + ((u >> 16) & 1u)) >> 16; }
__device__ __forceinline__ unsigned pk2(float lo, float hi) { unsigned r; asm("v_cvt_pk_bf16_f32 %0, %1, %2" : "=v"(r) : "v"(lo), "v"(hi)); return r; }
__device__ __forceinline__ float sigmoidf_(float x) { return __builtin_amdgcn_rcpf(1.f + __expf(-x)); }
__device__ __forceinline__ float siluf_(float x) { return x * __builtin_amdgcn_rcpf(1.f + __expf(-x)); }
#define LDS_BARRIER() do { asm volatile("s_waitcnt lgkmcnt(0)" ::: "memory"); __builtin_amdgcn_s_barrier(); asm volatile("" ::: "memory"); } while (0)
__device__ __forceinline__ float wave_sum(float v) {
#pragma unroll
    for (int o = 1; o < 64; o <<= 1) v += __shfl_xor(v, o);
    return v;
}
__device__ __forceinline__ void unpack8(const u32x4 v, float (&o)[8]) {
    o[0] = bf2f(v.x & 0xffffu); o[1] = bf2f(v.x >> 16); o[2] = bf2f(v.y & 0xffffu); o[3] = bf2f(v.y >> 16);
    o[4] = bf2f(v.z & 0xffffu); o[5] = bf2f(v.z >> 16); o[6] = bf2f(v.w & 0xffffu); o[7] = bf2f(v.w >> 16);
}
__device__ __forceinline__ u32x4 pack8(const float (&o)[8]) {
    u32x4 v; v.x = pk2(o[0], o[1]); v.y = pk2(o[2], o[3]); v.z = pk2(o[4], o[5]); v.w = pk2(o[6], o[7]); return v;
}

namespace pg8 {
#define PG8_LAS __attribute__((address_space(3)))
constexpr int BM = 256, BK = 64, HALF = 128, HTB = HALF * BK * 2, STAGE_BYTES = 8 * HTB, NXCD = 8, WGM = 8;
__host__ __device__ __forceinline__ int lds_byte(int r, int c) { const int st = (r >> 4) * 2 + (c >> 5), rr = r & 15, cc = c & 31, ob = rr * 64 + cc * 2; return st * 1024 + (ob ^ (((ob >> 9) & 1) << 5)); }
__host__ __device__ __forceinline__ void stage_rc(int b, int& R, int& C) { const int st = b / 1024, sb = b % 1024, swz = sb ^ (((sb >> 9) & 1) << 5); R = (st >> 1) * 16 + swz / 64; C = (st & 1) * 32 + (swz % 64) / 2; }
__host__ __device__ __forceinline__ int perm32(int rho) { const int n = rho >> 4, i = rho & 15; return 8 * (i >> 2) + 4 * n + (i & 3); }

struct Unit { int pm, pn, kt0, nkt, split; };
struct Gemm { const bf16_t* A; const bf16_t* Bt; int M, N, K; };
__host__ __device__ __forceinline__ unsigned long long pack_fields(int pm, int pn, int kt0, int nkt, int split) {
    return (unsigned long long)pm | ((unsigned long long)pn << 8) | ((unsigned long long)kt0 << 16) | ((unsigned long long)nkt << 24) | ((unsigned long long)(split + 1) << 32) | (1ull << 40); }
__host__ __device__ __forceinline__ unsigned long long pack_unit(const Unit& u) { return pack_fields(u.pm, u.pn, u.kt0, u.nkt, u.split); }
#define UP_PM(p) ((int)((p) & 0xff))
#define UP_PN(p) ((int)(((p) >> 8) & 0xff))
#define UP_KT0(p) ((int)(((p) >> 16) & 0xff))
#define UP_NKT(p) ((int)(((p) >> 24) & 0xff))
#define UP_SPLIT(p) ((int)(((p) >> 32) & 0xff) - 1)

struct StaticOrder {
    int nM, nN, nwg, G, c, nkt;
    __host__ __device__ void init(int M, int N, int G_, int c_, int K) { nM = M / BM; nN = N / BM; nwg = nM * nN; G = G_; c = c_; nkt = K / BK; }
    __host__ __device__ __forceinline__ bool next(int i, Unit& u) const {
        const long L = (long)i * G + c; if (L >= nwg) return false;
        int wgid = (int)L; { const int q = nwg / NXCD, r = nwg % NXCD, xcd = wgid % NXCD, off = wgid / NXCD; wgid = (xcd < r ? xcd * (q + 1) : r * (q + 1) + (xcd - r) * q) + off; }
        const int nig = WGM * nN, gid = wgid / nig, fm = gid * WGM, gsz = (nM - fm) < WGM ? (nM - fm) : WGM;
        u.pm = fm + ((wgid % nig) % gsz); u.pn = (wgid % nig) / gsz; u.kt0 = 0; u.nkt = nkt; u.split = -1; return true;
    }
    __host__ __device__ __forceinline__ unsigned long long nextp(int i) const { Unit u; if (!next(i, u)) return 0ull; return pack_unit(u); }
    __device__ __forceinline__ void a_ready(const Unit&) const {}
    __device__ __forceinline__ void done(const Unit&) const {}
};
struct SplitOrder {
    StaticOrder P; int G, c, S, base, total;
    __host__ __device__ void init(int K, int G_, int c_, int S_, int base_) { P.init(MP, DM, G_, c_, K); G = G_; c = c_; S = S_; base = base_; total = K / BK; }
    __host__ __device__ __forceinline__ bool next(int i, Unit& u) const {
        const long L = (long)i * G + c;
        if (L < P.nwg) {
            int wgid = (int)L; { const int q = P.nwg / NXCD, r = P.nwg % NXCD, xcd = wgid % NXCD, off = wgid / NXCD; wgid = (xcd < r ? xcd * (q + 1) : r * (q + 1) + (xcd - r) * q) + off; }
            const int nig = WGM * P.nN, gid = wgid / nig, fm = gid * WGM, gsz = (P.nM - fm) < WGM ? (P.nM - fm) : WGM;
            u.pm = fm + ((wgid % nig) % gsz); u.pn = (wgid % nig) / gsz; u.kt0 = 0; u.nkt = total; u.split = -1; return true;
        }
        const int l2 = (int)(L - P.nwg); if (l2 >= 16 * S) return false;
        u.pn = l2 & 7; u.pm = MP / BM + ((l2 >> 3) & 1); u.split = l2 >> 4; u.kt0 = u.split * base; u.nkt = (u.split == S - 1) ? total - base * (S - 1) : base; return true;
    }
    __host__ __device__ __forceinline__ unsigned long long nextp(int i) const {
        const long L = (long)i * G + c;
        if (L < P.nwg) {
            int wgid = (int)L; { const int q = P.nwg / NXCD, r = P.nwg % NXCD, xcd = wgid % NXCD, off = wgid / NXCD; wgid = (xcd < r ? xcd * (q + 1) : r * (q + 1) + (xcd - r) * q) + off; }
            const int nig = WGM * P.nN, gid = wgid / nig, fm = gid * WGM, gsz = (P.nM - fm) < WGM ? (P.nM - fm) : WGM;
            return pack_fields(fm + ((wgid % nig) % gsz), (wgid % nig) / gsz, 0, total, -1);
        }
        const int l2 = (int)(L - P.nwg); if (l2 >= 16 * S) return 0ull;
        const int sp = l2 >> 4;
        return pack_fields(MP / BM + ((l2 >> 3) & 1), l2 & 7, sp * base, (sp == S - 1) ? total - base * (S - 1) : base, sp);
    }
    __device__ __forceinline__ void a_ready(const Unit&) const {}
    __device__ __forceinline__ void done(const Unit&) const {}
};

__device__ __forceinline__ unsigned cvt_pk_bf16(float lo, float hi) { unsigned r; asm volatile("v_cvt_pk_bf16_f32 %0, %1, %2" : "=v"(r) : "v"(lo), "v"(hi)); return r; }

struct EpiBf16 {
    static constexpr bool PERM = true, AFTER_DRAIN = false;
    bf16_t* O; int ldc; const float* ssq; int glu0, glu_col;
    __device__ __forceinline__ void operator()(const f32x4 (&acc)[2][2][4][2], const Unit& u, int wr, int wc, int fr, int fq) const {
        const int row0 = u.pm * BM + wr * 64 + fr;
        if (glu0 >= 0 && u.pn >= glu0 && u.pn < glu0 + 16) {
            const int col0 = glu_col + 128 * (u.pn - glu0) + wc * 32 + 8 * fq;
#pragma unroll
            for (int ai = 0; ai < 2; ++ai)
#pragma unroll
                for (int m = 0; m < 4; ++m) { float o[8];
#pragma unroll
                    for (int n = 0; n < 2; ++n)
#pragma unroll
                        for (int j = 0; j < 4; ++j) { const float a = acc[ai][0][m][n][j], g = acc[ai][1][m][n][j]; o[4 * n + j] = a * __builtin_amdgcn_rcpf(1.f + __expf(-g)); }
                    u32x4 w; w.x = cvt_pk_bf16(o[0], o[1]); w.y = cvt_pk_bf16(o[2], o[3]); w.z = cvt_pk_bf16(o[4], o[5]); w.w = cvt_pk_bf16(o[6], o[7]);
                    *(u32x4*)(O + (size_t)(row0 + ai * HALF + m * 16) * ldc + col0) = w; }
            return;
        }
        const int col0 = u.pn * BM + wc * 32 + 8 * fq;
        float rs[2][4];
#pragma unroll
        for (int ai = 0; ai < 2; ++ai)
#pragma unroll
            for (int m = 0; m < 4; ++m) rs[ai][m] = ssq ? rsqrtf(ssq[row0 + ai * HALF + m * 16] * (1.f / DM) + EPS) : 1.f;
#pragma unroll
        for (int ai = 0; ai < 2; ++ai)
#pragma unroll
            for (int m = 0; m < 4; ++m) { bf16_t* rowp = O + (size_t)(row0 + ai * HALF + m * 16) * ldc + col0;
#pragma unroll
                for (int bj = 0; bj < 2; ++bj) { const f32x4 v0 = acc[ai][bj][m][0] * rs[ai][m], v1 = acc[ai][bj][m][1] * rs[ai][m];
                    u32x4 w; w.x = cvt_pk_bf16(v0[0], v0[1]); w.y = cvt_pk_bf16(v0[2], v0[3]); w.z = cvt_pk_bf16(v1[0], v1[1]); w.w = cvt_pk_bf16(v1[2], v1[3]);
                    *(u32x4*)(rowp + bj * HALF) = w; } }
    }
};
struct EpiX1 {
    static constexpr bool PERM = true, AFTER_DRAIN = false;
    const float* baseP; bf16_t* X1B; float* ssq; float* part; int probe_repeat;
    __device__ __forceinline__ void operator()(const f32x4 (&acc)[2][2][4][2], const Unit& u, int wr, int wc, int fr, int fq) const {
        const int row0 = u.pm * BM + wr * 64 + fr; const int col0 = u.pn * BM + wc * 32 + 8 * fq;
        if (u.split >= 0) {
            float* pp = part + ((size_t)u.split * MS + (row0 - MP)) * DM;
#pragma unroll
            for (int ai = 0; ai < 2; ++ai)
#pragma unroll
                for (int m = 0; m < 4; ++m) { const size_t ro = (size_t)(ai * HALF + m * 16) * DM + col0;
#pragma unroll
                    for (int bj = 0; bj < 2; ++bj) { *(f32x4*)(pp + ro + bj * HALF) = acc[ai][bj][m][0]; *(f32x4*)(pp + ro + bj * HALF + 4) = acc[ai][bj][m][1]; } }
            return;
        }
        const float* bp = baseP + (size_t)row0 * DM;
        bf16_t* op = X1B + (size_t)row0 * DM;
#pragma unroll
        for (int ai = 0; ai < 2; ++ai)
#pragma unroll
            for (int mp = 0; mp < 2; ++mp) {
                f32x4 bv[2][2][2];
#pragma unroll
                for (int mm = 0; mm < 2; ++mm)
#pragma unroll
                    for (int bj = 0; bj < 2; ++bj) { const size_t ro = (size_t)(ai * HALF + (2 * mp + mm) * 16) * DM + col0 + bj * HALF;
                        bv[mm][bj][0] = *(const f32x4*)(bp + ro); bv[mm][bj][1] = *(const f32x4*)(bp + ro + 4); }
#pragma unroll
                for (int mm = 0; mm < 2; ++mm) { float sq = 0.f;
#pragma unroll
                    for (int bj = 0; bj < 2; ++bj) { const size_t ro = (size_t)(ai * HALF + (2 * mp + mm) * 16) * DM + col0 + bj * HALF;
                        const f32x4 v0 = bv[mm][bj][0] + acc[ai][bj][2 * mp + mm][0], v1 = bv[mm][bj][1] + acc[ai][bj][2 * mp + mm][1];
                        sq += (v0[0] * v0[0] + v0[1] * v0[1]) + (v0[2] * v0[2] + v0[3] * v0[3]) + (v1[0] * v1[0] + v1[1] * v1[1]) + (v1[2] * v1[2] + v1[3] * v1[3]);
                        u32x4 w; w.x = cvt_pk_bf16(v0[0], v0[1]); w.y = cvt_pk_bf16(v0[2], v0[3]); w.z = cvt_pk_bf16(v1[0], v1[1]); w.w = cvt_pk_bf16(v1[2], v1[3]);
                        *(u32x4*)(op + ro) = w; }
                    sq += __shfl_xor(sq, 16); sq += __shfl_xor(sq, 32);
                    if (fq == 0 && !probe_repeat) atomicAdd(ssq + row0 + ai * HALF + (2 * mp + mm) * 16, sq); }
                asm volatile("" ::: "memory"); }
    }
};
struct EpiResF32 {
    static constexpr bool PERM = true, AFTER_DRAIN = false;
    bf16_t* X1B; float* out; float* part; int probe_repeat;
    __device__ __forceinline__ void operator()(const f32x4 (&acc)[2][2][4][2], const Unit& u, int wr, int wc, int fr, int fq) const {
        const int row0 = u.pm * BM + wr * 64 + fr; const int col0 = u.pn * BM + wc * 32 + 8 * fq;
        if (u.split >= 0) {
            float* pp = part + ((size_t)u.split * MS + (row0 - MP)) * DM;
#pragma unroll
            for (int ai = 0; ai < 2; ++ai)
#pragma unroll
                for (int m = 0; m < 4; ++m) { const size_t ro = (size_t)(ai * HALF + m * 16) * DM + col0;
#pragma unroll
                    for (int bj = 0; bj < 2; ++bj) { *(f32x4*)(pp + ro + bj * HALF) = acc[ai][bj][m][0]; *(f32x4*)(pp + ro + bj * HALF + 4) = acc[ai][bj][m][1]; } }
            return;
        }
        bf16_t* bp = X1B + (size_t)row0 * DM;
        bf16_t* wp = probe_repeat ? (bf16_t*)out + (size_t)row0 * DM : bp;
#pragma unroll
        for (int ai = 0; ai < 2; ++ai) {
            u32x4 bv[4][2];
#pragma unroll
            for (int m = 0; m < 4; ++m)
#pragma unroll
                for (int bj = 0; bj < 2; ++bj) bv[m][bj] = *(const u32x4*)(bp + (size_t)(ai * HALF + m * 16) * DM + col0 + bj * HALF);
#pragma unroll
            for (int m = 0; m < 4; ++m)
#pragma unroll
                for (int bj = 0; bj < 2; ++bj) { const size_t ro = (size_t)(ai * HALF + m * 16) * DM + col0 + bj * HALF; float b[8]; unpack8(bv[m][bj], b);
                    const f32x4 v0 = (f32x4){b[0], b[1], b[2], b[3]} + acc[ai][bj][m][0], v1 = (f32x4){b[4], b[5], b[6], b[7]} + acc[ai][bj][m][1];
                    u32x4 w; w.x = cvt_pk_bf16(v0[0], v0[1]); w.y = cvt_pk_bf16(v0[2], v0[3]); w.z = cvt_pk_bf16(v1[0], v1[1]); w.w = cvt_pk_bf16(v1[2], v1[3]);
                    *(u32x4*)(wp + ro) = w; }
            asm volatile("" ::: "memory"); }
    }
};

template <class Epi, class Sched, bool ALIGN_EPI = false, bool SP2 = false>
__device__ __forceinline__ void gemm_phase(PG8_LAS unsigned char* lds, const Gemm g, const Sched& S, const Epi& E) {
    const int tid = ltid(), wid = __builtin_amdgcn_readfirstlane(tid >> 6), lane = tid & 63, wr = wid >> 2, wc = wid & 3, fr = lane & 15, fq = lane >> 4;
    const int K = g.K;
    unsigned voffA[2], voffB[2];
#pragma unroll
    for (int i = 0; i < 2; ++i) { int R, C; stage_rc(tid * 16 + i * 8192, R, C); const int Rb = Epi::PERM ? ((R & ~31) + perm32(R & 31)) : R;
        voffA[i] = (unsigned)(R * K + C) * 2u; voffB[i] = (unsigned)(Rb * K + C) * 2u; }
    const size_t kstep = (size_t)(BK * 2);
    const size_t hstep = (size_t)HALF * K * 2;
    const size_t tstep = 2 * hstep;
    const unsigned ldsw = (unsigned)wid * 1024u;
    const int aoff = lds_byte(wr * 64 + fr, fq * 8), boff = lds_byte(wc * 32 + fr, fq * 8);
#define PG8_SA(b, h) (((b) * 2 + (h)) * HTB)
#define PG8_SB(b, h) ((4 + (b) * 2 + (h)) * HTB)
#define PG8_STAGE(bufoff, gbase, voff) do { _Pragma("unroll") for (int _i = 0; _i < 2; ++_i) \
        __builtin_amdgcn_global_load_lds((const unsigned*)((const char*)(gbase) + (voff)[_i]), (PG8_LAS unsigned*)(lds + (bufoff) + ldsw + _i * 8192), 16, 0, 0); } while (0)
#define PG8_LDA(dst, b, h) do { _Pragma("unroll") for (int m = 0; m < 4; ++m) _Pragma("unroll") for (int k = 0; k < 2; ++k) dst[m][k] = *(const PG8_LAS bf16x8*)(lds + PG8_SA(b, h) + aoff + m * 2048 + k * 1024); } while (0)
#define PG8_LDB(dst, b, h) do { _Pragma("unroll") for (int n = 0; n < 2; ++n) _Pragma("unroll") for (int k = 0; k < 2; ++k) dst[n][k] = *(const PG8_LAS bf16x8*)(lds + PG8_SB(b, h) + boff + n * 2048 + k * 1024); } while (0)
#define PG8_MMA(ai, bj, At, Bt) do { __builtin_amdgcn_s_setprio(1); _Pragma("unroll") for (int m = 0; m < 4; ++m) _Pragma("unroll") for (int n = 0; n < 2; ++n) _Pragma("unroll") for (int k = 0; k < 2; ++k) \
        acc[ai][bj][m][n] = __builtin_amdgcn_mfma_f32_16x16x32_bf16(Bt[n][k], At[m][k], acc[ai][bj][m][n], 0, 0, 0); __builtin_amdgcn_s_setprio(0); } while (0)
#define PG8_WAIT_V(n) asm volatile("s_waitcnt vmcnt(" #n ")" ::: "memory")
#define PG8_WAIT_L(n) asm volatile("s_waitcnt lgkmcnt(" #n ")" ::: "memory")
#define PG8_BAR __builtin_amdgcn_s_barrier()
#define PG8_SCHED __builtin_amdgcn_sched_barrier(0)
    unsigned long long cur = S.nextp(0), nxt; int ui = 0;
    if (!cur) return;
    f32x4 acc[2][2][4][2];
#pragma unroll
    for (int a = 0; a < 2; ++a)
#pragma unroll
        for (int b = 0; b < 2; ++b)
#pragma unroll
            for (int m = 0; m < 4; ++m)
#pragma unroll
                for (int n = 0; n < 2; ++n) acc[a][b][m][n] = (f32x4){0.f, 0.f, 0.f, 0.f};
    bf16x8 At[4][2], B0[2][2], B1[2][2];
    const char* cA = (const char*)g.A + (size_t)UP_PM(cur) * tstep + (size_t)UP_KT0(cur) * kstep; const char* cB = (const char*)g.Bt + (size_t)UP_PN(cur) * tstep + (size_t)UP_KT0(cur) * kstep;
    if constexpr (SP2) {
        PG8_STAGE(PG8_SB(0, 0), cB, voffB); PG8_STAGE(PG8_SB(0, 1), cB + hstep, voffB); PG8_STAGE(PG8_SA(0, 0), cA, voffA); PG8_STAGE(PG8_SA(0, 1), cA + hstep, voffA);
        if (wr == 1) PG8_BAR;
        PG8_WAIT_V(2); PG8_BAR;
        PG8_STAGE(PG8_SB(1, 0), cB + kstep, voffB); PG8_STAGE(PG8_SA(1, 0), cA + kstep, voffA); PG8_STAGE(PG8_SB(1, 1), cB + hstep + kstep, voffB);
        PG8_WAIT_V(6); PG8_BAR;
    } else {
        PG8_STAGE(PG8_SB(0, 0), cB, voffB); PG8_STAGE(PG8_SA(0, 0), cA, voffA); PG8_STAGE(PG8_SB(0, 1), cB + hstep, voffB); PG8_STAGE(PG8_SA(0, 1), cA + hstep, voffA);
        if (wr == 1) PG8_BAR;
        PG8_WAIT_V(4); PG8_BAR;
        PG8_STAGE(PG8_SB(1, 0), cB + kstep, voffB); PG8_STAGE(PG8_SA(1, 0), cA + kstep, voffA); PG8_STAGE(PG8_SB(1, 1), cB + hstep + kstep, voffB);
        PG8_WAIT_V(6); PG8_BAR;
    }
    for (;;) {
        nxt = S.nextp(ui + 1); const bool has_next = (nxt != 0ull);
        const char* nA = has_next ? (const char*)g.A + (size_t)UP_PM(nxt) * tstep + (size_t)UP_KT0(nxt) * kstep : cA; const char* nB = has_next ? (const char*)g.Bt + (size_t)UP_PN(nxt) * tstep + (size_t)UP_KT0(nxt) * kstep : cB;
        const int nt = UP_NKT(cur);
        for (int t = 0; t < nt; t += 2) {
            const bool last = (t == nt - 2);
            const char* a1 = cA + (size_t)(t + 1) * kstep;
            const char* a2 = last ? nA : cA + (size_t)(t + 2) * kstep; const char* b2 = last ? nB : cB + (size_t)(t + 2) * kstep;
            const char* a3 = a2 + kstep; const char* b3 = b2 + kstep;
            if constexpr (SP2) {
            PG8_LDB(B0, 0, 0); PG8_LDB(B1, 0, 1); PG8_SCHED; PG8_LDA(At, 0, 0); PG8_STAGE(PG8_SA(1, 1), a1 + hstep, voffA);
            PG8_WAIT_V(8); PG8_WAIT_L(0); PG8_BAR; PG8_MMA(0, 0, At, B0); PG8_MMA(0, 1, At, B1); PG8_BAR; PG8_SCHED;
            PG8_LDA(At, 0, 1); PG8_STAGE(PG8_SB(0, 0), b2, voffB); PG8_STAGE(PG8_SB(0, 1), b2 + hstep, voffB); PG8_STAGE(PG8_SA(0, 0), a2, voffA);
            PG8_WAIT_V(8); PG8_WAIT_L(0); PG8_BAR; PG8_MMA(1, 0, At, B0); PG8_MMA(1, 1, At, B1); PG8_BAR; PG8_SCHED;
            PG8_LDB(B0, 1, 0); PG8_LDB(B1, 1, 1); PG8_SCHED; PG8_LDA(At, 1, 0); PG8_STAGE(PG8_SA(0, 1), a2 + hstep, voffA);
            PG8_WAIT_V(8); PG8_WAIT_L(0); PG8_BAR; PG8_MMA(0, 0, At, B0); PG8_MMA(0, 1, At, B1); PG8_BAR; PG8_SCHED;
            PG8_LDA(At, 1, 1); PG8_STAGE(PG8_SB(1, 0), b3, voffB); PG8_STAGE(PG8_SB(1, 1), b3 + hstep, voffB); PG8_STAGE(PG8_SA(1, 0), a3, voffA);
            PG8_WAIT_V(8); PG8_WAIT_L(0); PG8_BAR; PG8_MMA(1, 0, At, B0); PG8_MMA(1, 1, At, B1); PG8_BAR; PG8_SCHED;
            } else {
            PG8_LDB(B0, 0, 0); PG8_SCHED; PG8_LDA(At, 0, 0); PG8_STAGE(PG8_SA(1, 1), a1 + hstep, voffA);
            PG8_WAIT_L(8); PG8_BAR; PG8_WAIT_L(0); PG8_MMA(0, 0, At, B0); PG8_BAR; PG8_SCHED;
            PG8_LDB(B1, 0, 1); PG8_STAGE(PG8_SB(0, 0), b2, voffB);
            PG8_BAR; PG8_WAIT_L(0); PG8_MMA(0, 1, At, B1); PG8_BAR;
            PG8_LDA(At, 0, 1); PG8_STAGE(PG8_SA(0, 0), a2, voffA);
            PG8_BAR; PG8_WAIT_L(0); PG8_MMA(1, 0, At, B0); PG8_BAR; PG8_SCHED;
            PG8_STAGE(PG8_SB(0, 1), b2 + hstep, voffB);
            PG8_WAIT_V(6); PG8_BAR; PG8_MMA(1, 1, At, B1); PG8_BAR;
            PG8_LDB(B0, 1, 0); PG8_SCHED; PG8_LDA(At, 1, 0); PG8_STAGE(PG8_SA(0, 1), a2 + hstep, voffA);
            PG8_WAIT_L(8); PG8_BAR; PG8_WAIT_L(0); PG8_MMA(0, 0, At, B0); PG8_BAR; PG8_SCHED;
            PG8_LDB(B1, 1, 1); PG8_STAGE(PG8_SB(1, 0), b3, voffB);
            PG8_BAR; PG8_WAIT_L(0); PG8_MMA(0, 1, At, B1); PG8_BAR;
            PG8_LDA(At, 1, 1); PG8_STAGE(PG8_SA(1, 0), a3, voffA);
            PG8_BAR; PG8_WAIT_L(0); PG8_MMA(1, 0, At, B0); PG8_BAR; PG8_SCHED;
            PG8_STAGE(PG8_SB(1, 1), b3 + hstep, voffB);
            PG8_WAIT_V(6); PG8_BAR; PG8_MMA(1, 1, At, B1); PG8_BAR;
            }
        }
        if constexpr (ALIGN_EPI) { if (wr == 0) PG8_BAR; }
        { Unit cu; cu.pm = UP_PM(cur); cu.pn = UP_PN(cur); cu.kt0 = UP_KT0(cur); cu.nkt = UP_NKT(cur); cu.split = UP_SPLIT(cur); E(acc, cu, wr, wc, fr, fq); }
        if (!has_next) break;
#pragma unroll
        for (int a = 0; a < 2; ++a)
#pragma unroll
            for (int b = 0; b < 2; ++b)
#pragma unroll
                for (int m = 0; m < 4; ++m)
#pragma unroll
                    for (int n = 0; n < 2; ++n) acc[a][b][m][n] = (f32x4){0.f, 0.f, 0.f, 0.f};
        cur = nxt; cA = nA; cB = nB; ++ui;
        if constexpr (ALIGN_EPI) { if (wr == 1) PG8_BAR; }
    }
    PG8_WAIT_V(0);
    if constexpr (!ALIGN_EPI) { if (wr == 0) PG8_BAR; }
    PG8_BAR;
#undef PG8_SA
#undef PG8_SB
#undef PG8_STAGE
#undef PG8_LDA
#undef PG8_LDB
#undef PG8_MMA
#undef PG8_WAIT_V
#undef PG8_WAIT_L
#undef PG8_BAR
#undef PG8_SCHED
}
}

__device__ __forceinline__ void p0_transpose_item(const float* W, int K, int N, bf16_t* WT, int k0, int n0, int drow0, LAS float* scr, int lane, const float* kscale = nullptr) {
    const float ks = kscale ? kscale[k0 + lane] : 1.f;
#pragma unroll 8
    for (int i = 0; i < 32; ++i) { const int kk = 2 * i + (lane >> 5); scr[kk * 33 + (lane & 31)] = W[(size_t)(k0 + kk) * N + n0 + (lane & 31)] * __shfl(ks, kk); }
    asm volatile("s_waitcnt lgkmcnt(0)" ::: "memory");
    const int c = lane & 7;
#pragma unroll
    for (int j = 0; j < 4; ++j) { const int n = (lane >> 3) + 8 * j; const LAS float* s = scr + (8 * c) * 33 + n;
        u32x4 o; o.x = pk2(s[0 * 33], s[1 * 33]); o.y = pk2(s[2 * 33], s[3 * 33]); o.z = pk2(s[4 * 33], s[5 * 33]); o.w = pk2(s[6 * 33], s[7 * 33]);
        *(u32x4*)(WT + (size_t)(drow0 + n) * K + k0 + 8 * c) = o; }
    asm volatile("s_waitcnt lgkmcnt(0)" ::: "memory");
}
__device__ __forceinline__ int win_dest_row(int n0) {
    if (n0 < 5120) return n0;
    if (n0 < 5152) return CDT + (n0 - 5120);
    if (n0 < 7200) { const int c = n0 - 5152; return CCF + 256 * (c >> 7) + (c & 127); }
    { const int c = n0 - 7200; return CCF + 256 * (c >> 7) + 128 + (c & 127); }
}
__device__ __forceinline__ void rms_row_to_bf16(const float* xrow, const float* w, bf16_t* orow, int lane) {
    f32x4 v[8], ww[8]; float s = 0.f;
#pragma unroll
    for (int j = 0; j < 8; ++j) { v[j] = *(const f32x4*)(xrow + (j * 64 + lane) * 4); ww[j] = *(const f32x4*)(w + (j * 64 + lane) * 4); }
#pragma unroll
    for (int j = 0; j < 8; ++j) s += (v[j].x * v[j].x + v[j].y * v[j].y) + (v[j].z * v[j].z + v[j].w * v[j].w);
    const float r = rsqrtf(wave_sum(s) * (1.f / DM) + EPS);
#pragma unroll
    for (int j = 0; j < 8; ++j) {
        u32x2 o; o.x = pk2(v[j].x * r * ww[j].x, v[j].y * r * ww[j].y); o.y = pk2(v[j].z * r * ww[j].z, v[j].w * r * ww[j].w);
        *(u32x2*)(orow + (j * 64 + lane) * 4) = o; }
}

template <int NT, bool SAMPLE>
__device__ __forceinline__ void ssdconv_item(const bf16_t* PROJ, int row0, bool has_hist, const float* st, int cgi, const float* w, const float* bias, bf16_t* XBC, float* state_out) {
    const int c0 = cgi * 8;
    float wv[4][8], bv[8], h0[8], h1[8], h2[8];
#pragma unroll
    for (int i = 0; i < 4; ++i) { const f32x4 a = *(const f32x4*)(w + i * XBCW + c0), b = *(const f32x4*)(w + i * XBCW + c0 + 4);
        wv[i][0] = a.x; wv[i][1] = a.y; wv[i][2] = a.z; wv[i][3] = a.w; wv[i][4] = b.x; wv[i][5] = b.y; wv[i][6] = b.z; wv[i][7] = b.w; }
    { const f32x4 a = *(const f32x4*)(bias + c0), b = *(const f32x4*)(bias + c0 + 4);
      bv[0] = a.x; bv[1] = a.y; bv[2] = a.z; bv[3] = a.w; bv[4] = b.x; bv[5] = b.y; bv[6] = b.z; bv[7] = b.w; }
    if (SAMPLE) {
#pragma unroll
        for (int e = 0; e < 8; ++e) { h0[e] = st[0 * XBCW + c0 + e]; h1[e] = st[1 * XBCW + c0 + e]; h2[e] = st[2 * XBCW + c0 + e]; }
    } else if (has_hist) {
        unpack8(*(const u32x4*)(PROJ + (size_t)(row0 - 3) * NPROJ + CXBC + c0), h0);
        unpack8(*(const u32x4*)(PROJ + (size_t)(row0 - 2) * NPROJ + CXBC + c0), h1);
        unpack8(*(const u32x4*)(PROJ + (size_t)(row0 - 1) * NPROJ + CXBC + c0), h2);
    } else {
#pragma unroll
        for (int e = 0; e < 8; ++e) { h0[e] = 0.f; h1[e] = 0.f; h2[e] = 0.f; }
    }
    u32x4 rows[NT];
#pragma unroll
    for (int t = 0; t < NT; ++t) rows[t] = *(const u32x4*)(PROJ + (size_t)(row0 + t) * NPROJ + CXBC + c0);
#pragma unroll
    for (int t = 0; t < NT; ++t) {
        float cur[8], o[8];
        unpack8(rows[t], cur);
#pragma unroll
        for (int e = 0; e < 8; ++e) { float v = h0[e] * wv[0][e] + h1[e] * wv[1][e] + h2[e] * wv[2][e] + cur[e] * wv[3][e] + bv[e]; o[e] = siluf_(v); h0[e] = h1[e]; h1[e] = h2[e]; h2[e] = cur[e]; }
        *(u32x4*)(XBC + (size_t)(row0 + t) * XBCW + c0) = pack8(o);
    }
    if (state_out) {
        *(f32x4*)(state_out + 0 * XBCW + c0) = (f32x4){h0[0], h0[1], h0[2], h0[3]}; *(f32x4*)(state_out + 0 * XBCW + c0 + 4) = (f32x4){h0[4], h0[5], h0[6], h0[7]};
        *(f32x4*)(state_out + 1 * XBCW + c0) = (f32x4){h1[0], h1[1], h1[2], h1[3]}; *(f32x4*)(state_out + 1 * XBCW + c0 + 4) = (f32x4){h1[4], h1[5], h1[6], h1[7]};
        *(f32x4*)(state_out + 2 * XBCW + c0) = (f32x4){h2[0], h2[1], h2[2], h2[3]}; *(f32x4*)(state_out + 2 * XBCW + c0 + 4) = (f32x4){h2[4], h2[5], h2[6], h2[7]};
    }
}

__device__ __forceinline__ void ssdconv_prompt_item(const bf16_t* PROJ, int row0, bool has_hist, int cgi, const float* w, const float* bias, bf16_t* XBC, float* state_out,
                                                    const float* DT, const float* CS, bf16_t* XT1, bf16_t* XT2, bf16_t* BT) {
    const int c0 = cgi * 8;
    float wv[4][8], bv[8], h0[8], h1[8], h2[8];
#pragma unroll
    for (int i = 0; i < 4; ++i) { const f32x4 a = *(const f32x4*)(w + i * XBCW + c0), b = *(const f32x4*)(w + i * XBCW + c0 + 4);
        wv[i][0] = a.x; wv[i][1] = a.y; wv[i][2] = a.z; wv[i][3] = a.w; wv[i][4] = b.x; wv[i][5] = b.y; wv[i][6] = b.z; wv[i][7] = b.w; }
    { const f32x4 a = *(const f32x4*)(bias + c0), b = *(const f32x4*)(bias + c0 + 4);
      bv[0] = a.x; bv[1] = a.y; bv[2] = a.z; bv[3] = a.w; bv[4] = b.x; bv[5] = b.y; bv[6] = b.z; bv[7] = b.w; }
    u32x4 rows[8], hr[3];
#pragma unroll
    for (int t = 0; t < 8; ++t) rows[t] = *(const u32x4*)(PROJ + (size_t)(row0 + t) * NPROJ + CXBC + c0);
    if (has_hist) {
#pragma unroll
        for (int i = 0; i < 3; ++i) hr[i] = *(const u32x4*)(PROJ + (size_t)(row0 - 3 + i) * NPROJ + CXBC + c0);
    } else {
#pragma unroll
        for (int i = 0; i < 3; ++i) hr[i] = (u32x4){0u, 0u, 0u, 0u};
    }
    const bool isx = cgi < 256, isb = (cgi >= 256 && cgi < 320);
    float f1[8], f2[8];
    if (isx) { const int h = cgi >> 3; const float csl = CS[(size_t)((row0 & ~127) + 127) * NH + h];
#pragma unroll
        for (int t = 0; t < 8; ++t) { const float d = DT[(size_t)(row0 + t) * NH + h]; const float c = CS[(size_t)(row0 + t) * NH + h]; f1[t] = d; f2[t] = d * __expf(csl - c); } }
    unpack8(hr[0], h0); unpack8(hr[1], h1); unpack8(hr[2], h2);
    float o[8][8];
#pragma unroll
    for (int t = 0; t < 8; ++t) {
        float cur[8];
        unpack8(rows[t], cur);
#pragma unroll
        for (int e = 0; e < 8; ++e) { float v = h0[e] * wv[0][e] + h1[e] * wv[1][e] + h2[e] * wv[2][e] + cur[e] * wv[3][e] + bv[e]; o[t][e] = siluf_(v); h0[e] = h1[e]; h1[e] = h2[e]; h2[e] = cur[e]; }
        *(u32x4*)(XBC + (size_t)(row0 + t) * XBCW + c0) = pack8(o[t]);
    }
    if (state_out) {
        *(f32x4*)(state_out + 0 * XBCW + c0) = (f32x4){h0[0], h0[1], h0[2], h0[3]}; *(f32x4*)(state_out + 0 * XBCW + c0 + 4) = (f32x4){h0[4], h0[5], h0[6], h0[7]};
        *(f32x4*)(state_out + 1 * XBCW + c0) = (f32x4){h1[0], h1[1], h1[2], h1[3]}; *(f32x4*)(state_out + 1 * XBCW + c0 + 4) = (f32x4){h1[4], h1[5], h1[6], h1[7]};
        *(f32x4*)(state_out + 2 * XBCW + c0) = (f32x4){h2[0], h2[1], h2[2], h2[3]}; *(f32x4*)(state_out + 2 * XBCW + c0 + 4) = (f32x4){h2[4], h2[5], h2[6], h2[7]};
    }
    const int chunk = row0 >> 7, jb = row0 & 127;
    if (isx) {
#pragma unroll
        for (int e = 0; e < 8; ++e) { u32x4 a, b2;
            a.x = pk2(o[0][e] * f1[0], o[1][e] * f1[1]); a.y = pk2(o[2][e] * f1[2], o[3][e] * f1[3]); a.z = pk2(o[4][e] * f1[4], o[5][e] * f1[5]); a.w = pk2(o[6][e] * f1[6], o[7][e] * f1[7]);
            b2.x = pk2(o[0][e] * f2[0], o[1][e] * f2[1]); b2.y = pk2(o[2][e] * f2[2], o[3][e] * f2[3]); b2.z = pk2(o[4][e] * f2[4], o[5][e] * f2[5]); b2.w = pk2(o[6][e] * f2[6], o[7][e] * f2[7]);
            const size_t off = ((size_t)chunk * DM + c0 + e) * 128 + jb;
            *(u32x4*)(XT1 + off) = a; *(u32x4*)(XT2 + off) = b2; }
    } else if (isb) {
#pragma unroll
        for (int e = 0; e < 8; ++e) { u32x4 a;
            a.x = pk2(o[0][e], o[1][e]); a.y = pk2(o[2][e], o[3][e]); a.z = pk2(o[4][e], o[5][e]); a.w = pk2(o[6][e], o[7][e]);
            *(u32x4*)(BT + ((size_t)chunk * 512 + (c0 - 2048) + e) * 128 + jb) = a; }
    }
}

__device__ __forceinline__ void cf_sample_item(const bf16_t* PROJ, int s, int c, const float* st, const float* cw, const float* cb, bf16_t* CONVOUT, float* state_out) {
    f32x2 xp[34], w[31];
    unsigned uv[4];
#pragma unroll
    for (int j = 0; j < 30; ++j) xp[j] = *(const f32x2*)(st + j * DM + c);
#pragma unroll
    for (int t = 0; t < 4; ++t) uv[t] = *(const unsigned*)(PROJ + (size_t)(MP + 4 * s + t) * NPROJ + CUCF + c);
#pragma unroll
    for (int i = 0; i < 31; ++i) w[i] = *(const f32x2*)(cw + i * DM + c);
    const f32x2 bias = *(const f32x2*)(cb + c);
#pragma unroll
    for (int t = 0; t < 4; ++t) { xp[30 + t].x = bf2f(uv[t] & 0xffffu); xp[30 + t].y = bf2f(uv[t] >> 16); }
#pragma unroll
    for (int t = 0; t < 4; ++t) { f32x2 acc = bias;
#pragma unroll
        for (int i = 0; i < 31; ++i) acc += xp[t + i] * w[i];
        *(unsigned*)(CONVOUT + (size_t)(MP + 4 * s + t) * DM + c) = pk2(acc.x, acc.y); }
#pragma unroll
    for (int i = 0; i < 30; ++i) *(f32x2*)(state_out + (size_t)i * DM + c) = xp[4 + i];
}

template <int J> struct CfLds {
    static __device__ __forceinline__ void run(float (&acc)[32], const float (&w)[31], const LAS float* us) {
        const float v = us[J * 512];
        constexpr int TLO = (J - 30 > 0) ? J - 30 : 0, THI = (J < 31) ? J : 31;
#pragma unroll
        for (int t = TLO; t <= THI; ++t) acc[t] += v * w[J - t];
        if constexpr (J + 1 < 62) CfLds<J + 1>::run(acc, w, us);
    }
};
__device__ __forceinline__ void cf_prompt_items(LAS unsigned char* lds, const bf16_t* PROJ, int it0, int itstride, int nitems, const float* cw, const float* cb, bf16_t* CONVOUT, float* pcfc) {
    const int tid = ltid(), w = __builtin_amdgcn_readfirstlane(tid >> 6), lane = tid & 63;
    LAS float* Us = (LAS float*)lds;
    if (it0 >= nitems) return;
    u32x4 av[8];
#define CF_LOAD(itx) do { const int r0_ = ((itx) >> 2) * 32, t0_ = r0_ % SEQ, cc_ = ((itx) & 3) * 512; \
        _Pragma("unroll") for (int i = 0; i < 8; ++i) { const int j = w + 8 * i, tt = j - 30; \
            if (j < 62 && t0_ + tt >= 0) av[i] = *(const u32x4*)(PROJ + (size_t)(r0_ + tt) * NPROJ + CUCF + cc_ + lane * 8); \
            else av[i] = (u32x4){0u, 0u, 0u, 0u}; } } while (0)
    CF_LOAD(it0);
    for (int it = it0; it < nitems; it += itstride) {
        const int row0 = (it >> 2) * 32, t0 = row0 % SEQ, b = row0 / SEQ, c0 = (it & 3) * 512;
        float* state_out = (t0 == SEQ - 32) ? pcfc + (size_t)b * 30 * DM : nullptr;
        float wv[31];
#pragma unroll
        for (int i = 0; i < 31; ++i) wv[i] = cw[i * DM + c0 + tid];
        const float bias = cb[c0 + tid];
#pragma unroll
        for (int i = 0; i < 8; ++i) { const int j = w + 8 * i;
            if (j < 62) { float a[8]; unpack8(av[i], a);
                const f32x4 u0 = (f32x4){a[0], a[1], a[2], a[3]}, u1 = (f32x4){a[4], a[5], a[6], a[7]};
                *(LAS f32x4*)(Us + j * 512 + lane * 8) = u0; *(LAS f32x4*)(Us + j * 512 + lane * 8 + 4) = u1;
                if (state_out && j >= 32) { float* sp = state_out + (size_t)(j - 32) * DM + c0 + lane * 8; *(f32x4*)sp = u0; *(f32x4*)(sp + 4) = u1; } } }
        LDS_BARRIER();
        if (it + itstride < nitems) CF_LOAD(it + itstride);
        float acc[32];
#pragma unroll
        for (int t = 0; t < 32; ++t) acc[t] = bias;
        CfLds<0>::run(acc, wv, Us + tid);
#pragma unroll
        for (int t = 0; t < 32; ++t) CONVOUT[(size_t)(row0 + t) * DM + c0 + tid] = (bf16_t)f2bf(acc[t]);
        LDS_BARRIER();
    }
#undef CF_LOAD
}

constexpr int LDP = 136;
constexpr int Q_B = 0, Q_BT = 34816, Q_X1 = 69632, Q_X2 = 87040, Q_H = 104448, Q_CS = 121856;

#define MFMA16(a, b, c) __builtin_amdgcn_mfma_f32_16x16x32_bf16((a), (b), (c), 0, 0, 0)

__device__ __forceinline__ void ssd_prompt(LAS unsigned char* lds, int b, int h, const bf16_t* XBC, const float* CS, const bf16_t* XT1, const bf16_t* XT2, const bf16_t* BT, bf16_t* MIX, float* p_ssm) {
    const int tid = ltid(), w = __builtin_amdgcn_readfirstlane(tid >> 6), lane = tid & 63, fr = lane & 15, fq = lane >> 4;
    const int g = h >> 3;
    const int rt = (w < 4) ? w : 11 - w;
    LAS bf16_t* Bs = (LAS bf16_t*)(lds + Q_B); LAS bf16_t* BTs = (LAS bf16_t*)(lds + Q_BT);
    LAS bf16_t* X1s = (LAS bf16_t*)(lds + Q_X1); LAS bf16_t* X2s = (LAS bf16_t*)(lds + Q_X2); LAS bf16_t* Hs = (LAS bf16_t*)(lds + Q_H);
    LAS float* css_all = (LAS float*)(lds + Q_CS);
    for (int i = tid; i < 64 * LDP / 2; i += 512) ((LAS unsigned*)Hs)[i] = 0u;
#pragma unroll
    for (int i = 0; i < 4; ++i) { const int j = tid + 512 * i; css_all[j] = CS[(size_t)(b * SEQ + j) * NH + h]; }
    f32x4 hacc[4];
#pragma unroll
    for (int pt = 0; pt < 4; ++pt) hacc[pt] = (f32x4){0.f, 0.f, 0.f, 0.f};
    u32x4 Bv[4], BTv[4], X1v[2], X2v[2]; bf16x8 afn[4];
#define SSD_PREFETCH(cidx) do { const int rb_ = b * SEQ + (cidx) * 128; const size_t ci_ = (size_t)(b * (SEQ / 128) + (cidx)); \
        _Pragma("unroll") for (int i = 0; i < 4; ++i) { const int idx = tid + 512 * i, rr = idx >> 4, ch = idx & 15; \
            Bv[i] = *(const u32x4*)(XBC + (size_t)(rb_ + rr) * XBCW + 2048 + g * 128 + ch * 8); BTv[i] = *(const u32x4*)(BT + (ci_ * 512 + g * 128 + rr) * 128 + ch * 8); } \
        _Pragma("unroll") for (int i = 0; i < 2; ++i) { const int idx = tid + 512 * i, rr = idx >> 4, ch = idx & 15; \
            X1v[i] = *(const u32x4*)(XT1 + (ci_ * DM + h * 64 + rr) * 128 + ch * 8); X2v[i] = *(const u32x4*)(XT2 + (ci_ * DM + h * 64 + rr) * 128 + ch * 8); } \
        _Pragma("unroll") for (int ks = 0; ks < 4; ++ks) afn[ks] = *(const bf16x8*)(XBC + (size_t)(rb_ + 16 * rt + fr) * XBCW + 2560 + g * 128 + ks * 32 + fq * 8); } while (0)
    SSD_PREFETCH(0);
    LDS_BARRIER();
    for (int c = 0; c < SEQ / 128; ++c) {
        const int rowbase = b * SEQ + c * 128;
        LAS float* css = css_all + c * 128;
        const float cs_last = css[127];
#pragma unroll
        for (int i = 0; i < 4; ++i) { const int idx = tid + 512 * i, rr = idx >> 4, ch = idx & 15;
            *(LAS u32x4*)(Bs + rr * LDP + ch * 8) = Bv[i]; *(LAS u32x4*)(BTs + rr * LDP + ch * 8) = BTv[i]; }
#pragma unroll
        for (int i = 0; i < 2; ++i) { const int idx = tid + 512 * i, rr = idx >> 4, ch = idx & 15;
            *(LAS u32x4*)(X1s + rr * LDP + ch * 8) = X1v[i]; *(LAS u32x4*)(X2s + rr * LDP + ch * 8) = X2v[i]; }
        bf16x8 afr[4];
#pragma unroll
        for (int ks = 0; ks < 4; ++ks) afr[ks] = afn[ks];
        if (c + 1 < SEQ / 128) SSD_PREFETCH(c + 1);
        LDS_BARRIER();
        u32x2 cbm[8];
        const float csi = css[16 * rt + fr];
#pragma unroll
        for (int jt = 0; jt < 8; ++jt) {
            cbm[jt] = (u32x2){0u, 0u};
            if (jt <= rt) {
                f32x4 a4 = (f32x4){0.f, 0.f, 0.f, 0.f};
#pragma unroll
                for (int ks = 0; ks < 4; ++ks) { const bf16x8 bb = *(const LAS bf16x8*)(Bs + (16 * jt + fr) * LDP + ks * 32 + fq * 8); a4 = MFMA16(bb, afr[ks], a4); }
                const f32x4 csj = *(const LAS f32x4*)(css + 16 * jt + 4 * fq);
                const int i = 16 * rt + fr, j0 = 16 * jt + 4 * fq;
#pragma unroll
                for (int r = 0; r < 4; ++r) a4[r] = (j0 + r <= i) ? a4[r] * __expf(csi - csj[r]) : 0.f;
                cbm[jt].x = pk2(a4[0], a4[1]); cbm[jt].y = pk2(a4[2], a4[3]);
            }
        }
        LDS_BARRIER();
        LAS bf16_t* Ms = Bs;
#pragma unroll
        for (int jt = 0; jt < 8; ++jt) if (jt <= (rt | 1)) {
            *(LAS u32x2*)(Ms + (16 * rt + fr) * LDP + 16 * jt + 4 * fq) = cbm[jt];
        }
        asm volatile("s_waitcnt lgkmcnt(0)" ::: "memory");
        f32x4 yacc[4];
#pragma unroll
        for (int pt = 0; pt < 4; ++pt) yacc[pt] = (f32x4){0.f, 0.f, 0.f, 0.f};
#pragma unroll
        for (int ks = 0; ks < 4; ++ks)
#pragma unroll
            for (int pt = 0; pt < 4; ++pt) { const bf16x8 bb = *(const LAS bf16x8*)(Hs + (16 * pt + fr) * LDP + ks * 32 + fq * 8); yacc[pt] = MFMA16(bb, afr[ks], yacc[pt]); }
        { const float e = __expf(csi);
#pragma unroll
          for (int pt = 0; pt < 4; ++pt) yacc[pt] *= e; }
#pragma unroll
        for (int ks = 0; ks < 4; ++ks) if (ks <= (rt >> 1)) {
            const bf16x8 am = *(const LAS bf16x8*)(Ms + (16 * rt + fr) * LDP + ks * 32 + fq * 8);
#pragma unroll
            for (int pt = 0; pt < 4; ++pt) { const bf16x8 bb = *(const LAS bf16x8*)(X1s + (16 * pt + fr) * LDP + ks * 32 + fq * 8); yacc[pt] = MFMA16(bb, am, yacc[pt]); }
        }
#pragma unroll
        for (int pt = 0; pt < 4; ++pt) { u32x2 pk; pk.x = pk2(yacc[pt][0], yacc[pt][1]); pk.y = pk2(yacc[pt][2], yacc[pt][3]);
            *(u32x2*)(MIX + (size_t)(rowbase + 16 * rt + fr) * DMIX + h * 64 + 16 * pt + 4 * fq) = pk; }
        { const float dl = __expf(cs_last);
#pragma unroll
          for (int pt = 0; pt < 4; ++pt) hacc[pt] *= dl; }
#pragma unroll
        for (int ks = 0; ks < 4; ++ks) { const bf16x8 bb = *(const LAS bf16x8*)(BTs + (16 * w + fr) * LDP + ks * 32 + fq * 8);
#pragma unroll
            for (int pt = 0; pt < 4; ++pt) { const bf16x8 aa = *(const LAS bf16x8*)(X2s + (16 * pt + fr) * LDP + ks * 32 + fq * 8); hacc[pt] = MFMA16(bb, aa, hacc[pt]); } }
        LDS_BARRIER();
#pragma unroll
        for (int pt = 0; pt < 4; ++pt) { u32x2 pk; pk.x = pk2(hacc[pt][0], hacc[pt][1]); pk.y = pk2(hacc[pt][2], hacc[pt][3]);
            *(LAS u32x2*)(Hs + (16 * pt + fr) * LDP + 16 * w + 4 * fq) = pk; }
    }
#undef SSD_PREFETCH
#pragma unroll
    for (int pt = 0; pt < 4; ++pt) *(f32x4*)(p_ssm + ((size_t)(b * NH + h) * HP + 16 * pt + fr) * NS + 16 * w + 4 * fq) = hacc[pt];
    LDS_BARRIER();
}

__device__ __forceinline__ void ssd_sample_items(LAS unsigned char* lds, int it0, int itstride, int nitems, const bf16_t* XBC, const float* DT, const float* a_log,
                                                 const float* state_in, bf16_t* MIX, float* s_ssm) {
    const int tid = ltid(), w = __builtin_amdgcn_readfirstlane(tid >> 6), lane = tid & 63, nl = lane & 31, half = lane >> 5;
    LAS float* Xs = (LAS float*)lds;
    if (it0 >= nitems) return;
    f32x4 nx[16];
    { const int b = it0 >> 2, g = it0 & 3, h = g * 8 + w; const float* sp = state_in + (size_t)(b * NH + h) * HP * NS;
#pragma unroll
      for (int k = 0; k < 16; ++k) nx[k] = *(const f32x4*)(sp + k * 256 + lane * 4); }
    for (int it = it0; it < nitems; it += itstride) {
        const int b = it >> 2, g = it & 3, h = g * 8 + w;
        u32x2 Bp[4], Cp[4]; float dtv[4];
#pragma unroll
        for (int t = 0; t < 4; ++t) { const size_t row = (size_t)(MP + 4 * b + t);
            Xs[t * 512 + tid] = bf2f(XBC[row * XBCW + g * 512 + tid]);
            Bp[t] = *(const u32x2*)(XBC + row * XBCW + 2048 + g * 128 + 4 * nl); Cp[t] = *(const u32x2*)(XBC + row * XBCW + 2560 + g * 128 + 4 * nl);
            dtv[t] = DT[row * NH + h]; }
        const float A = -__expf(a_log[h]);
        LDS_BARRIER();
#pragma unroll
        for (int hh = 0; hh < 2; ++hh) {
            f32x4 st[16];
#pragma unroll
            for (int k = 0; k < 16; ++k) st[k] = nx[k];
            {
                const int itn = it + itstride;
                if (hh == 0) { const float* sp = state_in + (size_t)(b * NH + h) * HP * NS + 4096;
#pragma unroll
                    for (int k = 0; k < 16; ++k) nx[k] = *(const f32x4*)(sp + k * 256 + lane * 4); }
                else if (itn < nitems) { const int bn = itn >> 2, gn = itn & 3; const float* sp = state_in + (size_t)(bn * NH + gn * 8 + w) * HP * NS;
#pragma unroll
                    for (int k = 0; k < 16; ++k) nx[k] = *(const f32x4*)(sp + k * 256 + lane * 4); }
            }
            float yv[4];
#pragma unroll
            for (int t = 0; t < 4; ++t) {
                const float dt = dtv[t]; const float da = __expf(dt * A);
                const f32x4 Bt = (f32x4){bf2f(Bp[t].x & 0xffffu), bf2f(Bp[t].x >> 16), bf2f(Bp[t].y & 0xffffu), bf2f(Bp[t].y >> 16)} * dt;
                const f32x4 Ct = (f32x4){bf2f(Cp[t].x & 0xffffu), bf2f(Cp[t].x >> 16), bf2f(Cp[t].y & 0xffffu), bf2f(Cp[t].y >> 16)};
                float part[8];
                { const bool up8 = (nl & 8) != 0;
#pragma unroll
                  for (int i = 0; i < 8; ++i) {
                    const float x0 = Xs[t * 512 + w * 64 + 32 * hh + 2 * i + half], x1 = Xs[t * 512 + w * 64 + 32 * hh + 2 * (i + 8) + half];
                    st[i] = st[i] * da + Bt * x0; st[i + 8] = st[i + 8] * da + Bt * x1;
                    const f32x4 q0 = Ct * st[i], q1 = Ct * st[i + 8];
                    const float p0 = (q0.x + q0.y) + (q0.z + q0.w), p1 = (q1.x + q1.y) + (q1.z + q1.w);
                    const float send = up8 ? p0 : p1, keep = up8 ? p1 : p0; part[i] = keep + __shfl_xor(send, 8); } }
#define BFLY(o) do { const bool up = (nl & (o)) != 0; _Pragma("unroll") for (int i = 0; i < (o); ++i) { \
                    const float send = up ? part[i] : part[i + (o)]; const float keep = up ? part[i + (o)] : part[i]; part[i] = keep + __shfl_xor(send, (o)); } } while (0)
                BFLY(4); BFLY(2); BFLY(1);
#undef BFLY
                yv[t] = part[0] + __shfl_xor(part[0], 16);
            }
            const int pout = 32 * hh + 2 * (nl & 15) + half;
            if ((nl & 16) == 0) {
#pragma unroll
                for (int t = 0; t < 4; ++t) MIX[(size_t)(MP + 4 * b + t) * DMIX + h * 64 + pout] = (bf16_t)f2bf(yv[t]);
            }
            float* op = s_ssm + (size_t)(b * NH + h) * HP * NS + hh * 4096;
#pragma unroll
            for (int k = 0; k < 16; ++k) *(f32x4*)(op + k * 256 + lane * 4) = st[k];
        }
        LDS_BARRIER();
    }
}

__device__ __forceinline__ void mix_finalize_row(size_t row, bf16_t* MIX, const bf16_t* CONVOUT, const bf16_t* XBC, const bf16_t* PROJ, const float* d_skip, const float* ssd_norm_w, const float* ln_w, const float* ln_b, int lane, bf16_t* ssd_dst) {
    bf16_t* mp = MIX + row * DMIX;
    {
        u32x4 yv[4], xv[4], zv[4]; float dsk[4];
#pragma unroll
        for (int k = 0; k < 4; ++k) { const int c = (k * 64 + lane) * 8;
            yv[k] = *(const u32x4*)(mp + c); xv[k] = *(const u32x4*)(XBC + row * XBCW + c); zv[k] = *(const u32x4*)(PROJ + row * NPROJ + CZ + c);
            dsk[k] = d_skip[c >> 6]; }
        float s = 0.f;
#pragma unroll
        for (int k = 0; k < 4; ++k) { float f[8], xf[8], zf[8]; unpack8(yv[k], f); unpack8(xv[k], xf); unpack8(zv[k], zf);
#pragma unroll
            for (int e = 0; e < 8; ++e) { f[e] = (f[e] + dsk[k] * xf[e]) * siluf_(zf[e]); s += f[e] * f[e]; }
            yv[k] = pack8(f); }
        const float r = rsqrtf(wave_sum(s) * (1.f / DM) + EPS);
#pragma unroll 1
        for (int k = 0; k < 4; ++k) { const int c = (k * 64 + lane) * 8;
            const f32x4 w0 = *(const f32x4*)(ssd_norm_w + c), w1 = *(const f32x4*)(ssd_norm_w + c + 4);
            const u32x4 yk = (k == 0) ? yv[0] : (k == 1) ? yv[1] : (k == 2) ? yv[2] : yv[3];
            float f[8]; unpack8(yk, f);
            float o[8]; o[0] = f[0] * r * w0.x; o[1] = f[1] * r * w0.y; o[2] = f[2] * r * w0.z; o[3] = f[3] * r * w0.w;
            o[4] = f[4] * r * w1.x; o[5] = f[5] * r * w1.y; o[6] = f[6] * r * w1.z; o[7] = f[7] * r * w1.w;
            *(u32x4*)(ssd_dst + c) = pack8(o); }
    }
    {
        const bf16_t* cp = CONVOUT + row * DM;
        f32x4 v[8], ww[8], bb[8];
#pragma unroll
        for (int k = 0; k < 8; ++k) { const u32x2 cv = *(const u32x2*)(cp + (k * 64 + lane) * 4); v[k] = (f32x4){bf2f(cv.x & 0xffffu), bf2f(cv.x >> 16), bf2f(cv.y & 0xffffu), bf2f(cv.y >> 16)};
            ww[k] = *(const f32x4*)(ln_w + (k * 64 + lane) * 4); bb[k] = *(const f32x4*)(ln_b + (k * 64 + lane) * 4); }
        float s = 0.f;
#pragma unroll
        for (int k = 0; k < 8; ++k) s += (v[k].x + v[k].y) + (v[k].z + v[k].w);
        const float mean = wave_sum(s) * (1.f / DM); float q = 0.f;
#pragma unroll
        for (int k = 0; k < 8; ++k) { v[k] = v[k] - mean; q += (v[k].x * v[k].x + v[k].y * v[k].y) + (v[k].z * v[k].z + v[k].w * v[k].w); }
        const float rstd = rsqrtf(wave_sum(q) * (1.f / DM) + EPS);
#pragma unroll
        for (int k = 0; k < 8; ++k) {
            const f32x4 o = v[k] * rstd * ww[k] + bb[k];
            u32x2 pk; pk.x = pk2(siluf_(o.x), siluf_(o.y)); pk.y = pk2(siluf_(o.z), siluf_(o.w));
            *(u32x2*)(mp + DM + (k * 64 + lane) * 4) = pk; }
    }
}

template <int NT, bool SAMPLE>
__device__ __forceinline__ void ffn_item(const bf16_t* U, int row0, bool has_hist, const float* st, int cgi, const float* w, const float* bias, bf16_t* ACT, float* state_out) {
    const int c0 = cgi * 8;
    float wg[3][8], wv[3][8], bg[8], bvv[8], g0[8], g1[8], v0[8], v1[8];
#define LD8(dst, ptr) do { const f32x4 a_ = *(const f32x4*)(ptr), b_ = *(const f32x4*)((ptr) + 4); dst[0] = a_.x; dst[1] = a_.y; dst[2] = a_.z; dst[3] = a_.w; dst[4] = b_.x; dst[5] = b_.y; dst[6] = b_.z; dst[7] = b_.w; } while (0)
#pragma unroll
    for (int i = 0; i < 3; ++i) { LD8(wg[i], w + i * FF2 + c0); LD8(wv[i], w + i * FF2 + FF + c0); }
    LD8(bg, bias + c0); LD8(bvv, bias + FF + c0);
    if (SAMPLE) {
        LD8(g0, st + 0 * FF2 + c0); LD8(g1, st + 1 * FF2 + c0); LD8(v0, st + 0 * FF2 + FF + c0); LD8(v1, st + 1 * FF2 + FF + c0);
    } else if (has_hist) {
        unpack8(*(const u32x4*)(U + (size_t)(row0 - 2) * FF2 + c0), g0); unpack8(*(const u32x4*)(U + (size_t)(row0 - 1) * FF2 + c0), g1);
        unpack8(*(const u32x4*)(U + (size_t)(row0 - 2) * FF2 + FF + c0), v0); unpack8(*(const u32x4*)(U + (size_t)(row0 - 1) * FF2 + FF + c0), v1);
    } else {
#pragma unroll
        for (int e = 0; e < 8; ++e) { g0[e] = 0.f; g1[e] = 0.f; v0[e] = 0.f; v1[e] = 0.f; }
    }
#undef LD8
    u32x4 rg[NT], rv[NT];
#pragma unroll
    for (int t = 0; t < NT; ++t) { rg[t] = *(const u32x4*)(U + (size_t)(row0 + t) * FF2 + c0); rv[t] = *(const u32x4*)(U + (size_t)(row0 + t) * FF2 + FF + c0); }
#pragma unroll
    for (int t = 0; t < NT; ++t) {
        float cg_[8], cv_[8], o[8];
        unpack8(rg[t], cg_); unpack8(rv[t], cv_);
#pragma unroll
        for (int e = 0; e < 8; ++e) {
            const float gg = g0[e] * wg[0][e] + g1[e] * wg[1][e] + cg_[e] * wg[2][e] + bg[e];
            const float vv = v0[e] * wv[0][e] + v1[e] * wv[1][e] + cv_[e] * wv[2][e] + bvv[e];
            o[e] = siluf_(gg) * vv; g0[e] = g1[e]; g1[e] = cg_[e]; v0[e] = v1[e]; v1[e] = cv_[e]; }
        *(u32x4*)(ACT + (size_t)(row0 + t) * FF + c0) = pack8(o);
    }
    if (state_out) {
#define ST8(ptr, src) do { *(f32x4*)(ptr) = (f32x4){src[0], src[1], src[2], src[3]}; *(f32x4*)((ptr) + 4) = (f32x4){src[4], src[5], src[6], src[7]}; } while (0)
        ST8(state_out + 0 * FF2 + c0, g0); ST8(state_out + 1 * FF2 + c0, g1); ST8(state_out + 0 * FF2 + FF + c0, v0); ST8(state_out + 1 * FF2 + FF + c0, v1);
#undef ST8
    }
}


#define XB_TMO      128
#define XB_XCNT(j)  (256  + 64 * (j))
#define XB_XSUB(j)  (1280 + 64 * (j))
#define XB_XGEN(j)  (2304 + 64 * (j))
#define XB_TOP      3328
#define XB_TOPGEN   3392
#define XCD_BAR_WORDS 3456
#define XB_SPIN_CAP (1u << 18)
__device__ __forceinline__ unsigned xb_ld(unsigned* p)              { return __hip_atomic_load(p, __ATOMIC_RELAXED, __HIP_MEMORY_SCOPE_AGENT); }
__device__ __forceinline__ unsigned xb_add(unsigned* p, unsigned v) { return __hip_atomic_fetch_add(p, v, __ATOMIC_RELAXED, __HIP_MEMORY_SCOPE_AGENT); }
__device__ __forceinline__ unsigned xb_xcc_id() { return (unsigned)__builtin_amdgcn_s_getreg((3 << 11) | 20) & 0xFu; }
#define XB_SPIN(cond, bar) do { unsigned _sp = 0; while (cond) { __builtin_amdgcn_s_sleep(1); \
    if ((++_sp & 255u) == 0u) { if (xb_ld(&(bar)[XB_TMO])) break; if (_sp > XB_SPIN_CAP) { atomicAdd(&(bar)[XB_TMO], 1u); break; } } } } while (0)
struct XcdBarrier { unsigned* bar; unsigned x; volatile LAS unsigned* st; };
__device__ __forceinline__ XcdBarrier xcd_barrier_post(unsigned* bar, volatile LAS unsigned* st) {
    XcdBarrier b; b.bar = bar; b.x = xb_xcc_id(); b.st = st;
    if (threadIdx.x == 0) (void)xb_add(&bar[XB_XCNT(b.x)], 1u);
    return b;
}
__device__ __forceinline__ void xcd_barrier_complete(unsigned* bar, unsigned x, unsigned& nloc, unsigned& nx) {
    const unsigned G = gridDim.x * gridDim.y * gridDim.z;
    unsigned sum, cnt, mine, sp = 0u;
    for (;;) {
        sum = 0u; cnt = 0u; mine = 0u;
#pragma unroll
        for (unsigned j = 0; j < 16; ++j) { const unsigned c = xb_ld(&bar[XB_XCNT(j)]); sum += c; cnt += (c > 0u) ? 1u : 0u; mine = (j == x) ? c : mine; }
        if (sum == G) break;
        __builtin_amdgcn_s_sleep(1);
        if ((++sp & 255u) == 0u) { if (xb_ld(&bar[XB_TMO])) break; if (sp > XB_SPIN_CAP) { atomicAdd(&bar[XB_TMO], 1u); break; } }
    }
    nloc = mine > 0u ? mine : 1u; nx = cnt > 0u ? cnt : 1u;
}
__device__ __forceinline__ void xcd_barrier(const XcdBarrier& b) {
    asm volatile("s_waitcnt vmcnt(0)" ::: "memory");
    __syncthreads();
    if (threadIdx.x == 0) {
        unsigned* bar = b.bar;
        __builtin_amdgcn_s_waitcnt(0);
        unsigned nloc = b.st[0], nx = b.st[1];
        if (nloc == 0u) { xcd_barrier_complete(bar, b.x, nloc, nx); b.st[0] = nloc; b.st[1] = nx; }
        const unsigned old = xb_add(&bar[XB_XSUB(b.x)], 1u);
        const unsigned gen = old / nloc;
        if (old + 1u == (gen + 1u) * nloc) {
            __builtin_amdgcn_fence(__ATOMIC_RELEASE, "agent");
            asm volatile("s_waitcnt vmcnt(0)" ::: "memory");
            const unsigned og = xb_add(&bar[XB_TOP], 1u);
            const unsigned tg = og / nx;
            if (og + 1u == (tg + 1u) * nx) xb_add(&bar[XB_TOPGEN], 1u);
            else XB_SPIN(xb_ld(&bar[XB_TOPGEN]) == tg, bar);
            __builtin_amdgcn_fence(__ATOMIC_ACQUIRE, "agent");
            xb_add(&bar[XB_XGEN(b.x)], 1u);
            asm volatile("s_waitcnt vmcnt(0)" ::: "memory");
        } else {
            XB_SPIN(xb_ld(&bar[XB_XGEN(b.x)]) == gen, bar);
            __builtin_amdgcn_fence(__ATOMIC_ACQUIRE, "agent");
            asm volatile("s_waitcnt vmcnt(0)" ::: "memory");
        }
    }
    __syncthreads();
}

struct Args { const float* in[25]; float* out_p; unsigned char* ws_p; int ph_lo, ph_hi, li, pad; };
constexpr int N_PHASES = 11;
typedef const __attribute__((address_space(4))) Args* KArgs;
__device__ __forceinline__ KArgs ka_get() { KArgs p = (KArgs)__builtin_amdgcn_kernarg_segment_ptr(); asm volatile("" : "+s"(p)); return p; }

__global__ void __launch_bounds__(512, 2) mk_fwd(Args args) {
    extern __shared__ __attribute__((aligned(16))) unsigned char lds_raw[];
    LAS unsigned char* lds = (LAS unsigned char*)lds_raw;
    const int tid = ltid(), lane = tid & 63, wave = __builtin_amdgcn_readfirstlane(tid >> 6);
    const int G = gridDim.x, bx = blockIdx.x;
    const int lo = args.ph_lo, hi = args.ph_hi;
#define x_prompt ((const float*)KA->in[0])
#define x_sample ((const float*)KA->in[1])
#define state_ssm ((const float*)KA->in[2])
#define state_ssdc ((const float*)KA->in[3])
#define state_cfc ((const float*)KA->in[4])
#define state_ffc ((const float*)KA->in[5])
#define norm_mix_w ((const float*)KA->in[6])
#define w_in ((const float*)KA->in[7])
#define ssd_conv_w ((const float*)KA->in[8])
#define ssd_conv_b ((const float*)KA->in[9])
#define dt_bias ((const float*)KA->in[10])
#define a_log ((const float*)KA->in[11])
#define d_skip ((const float*)KA->in[12])
#define ssd_norm_w ((const float*)KA->in[13])
#define cf_conv_w ((const float*)KA->in[14])
#define cf_conv_b ((const float*)KA->in[15])
#define cf_ln_w ((const float*)KA->in[16])
#define cf_ln_b ((const float*)KA->in[17])
#define w_out ((const float*)KA->in[18])
#define norm_ffn_w ((const float*)KA->in[19])
#define w_up ((const float*)KA->in[20])
#define ffn_conv_w ((const float*)KA->in[21])
#define ffn_conv_b ((const float*)KA->in[22])
#define w_down ((const float*)KA->in[23])
#define norm_final_w ((const float*)KA->in[24])
#define out ((float*)KA->out_p)
#define ws ((unsigned char*)KA->ws_p)
#define WinT ((bf16_t*)(ws + WS_WIN))
#define WoutT ((bf16_t*)(ws + WS_WOUT))
#define WupT ((bf16_t*)(ws + WS_WUP))
#define WdnT ((bf16_t*)(ws + WS_WDN))
#define XN ((bf16_t*)(ws + WS_XN))
#define DT ((float*)(ws + WS_DT))
#define PROJ ((bf16_t*)(ws + WS_PROJ))
#define XBC ((bf16_t*)(ws + WS_XBC))
#define U ((bf16_t*)(ws + WS_U))
#define CONVOUT ((bf16_t*)(ws + WS_CONV))
#define MIX ((bf16_t*)(ws + WS_MIX))
#define ACT ((bf16_t*)(ws + WS_ACT))
#define PART ((float*)(ws + WS_RA))
    constexpr int S2 = 8, S4 = 7;

#ifndef PHASE_MASK
#define PHASE_MASK 0x7ff
#endif
#define IN(k) (((PHASE_MASK >> (k)) & 1) && lo <= (k) && (k) < hi)
    volatile LAS unsigned* bst = (volatile LAS unsigned*)(lds + LDS_BYTES - 64);
    if (tid < 2) bst[tid] = 0u;
    __syncthreads();
    const KArgs KA0 = ka_get();
    const XcdBarrier gbar = xcd_barrier_post((unsigned*)((unsigned char*)KA0->ws_p + WS_CTL) + (args.li & 0xff) * XCD_BAR_WORDS, bst);
    const int psel = args.li >> 8;
    if (args.pad != 0) cg::this_grid().sync();
#define SEAM(k) do { if (IN(k) && IN((k) + 1)) xcd_barrier(gbar); } while (0)

    if (IN(0)) { const KArgs KA = ka_get(); const int tid = ltid(), lane = tid & 63, wave = __builtin_amdgcn_readfirstlane(tid >> 6); (void)lane; (void)wave;
        LAS float* scr = (LAS float*)(lds + wave * 16384);
        const int gw = bx * 8 + wave, NGW = G * 8;
        constexpr int I_IN = (DM / 64) * (9248 / 32), I_OUT = (DMIX / 64) * (DM / 32), I_UP = (DM / 64) * (FF2 / 32), I_DN = (FF / 64) * (DM / 32);
        for (int it = gw; it < I_IN + I_OUT + I_UP + I_DN; it += NGW) {
            int r = it;
            if (r < I_IN) { const int nblk = 9248 / 32, kb = r / nblk, nb = r % nblk; p0_transpose_item(w_in, DM, 9248, WinT, 64 * kb, 32 * nb, win_dest_row(32 * nb), scr, lane); continue; } r -= I_IN;
            if (r < I_OUT) { const int nblk = DM / 32, kb = r / nblk, nb = r % nblk; p0_transpose_item(w_out, DMIX, DM, WoutT, 64 * kb, 32 * nb, 32 * nb, scr, lane); continue; } r -= I_OUT;
            if (r < I_UP) { const int nblk = FF2 / 32, kb = r / nblk, nb = r % nblk; p0_transpose_item(w_up, DM, FF2, WupT, 64 * kb, 32 * nb, 32 * nb, scr, lane, norm_ffn_w); continue; } r -= I_UP;
            { const int nblk = DM / 32, kb = r / nblk, nb = r % nblk; p0_transpose_item(w_down, FF, DM, WdnT, 64 * kb, 32 * nb, 32 * nb, scr, lane); }
        }
        for (int m = gw; m < MT; m += NGW) { const float* xr = (m < MP) ? x_prompt + (size_t)m * DM : x_sample + (size_t)(m - MP) * DM; rms_row_to_bf16(xr, norm_mix_w, XN + (size_t)m * DM, lane); }
    }
    SEAM(0);
    if (IN(1)) { const KArgs KA = ka_get(); const int tid = ltid(), lane = tid & 63, wave = __builtin_amdgcn_readfirstlane(tid >> 6); (void)lane; (void)wave;
        pg8::Gemm g{XN, WinT, MT, NPROJ, DM}; pg8::StaticOrder S; S.init(MT, NPROJ, G, bx, DM);
        pg8::EpiBf16 E{PROJ, NPROJ, nullptr, CCF / 256, CUCF};
        pg8::gemm_phase<pg8::EpiBf16, pg8::StaticOrder, true, true>(lds, g, S, E);
    }
    SEAM(1);
    if (IN(2)) { const KArgs KA = ka_get(); const int tid = ltid(), lane = tid & 63, wave = __builtin_amdgcn_readfirstlane(tid >> 6); (void)lane; (void)wave;
        bf16_t* XT1 = (bf16_t*)(ws + WS_XT1); bf16_t* XT2 = (bf16_t*)((unsigned char*)out + OS_XT2); bf16_t* BT = (bf16_t*)((unsigned char*)out + OS_BT); float* CS = (float*)((unsigned char*)out + OS_CS);
        {   const int gw = bx * 8 + wave, NGW = G * 8;
            for (int it = gw; it < 64 * NH + (MS * NH) / 64; it += NGW) {
                if (it < 64 * NH) { const int ci = it >> 5, h = it & 31, rb = ci * 128;
                    const float bias = dt_bias[h], A = -__expf(a_log[h]);
                    const float v0 = bf2f(PROJ[(size_t)(rb + 2 * lane) * NPROJ + CDT + h]) + bias, v1 = bf2f(PROJ[(size_t)(rb + 2 * lane + 1) * NPROJ + CDT + h]) + bias;
                    const float d0 = fmaxf(v0, 0.f) + log1pf(__expf(-fabsf(v0))), d1 = fmaxf(v1, 0.f) + log1pf(__expf(-fabsf(v1)));
                    const float a1 = d1 * A; float sc = d0 * A + a1;
#pragma unroll
                    for (int o = 1; o < 64; o <<= 1) { const float t = __shfl_up(sc, o); if (lane >= o) sc += t; }
                    DT[(size_t)(rb + 2 * lane) * NH + h] = d0; DT[(size_t)(rb + 2 * lane + 1) * NH + h] = d1;
                    CS[(size_t)(rb + 2 * lane) * NH + h] = sc - a1; CS[(size_t)(rb + 2 * lane + 1) * NH + h] = sc; }
                else { const int e = (it - 64 * NH) * 64 + lane, row = MP + (e >> 5), h = e & 31;
                    const float v = bf2f(PROJ[(size_t)row * NPROJ + CDT + h]) + dt_bias[h];
                    DT[(size_t)row * NH + h] = fmaxf(v, 0.f) + log1pf(__expf(-fabsf(v))); }
            }
        }
        if (psel != 1) {
            cf_prompt_items(lds, PROJ, bx, G, 1024, cf_conv_w, cf_conv_b, CONVOUT, out + O_PCFC);
            for (int it2 = bx; it2 < 256; it2 += G) { const int s = it2 >> 1, c = (it2 & 1) * 1024 + tid * 2;
                cf_sample_item(PROJ, s, c, state_cfc + (size_t)s * 30 * DM, cf_conv_w, cf_conv_b, CONVOUT, out + O_SCFC + (size_t)s * 30 * DM); }
        }
        xcd_barrier(gbar);
        const int gt = bx * 512 + tid, NGT = G * 512;
        if (psel != 2) for (int it = gt; it < (MP / 8) * 384; it += NGT) {
            const int cq = it & 7, tgl = (it >> 3) & 7, rest = it >> 6; const int cgi = (rest % 48) * 8 + cq, tg = (rest / 48) * 8 + tgl; const int row0 = tg * 8, t0 = row0 % SEQ, b = row0 / SEQ;
            ssdconv_prompt_item(PROJ, row0, t0 > 0, cgi, ssd_conv_w, ssd_conv_b, XBC, (t0 == SEQ - 8) ? out + O_PSSDC + (size_t)b * 3 * XBCW : nullptr, DT, CS, XT1, XT2, BT); }
        for (int it = gt; it < DB * 384; it += NGT) { const int cgi = it % 384, s = it / 384;
            ssdconv_item<4, true>(PROJ, MP + 4 * s, true, state_ssdc + (size_t)s * 3 * XBCW, cgi, ssd_conv_w, ssd_conv_b, XBC, out + O_SSSDC + (size_t)s * 3 * XBCW); }
    }
    SEAM(2);
    if (IN(3)) { const KArgs KA = ka_get(); const int tid = ltid(), lane = tid & 63, wave = __builtin_amdgcn_readfirstlane(tid >> 6); (void)lane; (void)wave;
        const bf16_t* XT1 = (const bf16_t*)(ws + WS_XT1); const bf16_t* XT2 = (const bf16_t*)((unsigned char*)out + OS_XT2); const bf16_t* BT = (const bf16_t*)((unsigned char*)out + OS_BT); const float* CS = (const float*)((unsigned char*)out + OS_CS);
        const int npb = (G >= 256) ? 128 : (G / 2 > 0 ? G / 2 : 1);
        if (bx < npb) { if (psel != 2) for (int it = bx; it < NB * NH; it += npb) ssd_prompt(lds, it >> 5, it & 31, XBC, CS, XT1, XT2, BT, MIX, out + O_PSSM); }
        else { if (psel != 1) ssd_sample_items(lds, bx - npb, G - npb, DB * NG, XBC, DT, a_log, state_ssm, MIX, out + O_SSSM); }
    }
    SEAM(3);
    if (IN(4)) { const KArgs KA = ka_get(); const int tid = ltid(), lane = tid & 63, wave = __builtin_amdgcn_readfirstlane(tid >> 6); (void)lane; (void)wave;
        for (int m = bx * 8 + wave; m < MT; m += G * 8) mix_finalize_row((size_t)m, MIX, CONVOUT, XBC, PROJ, d_skip, ssd_norm_w, cf_ln_w, cf_ln_b, lane, (psel == 3) ? XN + (size_t)m * DM : MIX + (size_t)m * DMIX);
    }
    SEAM(4);
    if (IN(5)) { const KArgs KA = ka_get(); const int tid = ltid(), lane = tid & 63, wave = __builtin_amdgcn_readfirstlane(tid >> 6); (void)lane; (void)wave;
        pg8::Gemm g{MIX, WoutT, MT, DM, DMIX}; pg8::SplitOrder S; S.init(DMIX, G, bx, S2, 8);
        pg8::EpiX1 E{x_prompt, XN, (float*)(ws + WS_CTL + CTL_SSQ1), PART, psel == 3};
        pg8::gemm_phase<pg8::EpiX1, pg8::SplitOrder, true, true>(lds, g, S, E);
    }
    SEAM(5);
    if (IN(6)) { const KArgs KA = ka_get(); const int tid = ltid(), lane = tid & 63, wave = __builtin_amdgcn_readfirstlane(tid >> 6); (void)lane; (void)wave;
        float* SSQ1 = (float*)(ws + WS_CTL + CTL_SSQ1);
        for (int m = MP + bx * 8 + wave; m < MT; m += G * 8) {
            const float* base = x_sample + (size_t)(m - MP) * DM; const float* part = PART + (size_t)(m - MP) * DM;
            f32x4 v[8];
#pragma unroll
            for (int j = 0; j < 8; ++j) v[j] = *(const f32x4*)(base + (j * 64 + lane) * 4);
            for (int sp = 0; sp < S2; ++sp) {
#pragma unroll
                for (int j = 0; j < 8; ++j) v[j] += *(const f32x4*)(part + (size_t)sp * MS * DM + (j * 64 + lane) * 4); }
            float sq = 0.f;
#pragma unroll
            for (int j = 0; j < 8; ++j) sq += (v[j].x * v[j].x + v[j].y * v[j].y) + (v[j].z * v[j].z + v[j].w * v[j].w);
            sq = wave_sum(sq);
            if (lane == 0) SSQ1[m] = sq;
#pragma unroll
            for (int j = 0; j < 8; ++j) { u32x2 o; o.x = pk2(v[j].x, v[j].y); o.y = pk2(v[j].z, v[j].w); *(u32x2*)(XN + (size_t)m * DM + (j * 64 + lane) * 4) = o; }
        }
    }
    SEAM(6);
    if (IN(7)) { const KArgs KA = ka_get(); const int tid = ltid(), lane = tid & 63, wave = __builtin_amdgcn_readfirstlane(tid >> 6); (void)lane; (void)wave;
        pg8::Gemm g{XN, WupT, MT, FF2, DM}; pg8::StaticOrder S; S.init(MT, FF2, G, bx, DM);
        pg8::EpiBf16 E{U, FF2, (const float*)(ws + WS_CTL + CTL_SSQ1), -1, 0};
        pg8::gemm_phase<pg8::EpiBf16, pg8::StaticOrder, true, true>(lds, g, S, E);
    }
    SEAM(7);
    if (IN(8)) { const KArgs KA = ka_get(); const int tid = ltid(), lane = tid & 63, wave = __builtin_amdgcn_readfirstlane(tid >> 6); (void)lane; (void)wave;
        const int gt = bx * 512 + tid, NGT = G * 512;
        for (int it = gt; it < (MP / 8) * 688; it += NGT) { const int cgi = it % 688, tg = it / 688; const int row0 = tg * 8, t0 = row0 % SEQ, b = row0 / SEQ;
            ffn_item<8, false>(U, row0, t0 > 0, nullptr, cgi, ffn_conv_w, ffn_conv_b, ACT, (t0 == SEQ - 8) ? out + O_PFFC + (size_t)b * 2 * FF2 : nullptr); }
        for (int it = gt; it < DB * 688; it += NGT) { const int cgi = it % 688, s = it / 688;
            ffn_item<4, true>(U, MP + 4 * s, true, state_ffc + (size_t)s * 2 * FF2, cgi, ffn_conv_w, ffn_conv_b, ACT, out + O_SFFC + (size_t)s * 2 * FF2); }
    }
    SEAM(8);
    if (IN(9)) { const KArgs KA = ka_get(); const int tid = ltid(), lane = tid & 63, wave = __builtin_amdgcn_readfirstlane(tid >> 6); (void)lane; (void)wave;
        pg8::Gemm g{ACT, WdnT, MT, DM, FF}; pg8::SplitOrder S; S.init(FF, G, bx, S4, 12);
        pg8::EpiResF32 E{XN, out + O_Y, PART, psel == 3};
        pg8::gemm_phase<pg8::EpiResF32, pg8::SplitOrder, true, true>(lds, g, S, E);
    }
    SEAM(9);
    if (IN(10)) { const KArgs KA = ka_get(); const int tid = ltid(), lane = tid & 63, wave = __builtin_amdgcn_readfirstlane(tid >> 6); (void)lane; (void)wave;
        for (int m = bx * 8 + wave; m < MT; m += G * 8) {
            float* xr = out + O_Y + (size_t)m * DM;
            f32x4 v[8], ww[8];
#pragma unroll
            for (int j = 0; j < 8; ++j) { const u32x2 b = *(const u32x2*)(XN + (size_t)m * DM + (j * 64 + lane) * 4); v[j] = (f32x4){bf2f(b.x & 0xffffu), bf2f(b.x >> 16), bf2f(b.y & 0xffffu), bf2f(b.y >> 16)};
                ww[j] = *(const f32x4*)(norm_final_w + (j * 64 + lane) * 4); }
            if (m >= MP) { const float* part = PART + (size_t)(m - MP) * DM;
                for (int sp = 0; sp < S4; ++sp) {
#pragma unroll
                    for (int j = 0; j < 8; ++j) v[j] += *(const f32x4*)(part + (size_t)sp * MS * DM + (j * 64 + lane) * 4); } }
            float s = 0.f;
#pragma unroll
            for (int j = 0; j < 8; ++j) s += (v[j].x * v[j].x + v[j].y * v[j].y) + (v[j].z * v[j].z + v[j].w * v[j].w);
            const float r = rsqrtf(wave_sum(s) * (1.f / DM) + EPS);
#pragma unroll
            for (int j = 0; j < 8; ++j) *(f32x4*)(xr + (j * 64 + lane) * 4) = v[j] * r * ww[j];
        }
    }
#undef IN
#undef SEAM
}
#undef x_prompt
#undef x_sample
#undef state_ssm
#undef state_ssdc
#undef state_cfc
#undef state_ffc
#undef norm_mix_w
#undef w_in
#undef ssd_conv_w
#undef ssd_conv_b
#undef dt_bias
#undef a_log
#undef d_skip
#undef ssd_norm_w
#undef cf_conv_w
#undef cf_conv_b
#undef cf_ln_w
#undef cf_ln_b
#undef w_out
#undef norm_ffn_w
#undef w_up
#undef ffn_conv_w
#undef ffn_conv_b
#undef w_down
#undef norm_final_w
#undef out
#undef ws
#undef WinT
#undef WoutT
#undef WupT
#undef WdnT
#undef XN
#undef DT
#undef PROJ
#undef XBC
#undef U
#undef CONVOUT
#undef MIX
#undef ACT
#undef PART


extern "C" void kernel_launch(void* const* d_in, const int* in_sizes, int n_in, void* d_out, int out_size, void* d_ws, size_t ws_size, hipStream_t stream) {
    static int grid = 0;
    if (grid == 0) {
        if (n_in != 25 || (size_t)out_size != O_END || ws_size < WS_END) {
            fprintf(stderr, "kernel_launch: shape mismatch: n_in %d out %d (want %zu) ws %zu (need %zu)\n", n_in, out_size, (size_t)O_END, ws_size, (size_t)WS_END); grid = -1; return; }
        int dev = 0, cus = 0, per_cu = 0;
        hipGetDevice(&dev);
        hipDeviceGetAttribute(&cus, hipDeviceAttributeMultiprocessorCount, dev);
        if (hipFuncSetAttribute((const void*)mk_fwd, hipFuncAttributeMaxDynamicSharedMemorySize, LDS_BYTES) != hipSuccess) { fprintf(stderr, "kernel_launch: hipFuncSetAttribute failed\n"); grid = -1; return; }
        if (hipOccupancyMaxActiveBlocksPerMultiprocessor(&per_cu, (const void*)mk_fwd, 512, LDS_BYTES) != hipSuccess || per_cu < 1) { fprintf(stderr, "kernel_launch: occupancy query %d\n", per_cu); per_cu = 1; }
        (void)hipGetLastError();
        grid = cus * per_cu;
    }
    if (grid < 0) return;
    Args a{};
    for (int i = 0; i < 25; ++i) a.in[i] = (const float*)d_in[i];
    a.out_p = (float*)d_out; a.ws_p = (unsigned char*)d_ws;
#ifndef PROBE_SEL
#define PROBE_SEL 0
#endif
#ifndef PROBE_PHASE
#define PROBE_PHASE -1
#endif
    int ranges[3][2]; int nr = 0;
    if (PROBE_PHASE < 0) { ranges[0][0] = 0; ranges[0][1] = N_PHASES; nr = 1; }
    else { ranges[0][0] = 0; ranges[0][1] = PROBE_PHASE + 1; ranges[1][0] = PROBE_PHASE; ranges[1][1] = PROBE_PHASE + 1; nr = 2;
           if (PROBE_PHASE + 1 < N_PHASES) { ranges[2][0] = PROBE_PHASE + 1; ranges[2][1] = N_PHASES; nr = 3; } }
    if (hipMemsetAsync((char*)d_ws + WS_CTL, 0, CTL_BYTES, stream) != hipSuccess) { fprintf(stderr, "kernel_launch: memset failed\n"); return; }
    for (int i = 0; i < nr; ++i) {
        a.ph_lo = ranges[i][0]; a.ph_hi = ranges[i][1]; a.li = i | ((i == 1) ? (PROBE_SEL << 8) : 0);
        void* kargs[] = {&a};
        hipError_t e = hipLaunchCooperativeKernel((const void*)mk_fwd, dim3(grid), dim3(512), kargs, LDS_BYTES, stream);
        if (e != hipSuccess) fprintf(stderr, "kernel_launch: cooperative launch failed: %s (grid %d)\n", hipGetErrorString(e), grid);
    }
}
```

```cpp
#include <hip/hip_runtime.h>
#include <hip/hip_cooperative_groups.h>
#include <cstdio>
#include <cstdint>
namespace cg = cooperative_groups;

#ifndef MK_N_LAUNCHES
#define MK_N_LAUNCHES 1
#endif

#define LAS __attribute__((address_space(3)))
typedef unsigned short bf16_t;
typedef short bf16x8 __attribute__((ext_vector_type(8)));
typedef float f32x4 __attribute__((ext_vector_type(4)));
typedef float f32x2 __attribute__((ext_vector_type(2)));
typedef unsigned u32x4 __attribute__((ext_vector_type(4)));
typedef unsigned u32x2 __attribute__((ext_vector_type(2)));

constexpr int DM = 2048;
constexpr int MP = 8192, MS = 512, MT = MP + MS;
constexpr int SEQ = 2048, NB = 4, DB = 128, DSEQ = 4;
constexpr int NH = 32, HP = 64, NS = 128, NG = 4;
constexpr int XBCW = 3072;
constexpr int NPROJ = 9472;
constexpr int CZ = 0, CXBC = 2048, CCF = 5120, CDT = 9216;
constexpr int CUCF = 5120;
constexpr int DMIX = 4096, FF = 5504, FF2 = 11008;
constexpr float EPS = 1e-5f;

constexpr size_t O_Y = 0;
constexpr size_t O_PSSM = (size_t)MT * DM;
constexpr size_t O_PSSDC = O_PSSM + (size_t)NB * NH * HP * NS;
constexpr size_t O_PCFC = O_PSSDC + (size_t)NB * 3 * XBCW;
constexpr size_t O_PFFC = O_PCFC + (size_t)NB * 30 * DM;
constexpr size_t O_SSSM = O_PFFC + (size_t)NB * 2 * FF2;
constexpr size_t O_SSSDC = O_SSSM + (size_t)DB * NH * HP * NS;
constexpr size_t O_SCFC = O_SSSDC + (size_t)DB * 3 * XBCW;
constexpr size_t O_SFFC = O_SCFC + (size_t)DB * 30 * DM;
constexpr size_t O_END = O_SFFC + (size_t)DB * 2 * FF2;

constexpr size_t al256(size_t x) { return (x + 255) & ~(size_t)255; }
constexpr size_t WS_WIN = 0;
constexpr size_t WS_WOUT = WS_WIN + al256((size_t)NPROJ * DM * 2);
constexpr size_t WS_WUP = WS_WOUT + al256((size_t)DM * DMIX * 2);
constexpr size_t WS_WDN = WS_WUP + al256((size_t)FF2 * DM * 2);
constexpr size_t WS_XN = WS_WDN + al256((size_t)DM * FF * 2);
constexpr size_t WS_DT = WS_XN + al256((size_t)MT * DM * 2);
constexpr size_t WS_RA = WS_DT + al256((size_t)MT * NH * 4);
constexpr size_t WS_PROJ = WS_RA;
constexpr size_t WS_XBC = WS_PROJ + al256((size_t)MT * NPROJ * 2);
constexpr size_t WS_U = WS_RA;
constexpr size_t WS_RB = WS_XBC + al256((size_t)MT * XBCW * 2);
constexpr size_t WS_CONV = WS_RB;
constexpr size_t WS_MIX = WS_CONV + al256((size_t)MT * DM * 4);
constexpr size_t WS_ACT = WS_RB;
constexpr size_t WS_CTL = WS_MIX + al256((size_t)MT * DMIX * 2);
constexpr size_t CTL_BYTES = 131072;
constexpr size_t CTL_SSQ1 = 65536;
constexpr size_t WS_END = WS_CTL + CTL_BYTES;
static_assert((size_t)MT * FF2 * 2 <= WS_RB - WS_RA, "U overlay");
static_assert((size_t)MT * FF * 2 <= WS_END - WS_RB, "ACT overlay");

constexpr size_t WS_XT1 = WS_XN;
constexpr size_t OS_XT2 = 0, OS_BT = OS_XT2 + (size_t)MP * DM * 2, OS_CS = OS_BT + (size_t)64 * 512 * 128 * 2;
static_assert((size_t)MP * DM * 2 <= (size_t)MT * DM * 2 && OS_CS + (size_t)MP * NH * 4 <= (size_t)MT * DM * 4, "ssd scratch maps");
constexpr int LDS_BYTES = 147456;

__device__ __forceinline__ int ltid() { int t = threadIdx.x; asm volatile("" : "+v"(t)); return t; }
__device__ __forceinline__ float bf2f(unsigned h) { return __uint_as_float(h << 16); }
__device__ __forceinline__ unsigned f2bf(float f) { unsigned u = __float_as_uint(f); return (u + 0x7fffu + ((u >> 16) & 1u)) >> 16; }
__device__ __forceinline__ unsigned pk2(float lo, float hi) { unsigned r; asm("v_cvt_pk_bf16_f32 %0, %1, %2" : "=v"(r) : "v"(lo), "v"(hi)); return r; }
__device__ __forceinline__ float sigmoidf_(float x) { return __builtin_amdgcn_rcpf(1.f + __expf(-x)); }
__device__ __forceinline__ float siluf_(float x) { return x * __builtin_amdgcn_rcpf(1.f + __expf(-x)); }
#define LDS_BARRIER() do { asm volatile("s_waitcnt lgkmcnt(0)" ::: "memory"); __builtin_amdgcn_s_barrier(); asm volatile("" ::: "memory"); } while (0)
__device__ __forceinline__ float wave_sum(float v) {
#pragma unroll
    for (int o = 1; o < 64; o <<= 1) v += __shfl_xor(v, o);
    return v;
}
__device__ __forceinline__ void unpack8(const u32x4 v, float (&o)[8]) {
    o[0] = bf2f(v.x & 0xffffu); o[1] = bf2f(v.x >> 16); o[2] = bf2f(v.y & 0xffffu); o[3] = bf2f(v.y >> 16);
    o[4] = bf2f(v.z & 0xffffu); o[5] = bf2f(v.z >> 16); o[6] = bf2f(v.w & 0xffffu); o[7] = bf2f(v.w >> 16);
}
__device__ __forceinline__ u32x4 pack8(const float (&o)[8]) {
    u32x4 v; v.x = pk2(o[0], o[1]); v.y = pk2(o[2], o[3]); v.z = pk2(o[4], o[5]); v.w = pk2(o[6], o[7]); return v;
}

namespace pg8 {
#define PG8_LAS __attribute__((address_space(3)))
constexpr int BM = 256, BK = 64, HALF = 128, HTB = HALF * BK * 2, STAGE_BYTES = 8 * HTB, NXCD = 8, WGM = 8;
__host__ __device__ __forceinline__ int lds_byte(int r, int c) { const int st = (r >> 4) * 2 + (c >> 5), rr = r & 15, cc = c & 31, ob = rr * 64 + cc * 2; return st * 1024 + (ob ^ (((ob >> 9) & 1) << 5)); }
__host__ __device__ __forceinline__ void stage_rc(int b, int& R, int& C) { const int st = b / 1024, sb = b % 1024, swz = sb ^ (((sb >> 9) & 1) << 5); R = (st >> 1) * 16 + swz / 64; C = (st & 1) * 32 + (swz % 64) / 2; }
__host__ __device__ __forceinline__ int perm32(int rho) { const int n = rho >> 4, i = rho & 15; return 8 * (i >> 2) + 4 * n + (i & 3); }

struct Unit { int pm, pn, kt0, nkt, split; };
struct Gemm { const bf16_t* A; const bf16_t* Bt; int M, N, K; };
__host__ __device__ __forceinline__ unsigned long long pack_fields(int pm, int pn, int kt0, int nkt, int split) {
    return (unsigned long long)pm | ((unsigned long long)pn << 8) | ((unsigned long long)kt0 << 16) | ((unsigned long long)nkt << 24) | ((unsigned long long)(split + 1) << 32) | (1ull << 40); }
__host__ __device__ __forceinline__ unsigned long long pack_unit(const Unit& u) { return pack_fields(u.pm, u.pn, u.kt0, u.nkt, u.split); }
#define UP_PM(p) ((int)((p) & 0xff))
#define UP_PN(p) ((int)(((p) >> 8) & 0xff))
#define UP_KT0(p) ((int)(((p) >> 16) & 0xff))
#define UP_NKT(p) ((int)(((p) >> 24) & 0xff))
#define UP_SPLIT(p) ((int)(((p) >> 32) & 0xff) - 1)

struct StaticOrder {
    int nM, nN, nwg, G, c, nkt;
    __host__ __device__ void init(int M, int N, int G_, int c_, int K) { nM = M / BM; nN = N / BM; nwg = nM * nN; G = G_; c = c_; nkt = K / BK; }
    __host__ __device__ __forceinline__ bool next(int i, Unit& u) const {
        const long L = (long)i * G + c; if (L >= nwg) return false;
        int wgid = (int)L; { const int q = nwg / NXCD, r = nwg % NXCD, xcd = wgid % NXCD, off = wgid / NXCD; wgid = (xcd < r ? xcd * (q + 1) : r * (q + 1) + (xcd - r) * q) + off; }
        const int nig = WGM * nN, gid = wgid / nig, fm = gid * WGM, gsz = (nM - fm) < WGM ? (nM - fm) : WGM;
        u.pm = fm + ((wgid % nig) % gsz); u.pn = (wgid % nig) / gsz; u.kt0 = 0; u.nkt = nkt; u.split = -1; return true;
    }
    __host__ __device__ __forceinline__ unsigned long long nextp(int i) const { Unit u; if (!next(i, u)) return 0ull; return pack_unit(u); }
    __device__ __forceinline__ void a_ready(const Unit&) const {}
    __device__ __forceinline__ void done(const Unit&) const {}
};
struct SplitOrder {
    StaticOrder P; int G, c, S, base, total;
    __host__ __device__ void init(int K, int G_, int c_, int S_, int base_) { P.init(MP, DM, G_, c_, K); G = G_; c = c_; S = S_; base = base_; total = K / BK; }
    __host__ __device__ __forceinline__ bool next(int i, Unit& u) const {
        const long L = (long)i * G + c;
        if (L < P.nwg) {
            int wgid = (int)L; { const int q = P.nwg / NXCD, r = P.nwg % NXCD, xcd = wgid % NXCD, off = wgid / NXCD; wgid = (xcd < r ? xcd * (q + 1) : r * (q + 1) + (xcd - r) * q) + off; }
            const int nig = WGM * P.nN, gid = wgid / nig, fm = gid * WGM, gsz = (P.nM - fm) < WGM ? (P.nM - fm) : WGM;
            u.pm = fm + ((wgid % nig) % gsz); u.pn = (wgid % nig) / gsz; u.kt0 = 0; u.nkt = total; u.split = -1; return true;
        }
        const int l2 = (int)(L - P.nwg); if (l2 >= 16 * S) return false;
        u.pn = l2 & 7; u.pm = MP / BM + ((l2 >> 3) & 1); u.split = l2 >> 4; u.kt0 = u.split * base; u.nkt = (u.split == S - 1) ? total - base * (S - 1) : base; return true;
    }
    __host__ __device__ __forceinline__ unsigned long long nextp(int i) const {
        const long L = (long)i * G + c;
        if (L < P.nwg) {
            int wgid = (int)L; { const int q = P.nwg / NXCD, r = P.nwg % NXCD, xcd = wgid % NXCD, off = wgid / NXCD; wgid = (xcd < r ? xcd * (q + 1) : r * (q + 1) + (xcd - r) * q) + off; }
            const int nig = WGM * P.nN, gid = wgid / nig, fm = gid * WGM, gsz = (P.nM - fm) < WGM ? (P.nM - fm) : WGM;
            return pack_fields(fm + ((wgid % nig) % gsz), (wgid % nig) / gsz, 0, total, -1);
        }
        const int l2 = (int)(L - P.nwg); if (l2 >= 16 * S) return 0ull;
        const int sp = l2 >> 4;
        return pack_fields(MP / BM + ((l2 >> 3) & 1), l2 & 7, sp * base, (sp == S - 1) ? total - base * (S - 1) : base, sp);
    }
    __device__ __forceinline__ void a_ready(const Unit&) const {}
    __device__ __forceinline__ void done(const Unit&) const {}
};

__device__ __forceinline__ unsigned cvt_pk_bf16(float lo, float hi) { unsigned r; asm volatile("v_cvt_pk_bf16_f32 %0, %1, %2" : "=v"(r) : "v"(lo), "v"(hi)); return r; }

struct EpiBf16 {
    static constexpr bool PERM = true, AFTER_DRAIN = false;
    bf16_t* O; int ldc; const float* ssq; int glu0, glu_col;
    __device__ __forceinline__ void operator()(const f32x4 (&acc)[2][2][4][2], const Unit& u, int wr, int wc, int fr, int fq) const {
        const int row0 = u.pm * BM + wr * 64 + fr;
        if (glu0 >= 0 && u.pn >= glu0 && u.pn < glu0 + 16) {
            const int col0 = glu_col + 128 * (u.pn - glu0) + wc * 32 + 8 * fq;
#pragma unroll
            for (int ai = 0; ai < 2; ++ai)
#pragma unroll
                for (int m = 0; m < 4; ++m) { float o[8];
#pragma unroll
                    for (int n = 0; n < 2; ++n)
#pragma unroll
                        for (int j = 0; j < 4; ++j) { const float a = acc[ai][0][m][n][j], g = acc[ai][1][m][n][j]; o[4 * n + j] = a * __builtin_amdgcn_rcpf(1.f + __expf(-g)); }
                    u32x4 w; w.x = cvt_pk_bf16(o[0], o[1]); w.y = cvt_pk_bf16(o[2], o[3]); w.z = cvt_pk_bf16(o[4], o[5]); w.w = cvt_pk_bf16(o[6], o[7]);
                    *(u32x4*)(O + (size_t)(row0 + ai * HALF + m * 16) * ldc + col0) = w; }
            return;
        }
        const int col0 = u.pn * BM + wc * 32 + 8 * fq;
        float rs[2][4];
#pragma unroll
        for (int ai = 0; ai < 2; ++ai)
#pragma unroll
            for (int m = 0; m < 4; ++m) rs[ai][m] = ssq ? rsqrtf(ssq[row0 + ai * HALF + m * 16] * (1.f / DM) + EPS) : 1.f;
#pragma unroll
        for (int ai = 0; ai < 2; ++ai)
#pragma unroll
            for (int m = 0; m < 4; ++m) { bf16_t* rowp = O + (size_t)(row0 + ai * HALF + m * 16) * ldc + col0;
#pragma unroll
                for (int bj = 0; bj < 2; ++bj) { const f32x4 v0 = acc[ai][bj][m][0] * rs[ai][m], v1 = acc[ai][bj][m][1] * rs[ai][m];
                    u32x4 w; w.x = cvt_pk_bf16(v0[0], v0[1]); w.y = cvt_pk_bf16(v0[2], v0[3]); w.z = cvt_pk_bf16(v1[0], v1[1]); w.w = cvt_pk_bf16(v1[2], v1[3]);
                    *(u32x4*)(rowp + bj * HALF) = w; } }
    }
};
struct EpiX1 {
    static constexpr bool PERM = true, AFTER_DRAIN = false;
    const float* baseP; bf16_t* X1B; float* ssq; float* part; int probe_repeat;
    __device__ __forceinline__ void operator()(const f32x4 (&acc)[2][2][4][2], const Unit& u, int wr, int wc, int fr, int fq) const {
        const int row0 = u.pm * BM + wr * 64 + fr; const int col0 = u.pn * BM + wc * 32 + 8 * fq;
        if (u.split >= 0) {
            float* pp = part + ((size_t)u.split * MS + (row0 - MP)) * DM;
#pragma unroll
            for (int ai = 0; ai < 2; ++ai)
#pragma unroll
                for (int m = 0; m < 4; ++m) { const size_t ro = (size_t)(ai * HALF + m * 16) * DM + col0;
#pragma unroll
                    for (int bj = 0; bj < 2; ++bj) { *(f32x4*)(pp + ro + bj * HALF) = acc[ai][bj][m][0]; *(f32x4*)(pp + ro + bj * HALF + 4) = acc[ai][bj][m][1]; } }
            return;
        }
        const float* bp = baseP + (size_t)row0 * DM;
        bf16_t* op = X1B + (size_t)row0 * DM;
#pragma unroll
        for (int ai = 0; ai < 2; ++ai)
#pragma unroll
            for (int mp = 0; mp < 2; ++mp) {
                f32x4 bv[2][2][2];
#pragma unroll
                for (int mm = 0; mm < 2; ++mm)
#pragma unroll
                    for (int bj = 0; bj < 2; ++bj) { const size_t ro = (size_t)(ai * HALF + (2 * mp + mm) * 16) * DM + col0 + bj * HALF;
                        bv[mm][bj][0] = *(const f32x4*)(bp + ro); bv[mm][bj][1] = *(const f32x4*)(bp + ro + 4); }
#pragma unroll
                for (int mm = 0; mm < 2; ++mm) { float sq = 0.f;
#pragma unroll
                    for (int bj = 0; bj < 2; ++bj) { const size_t ro = (size_t)(ai * HALF + (2 * mp + mm) * 16) * DM + col0 + bj * HALF;
                        const f32x4 v0 = bv[mm][bj][0] + acc[ai][bj][2 * mp + mm][0], v1 = bv[mm][bj][1] + acc[ai][bj][2 * mp + mm][1];
                        sq += (v0[0] * v0[0] + v0[1] * v0[1]) + (v0[2] * v0[2] + v0[3] * v0[3]) + (v1[0] * v1[0] + v1[1] * v1[1]) + (v1[2] * v1[2] + v1[3] * v1[3]);
                        u32x4 w; w.x = cvt_pk_bf16(v0[0], v0[1]); w.y = cvt_pk_bf16(v0[2], v0[3]); w.z = cvt_pk_bf16(v1[0], v1[1]); w.w = cvt_pk_bf16(v1[2], v1[3]);
                        *(u32x4*)(op + ro) = w; }
                    sq += __shfl_xor(sq, 16); sq += __shfl_xor(sq, 32);
                    if (fq == 0 && !probe_repeat) atomicAdd(ssq + row0 + ai * HALF + (2 * mp + mm) * 16, sq); }
                asm volatile("" ::: "memory"); }
    }
};
struct EpiResF32 {
    static constexpr bool PERM = true, AFTER_DRAIN = false;
    bf16_t* X1B; float* out; float* part; int probe_repeat;
    __device__ __forceinline__ void operator()(const f32x4 (&acc)[2][2][4][2], const Unit& u, int wr, int wc, int fr, int fq) const {
        const int row0 = u.pm * BM + wr * 64 + fr; const int col0 = u.pn * BM + wc * 32 + 8 * fq;
        if (u.split >= 0) {
            float* pp = part + ((size_t)u.split * MS + (row0 - MP)) * DM;
#pragma unroll
            for (int ai = 0; ai < 2; ++ai)
#pragma unroll
                for (int m = 0; m < 4; ++m) { const size_t ro = (size_t)(ai * HALF + m * 16) * DM + col0;
#pragma unroll
                    for (int bj = 0; bj < 2; ++bj) { *(f32x4*)(pp + ro + bj * HALF) = acc[ai][bj][m][0]; *(f32x4*)(pp + ro + bj * HALF + 4) = acc[ai][bj][m][1]; } }
            return;
        }
        bf16_t* bp = X1B + (size_t)row0 * DM;
        bf16_t* wp = probe_repeat ? (bf16_t*)out + (size_t)row0 * DM : bp;
#pragma unroll
        for (int ai = 0; ai < 2; ++ai) {
            u32x4 bv[4][2];
#pragma unroll
            for (int m = 0; m < 4; ++m)
#pragma unroll
                for (int bj = 0; bj < 2; ++bj) bv[m][bj] = *(const u32x4*)(bp + (size_t)(ai * HALF + m * 16) * DM + col0 + bj * HALF);
#pragma unroll
            for (int m = 0; m < 4; ++m)
#pragma unroll
                for (int bj = 0; bj < 2; ++bj) { const size_t ro = (size_t)(ai * HALF + m * 16) * DM + col0 + bj * HALF; float b[8]; unpack8(bv[m][bj], b);
                    const f32x4 v0 = (f32x4){b[0], b[1], b[2], b[3]} + acc[ai][bj][m][0], v1 = (f32x4){b[4], b[5], b[6], b[7]} + acc[ai][bj][m][1];
                    u32x4 w; w.x = cvt_pk_bf16(v0[0], v0[1]); w.y = cvt_pk_bf16(v0[2], v0[3]); w.z = cvt_pk_bf16(v1[0], v1[1]); w.w = cvt_pk_bf16(v1[2], v1[3]);
                    *(u32x4*)(wp + ro) = w; }
            asm volatile("" ::: "memory"); }
    }
};

template <class Epi, class Sched, bool ALIGN_EPI = false, bool SP2 = false>
__device__ __forceinline__ void gemm_phase(PG8_LAS unsigned char* lds, const Gemm g, const Sched& S, const Epi& E) {
    const int tid = ltid(), wid = __builtin_amdgcn_readfirstlane(tid >> 6), lane = tid & 63, wr = wid >> 2, wc = wid & 3, fr = lane & 15, fq = lane >> 4;
    const int K = g.K;
    unsigned voffA[2], voffB[2];
#pragma unroll
    for (int i = 0; i < 2; ++i) { int R, C; stage_rc(tid * 16 + i * 8192, R, C); const int Rb = Epi::PERM ? ((R & ~31) + perm32(R & 31)) : R;
        voffA[i] = (unsigned)(R * K + C) * 2u; voffB[i] = (unsigned)(Rb * K + C) * 2u; }
    const size_t kstep = (size_t)(BK * 2);
    const size_t hstep = (size_t)HALF * K * 2;
    const size_t tstep = 2 * hstep;
    const unsigned ldsw = (unsigned)wid * 1024u;
    const int aoff = lds_byte(wr * 64 + fr, fq * 8), boff = lds_byte(wc * 32 + fr, fq * 8);
#define PG8_SA(b, h) (((b) * 2 + (h)) * HTB)
#define PG8_SB(b, h) ((4 + (b) * 2 + (h)) * HTB)
#define PG8_STAGE(bufoff, gbase, voff) do { _Pragma("unroll") for (int _i = 0; _i < 2; ++_i) \
        __builtin_amdgcn_global_load_lds((const unsigned*)((const char*)(gbase) + (voff)[_i]), (PG8_LAS unsigned*)(lds + (bufoff) + ldsw + _i * 8192), 16, 0, 0); } while (0)
#define PG8_LDA(dst, b, h) do { _Pragma("unroll") for (int m = 0; m < 4; ++m) _Pragma("unroll") for (int k = 0; k < 2; ++k) dst[m][k] = *(const PG8_LAS bf16x8*)(lds + PG8_SA(b, h) + aoff + m * 2048 + k * 1024); } while (0)
#define PG8_LDB(dst, b, h) do { _Pragma("unroll") for (int n = 0; n < 2; ++n) _Pragma("unroll") for (int k = 0; k < 2; ++k) dst[n][k] = *(const PG8_LAS bf16x8*)(lds + PG8_SB(b, h) + boff + n * 2048 + k * 1024); } while (0)
#define PG8_MMA(ai, bj, At, Bt) do { __builtin_amdgcn_s_setprio(1); _Pragma("unroll") for (int m = 0; m < 4; ++m) _Pragma("unroll") for (int n = 0; n < 2; ++n) _Pragma("unroll") for (int k = 0; k < 2; ++k) \
        acc[ai][bj][m][n] = __builtin_amdgcn_mfma_f32_16x16x32_bf16(Bt[n][k], At[m][k], acc[ai][bj][m][n], 0, 0, 0); __builtin_amdgcn_s_setprio(0); } while (0)
#define PG8_WAIT_V(n) asm volatile("s_waitcnt vmcnt(" #n ")" ::: "memory")
#define PG8_WAIT_L(n) asm volatile("s_waitcnt lgkmcnt(" #n ")" ::: "memory")
#define PG8_BAR __builtin_amdgcn_s_barrier()
#define PG8_SCHED __builtin_amdgcn_sched_barrier(0)
    unsigned long long cur = S.nextp(0), nxt; int ui = 0;
    if (!cur) return;
    f32x4 acc[2][2][4][2];
#pragma unroll
    for (int a = 0; a < 2; ++a)
#pragma unroll
        for (int b = 0; b < 2; ++b)
#pragma unroll
            for (int m = 0; m < 4; ++m)
#pragma unroll
                for (int n = 0; n < 2; ++n) acc[a][b][m][n] = (f32x4){0.f, 0.f, 0.f, 0.f};
    bf16x8 At[4][2], B0[2][2], B1[2][2];
    const char* cA = (const char*)g.A + (size_t)UP_PM(cur) * tstep + (size_t)UP_KT0(cur) * kstep; const char* cB = (const char*)g.Bt + (size_t)UP_PN(cur) * tstep + (size_t)UP_KT0(cur) * kstep;
    if constexpr (SP2) {
        PG8_STAGE(PG8_SB(0, 0), cB, voffB); PG8_STAGE(PG8_SB(0, 1), cB + hstep, voffB); PG8_STAGE(PG8_SA(0, 0), cA, voffA); PG8_STAGE(PG8_SA(0, 1), cA + hstep, voffA);
        if (wr == 1) PG8_BAR;
        PG8_WAIT_V(2); PG8_BAR;
        PG8_STAGE(PG8_SB(1, 0), cB + kstep, voffB); PG8_STAGE(PG8_SA(1, 0), cA + kstep, voffA); PG8_STAGE(PG8_SB(1, 1), cB + hstep + kstep, voffB);
        PG8_WAIT_V(6); PG8_BAR;
    } else {
        PG8_STAGE(PG8_SB(0, 0), cB, voffB); PG8_STAGE(PG8_SA(0, 0), cA, voffA); PG8_STAGE(PG8_SB(0, 1), cB + hstep, voffB); PG8_STAGE(PG8_SA(0, 1), cA + hstep, voffA);
        if (wr == 1) PG8_BAR;
        PG8_WAIT_V(4); PG8_BAR;
        PG8_STAGE(PG8_SB(1, 0), cB + kstep, voffB); PG8_STAGE(PG8_SA(1, 0), cA + kstep, voffA); PG8_STAGE(PG8_SB(1, 1), cB + hstep + kstep, voffB);
        PG8_WAIT_V(6); PG8_BAR;
    }
    for (;;) {
        nxt = S.nextp(ui + 1); const bool has_next = (nxt != 0ull);
        const char* nA = has_next ? (const char*)g.A + (size_t)UP_PM(nxt) * tstep + (size_t)UP_KT0(nxt) * kstep : cA; const char* nB = has_next ? (const char*)g.Bt + (size_t)UP_PN(nxt) * tstep + (size_t)UP_KT0(nxt) * kstep : cB;
        const int nt = UP_NKT(cur);
        for (int t = 0; t < nt; t += 2) {
            const bool last = (t == nt - 2);
            const char* a1 = cA + (size_t)(t + 1) * kstep;
            const char* a2 = last ? nA : cA + (size_t)(t + 2) * kstep; const char* b2 = last ? nB : cB + (size_t)(t + 2) * kstep;
            const char* a3 = a2 + kstep; const char* b3 = b2 + kstep;
            if constexpr (SP2) {
            PG8_LDB(B0, 0, 0); PG8_LDB(B1, 0, 1); PG8_SCHED; PG8_LDA(At, 0, 0); PG8_STAGE(PG8_SA(1, 1), a1 + hstep, voffA);
            PG8_WAIT_V(8); PG8_WAIT_L(0); PG8_BAR; PG8_MMA(0, 0, At, B0); PG8_MMA(0, 1, At, B1); PG8_BAR; PG8_SCHED;
            PG8_LDA(At, 0, 1); PG8_STAGE(PG8_SB(0, 0), b2, voffB); PG8_STAGE(PG8_SB(0, 1), b2 + hstep, voffB); PG8_STAGE(PG8_SA(0, 0), a2, voffA);
            PG8_WAIT_V(8); PG8_WAIT_L(0); PG8_BAR; PG8_MMA(1, 0, At, B0); PG8_MMA(1, 1, At, B1); PG8_BAR; PG8_SCHED;
            PG8_LDB(B0, 1, 0); PG8_LDB(B1, 1, 1); PG8_SCHED; PG8_LDA(At, 1, 0); PG8_STAGE(PG8_SA(0, 1), a2 + hstep, voffA);
            PG8_WAIT_V(8); PG8_WAIT_L(0); PG8_BAR; PG8_MMA(0, 0, At, B0); PG8_MMA(0, 1, At, B1); PG8_BAR; PG8_SCHED;
            PG8_LDA(At, 1, 1); PG8_STAGE(PG8_SB(1, 0), b3, voffB); PG8_STAGE(PG8_SB(1, 1), b3 + hstep, voffB); PG8_STAGE(PG8_SA(1, 0), a3, voffA);
            PG8_WAIT_V(8); PG8_WAIT_L(0); PG8_BAR; PG8_MMA(1, 0, At, B0); PG8_MMA(1, 1, At, B1); PG8_BAR; PG8_SCHED;
            } else {
            PG8_LDB(B0, 0, 0); PG8_SCHED; PG8_LDA(At, 0, 0); PG8_STAGE(PG8_SA(1, 1), a1 + hstep, voffA);
            PG8_WAIT_L(8); PG8_BAR; PG8_WAIT_L(0); PG8_MMA(0, 0, At, B0); PG8_BAR; PG8_SCHED;
            PG8_LDB(B1, 0, 1); PG8_STAGE(PG8_SB(0, 0), b2, voffB);
            PG8_BAR; PG8_WAIT_L(0); PG8_MMA(0, 1, At, B1); PG8_BAR;
            PG8_LDA(At, 0, 1); PG8_STAGE(PG8_SA(0, 0), a2, voffA);
            PG8_BAR; PG8_WAIT_L(0); PG8_MMA(1, 0, At, B0); PG8_BAR; PG8_SCHED;
            PG8_STAGE(PG8_SB(0, 1), b2 + hstep, voffB);
            PG8_WAIT_V(6); PG8_BAR; PG8_MMA(1, 1, At, B1); PG8_BAR;
            PG8_LDB(B0, 1, 0); PG8_SCHED; PG8_LDA(At, 1, 0); PG8_STAGE(PG8_SA(0, 1), a2 + hstep, voffA);
            PG8_WAIT_L(8); PG8_BAR; PG8_WAIT_L(0); PG8_MMA(0, 0, At, B0); PG8_BAR; PG8_SCHED;
            PG8_LDB(B1, 1, 1); PG8_STAGE(PG8_SB(1, 0), b3, voffB);
            PG8_BAR; PG8_WAIT_L(0); PG8_MMA(0, 1, At, B1); PG8_BAR;
            PG8_LDA(At, 1, 1); PG8_STAGE(PG8_SA(1, 0), a3, voffA);
            PG8_BAR; PG8_WAIT_L(0); PG8_MMA(1, 0, At, B0); PG8_BAR; PG8_SCHED;
            PG8_STAGE(PG8_SB(1, 1), b3 + hstep, voffB);
            PG8_WAIT_V(6); PG8_BAR; PG8_MMA(1, 1, At, B1); PG8_BAR;
            }
        }
        if constexpr (ALIGN_EPI) { if (wr == 0) PG8_BAR; }
        { Unit cu; cu.pm = UP_PM(cur); cu.pn = UP_PN(cur); cu.kt0 = UP_KT0(cur); cu.nkt = UP_NKT(cur); cu.split = UP_SPLIT(cur); E(acc, cu, wr, wc, fr, fq); }
        if (!has_next) break;
#pragma unroll
        for (int a = 0; a < 2; ++a)
#pragma unroll
            for (int b = 0; b < 2; ++b)
#pragma unroll
                for (int m = 0; m < 4; ++m)
#pragma unroll
                    for (int n = 0; n < 2; ++n) acc[a][b][m][n] = (f32x4){0.f, 0.f, 0.f, 0.f};
        cur = nxt; cA = nA; cB = nB; ++ui;
        if constexpr (ALIGN_EPI) { if (wr == 1) PG8_BAR; }
    }
    PG8_WAIT_V(0);
    if constexpr (!ALIGN_EPI) { if (wr == 0) PG8_BAR; }
    PG8_BAR;
#undef PG8_SA
#undef PG8_SB
#undef PG8_STAGE
#undef PG8_LDA
#undef PG8_LDB
#undef PG8_MMA
#undef PG8_WAIT_V
#undef PG8_WAIT_L
#undef PG8_BAR
#undef PG8_SCHED
}
}

__device__ __forceinline__ void p0_transpose_item(const float* W, int K, int N, bf16_t* WT, int k0, int n0, int drow0, LAS float* scr, int lane, const float* kscale = nullptr) {
    const float ks = kscale ? kscale[k0 + lane] : 1.f;
#pragma unroll 8
    for (int i = 0; i < 32; ++i) { const int kk = 2 * i + (lane >> 5); scr[kk * 33 + (lane & 31)] = W[(size_t)(k0 + kk) * N + n0 + (lane & 31)] * __shfl(ks, kk); }
    asm volatile("s_waitcnt lgkmcnt(0)" ::: "memory");
    const int c = lane & 7;
#pragma unroll
    for (int j = 0; j < 4; ++j) { const int n = (lane >> 3) + 8 * j; const LAS float* s = scr + (8 * c) * 33 + n;
        u32x4 o; o.x = pk2(s[0 * 33], s[1 * 33]); o.y = pk2(s[2 * 33], s[3 * 33]); o.z = pk2(s[4 * 33], s[5 * 33]); o.w = pk2(s[6 * 33], s[7 * 33]);
        *(u32x4*)(WT + (size_t)(drow0 + n) * K + k0 + 8 * c) = o; }
    asm volatile("s_waitcnt lgkmcnt(0)" ::: "memory");
}
__device__ __forceinline__ int win_dest_row(int n0) {
    if (n0 < 5120) return n0;
    if (n0 < 5152) return CDT + (n0 - 5120);
    if (n0 < 7200) { const int c = n0 - 5152; return CCF + 256 * (c >> 7) + (c & 127); }
    { const int c = n0 - 7200; return CCF + 256 * (c >> 7) + 128 + (c & 127); }
}
__device__ __forceinline__ void rms_row_to_bf16(const float* xrow, const float* w, bf16_t* orow, int lane) {
    f32x4 v[8], ww[8]; float s = 0.f;
#pragma unroll
    for (int j = 0; j < 8; ++j) { v[j] = *(const f32x4*)(xrow + (j * 64 + lane) * 4); ww[j] = *(const f32x4*)(w + (j * 64 + lane) * 4); }
#pragma unroll
    for (int j = 0; j < 8; ++j) s += (v[j].x * v[j].x + v[j].y * v[j].y) + (v[j].z * v[j].z + v[j].w * v[j].w);
    const float r = rsqrtf(wave_sum(s) * (1.f / DM) + EPS);
#pragma unroll
    for (int j = 0; j < 8; ++j) {
        u32x2 o; o.x = pk2(v[j].x * r * ww[j].x, v[j].y * r * ww[j].y); o.y = pk2(v[j].z * r * ww[j].z, v[j].w * r * ww[j].w);
        *(u32x2*)(orow + (j * 64 + lane) * 4) = o; }
}

template <int NT, bool SAMPLE>
__device__ __forceinline__ void ssdconv_item(const bf16_t* PROJ, int row0, bool has_hist, const float* st, int cgi, const float* w, const float* bias, bf16_t* XBC, float* state_out) {
    const int c0 = cgi * 8;
    float wv[4][8], bv[8], h0[8], h1[8], h2[8];
#pragma unroll
    for (int i = 0; i < 4; ++i) { const f32x4 a = *(const f32x4*)(w + i * XBCW + c0), b = *(const f32x4*)(w + i * XBCW + c0 + 4);
        wv[i][0] = a.x; wv[i][1] = a.y; wv[i][2] = a.z; wv[i][3] = a.w; wv[i][4] = b.x; wv[i][5] = b.y; wv[i][6] = b.z; wv[i][7] = b.w; }
    { const f32x4 a = *(const f32x4*)(bias + c0), b = *(const f32x4*)(bias + c0 + 4);
      bv[0] = a.x; bv[1] = a.y; bv[2] = a.z; bv[3] = a.w; bv[4] = b.x; bv[5] = b.y; bv[6] = b.z; bv[7] = b.w; }
    if (SAMPLE) {
#pragma unroll
        for (int e = 0; e < 8; ++e) { h0[e] = st[0 * XBCW + c0 + e]; h1[e] = st[1 * XBCW + c0 + e]; h2[e] = st[2 * XBCW + c0 + e]; }
    } else if (has_hist) {
        unpack8(*(const u32x4*)(PROJ + (size_t)(row0 - 3) * NPROJ + CXBC + c0), h0);
        unpack8(*(const u32x4*)(PROJ + (size_t)(row0 - 2) * NPROJ + CXBC + c0), h1);
        unpack8(*(const u32x4*)(PROJ + (size_t)(row0 - 1) * NPROJ + CXBC + c0), h2);
    } else {
#pragma unroll
        for (int e = 0; e < 8; ++e) { h0[e] = 0.f; h1[e] = 0.f; h2[e] = 0.f; }
    }
    u32x4 rows[NT];
#pragma unroll
    for (int t = 0; t < NT; ++t) rows[t] = *(const u32x4*)(PROJ + (size_t)(row0 + t) * NPROJ + CXBC + c0);
#pragma unroll
    for (int t = 0; t < NT; ++t) {
        float cur[8], o[8];
        unpack8(rows[t], cur);
#pragma unroll
        for (int e = 0; e < 8; ++e) { float v = h0[e] * wv[0][e] + h1[e] * wv[1][e] + h2[e] * wv[2][e] + cur[e] * wv[3][e] + bv[e]; o[e] = siluf_(v); h0[e] = h1[e]; h1[e] = h2[e]; h2[e] = cur[e]; }
        *(u32x4*)(XBC + (size_t)(row0 + t) * XBCW + c0) = pack8(o);
    }
    if (state_out) {
        *(f32x4*)(state_out + 0 * XBCW + c0) = (f32x4){h0[0], h0[1], h0[2], h0[3]}; *(f32x4*)(state_out + 0 * XBCW + c0 + 4) = (f32x4){h0[4], h0[5], h0[6], h0[7]};
        *(f32x4*)(state_out + 1 * XBCW + c0) = (f32x4){h1[0], h1[1], h1[2], h1[3]}; *(f32x4*)(state_out + 1 * XBCW + c0 + 4) = (f32x4){h1[4], h1[5], h1[6], h1[7]};
        *(f32x4*)(state_out + 2 * XBCW + c0) = (f32x4){h2[0], h2[1], h2[2], h2[3]}; *(f32x4*)(state_out + 2 * XBCW + c0 + 4) = (f32x4){h2[4], h2[5], h2[6], h2[7]};
    }
}

__device__ __forceinline__ void ssdconv_prompt_item(const bf16_t* PROJ, int row0, bool has_hist, int cgi, const float* w, const float* bias, bf16_t* XBC, float* state_out,
                                                    const float* DT, const float* CS, bf16_t* XT1, bf16_t* XT2, bf16_t* BT) {
    const int c0 = cgi * 8;
    float wv[4][8], bv[8], h0[8], h1[8], h2[8];
#pragma unroll
    for (int i = 0; i < 4; ++i) { const f32x4 a = *(const f32x4*)(w + i * XBCW + c0), b = *(const f32x4*)(w + i * XBCW + c0 + 4);
        wv[i][0] = a.x; wv[i][1] = a.y; wv[i][2] = a.z; wv[i][3] = a.w; wv[i][4] = b.x; wv[i][5] = b.y; wv[i][6] = b.z; wv[i][7] = b.w; }
    { const f32x4 a = *(const f32x4*)(bias + c0), b = *(const f32x4*)(bias + c0 + 4);
      bv[0] = a.x; bv[1] = a.y; bv[2] = a.z; bv[3] = a.w; bv[4] = b.x; bv[5] = b.y; bv[6] = b.z; bv[7] = b.w; }
    u32x4 rows[8], hr[3];
#pragma unroll
    for (int t = 0; t < 8; ++t) rows[t] = *(const u32x4*)(PROJ + (size_t)(row0 + t) * NPROJ + CXBC + c0);
    if (has_hist) {
#pragma unroll
        for (int i = 0; i < 3; ++i) hr[i] = *(const u32x4*)(PROJ + (size_t)(row0 - 3 + i) * NPROJ + CXBC + c0);
    } else {
#pragma unroll
        for (int i = 0; i < 3; ++i) hr[i] = (u32x4){0u, 0u, 0u, 0u};
    }
    const bool isx = cgi < 256, isb = (cgi >= 256 && cgi < 320);
    float f1[8], f2[8];
    if (isx) { const int h = cgi >> 3; const float csl = CS[(size_t)((row0 & ~127) + 127) * NH + h];
#pragma unroll
        for (int t = 0; t < 8; ++t) { const float d = DT[(size_t)(row0 + t) * NH + h]; const float c = CS[(size_t)(row0 + t) * NH + h]; f1[t] = d; f2[t] = d * __expf(csl - c); } }
    unpack8(hr[0], h0); unpack8(hr[1], h1); unpack8(hr[2], h2);
    float o[8][8];
#pragma unroll
    for (int t = 0; t < 8; ++t) {
        float cur[8];
        unpack8(rows[t], cur);
#pragma unroll
        for (int e = 0; e < 8; ++e) { float v = h0[e] * wv[0][e] + h1[e] * wv[1][e] + h2[e] * wv[2][e] + cur[e] * wv[3][e] + bv[e]; o[t][e] = siluf_(v); h0[e] = h1[e]; h1[e] = h2[e]; h2[e] = cur[e]; }
        *(u32x4*)(XBC + (size_t)(row0 + t) * XBCW + c0) = pack8(o[t]);
    }
    if (state_out) {
        *(f32x4*)(state_out + 0 * XBCW + c0) = (f32x4){h0[0], h0[1], h0[2], h0[3]}; *(f32x4*)(state_out + 0 * XBCW + c0 + 4) = (f32x4){h0[4], h0[5], h0[6], h0[7]};
        *(f32x4*)(state_out + 1 * XBCW + c0) = (f32x4){h1[0], h1[1], h1[2], h1[3]}; *(f32x4*)(state_out + 1 * XBCW + c0 + 4) = (f32x4){h1[4], h1[5], h1[6], h1[7]};
        *(f32x4*)(state_out + 2 * XBCW + c0) = (f32x4){h2[0], h2[1], h2[2], h2[3]}; *(f32x4*)(state_out + 2 * XBCW + c0 + 4) = (f32x4){h2[4], h2[5], h2[6], h2[7]};
    }
    const int chunk = row0 >> 7, jb = row0 & 127;
    if (isx) {
#pragma unroll
        for (int e = 0; e < 8; ++e) { u32x4 a, b2;
            a.x = pk2(o[0][e] * f1[0], o[1][e] * f1[1]); a.y = pk2(o[2][e] * f1[2], o[3][e] * f1[3]); a.z = pk2(o[4][e] * f1[4], o[5][e] * f1[5]); a.w = pk2(o[6][e] * f1[6], o[7][e] * f1[7]);
            b2.x = pk2(o[0][e] * f2[0], o[1][e] * f2[1]); b2.y = pk2(o[2][e] * f2[2], o[3][e] * f2[3]); b2.z = pk2(o[4][e] * f2[4], o[5][e] * f2[5]); b2.w = pk2(o[6][e] * f2[6], o[7][e] * f2[7]);
            const size_t off = ((size_t)chunk * DM + c0 + e) * 128 + jb;
            *(u32x4*)(XT1 + off) = a; *(u32x4*)(XT2 + off) = b2; }
    } else if (isb) {
#pragma unroll
        for (int e = 0; e < 8; ++e) { u32x4 a;
            a.x = pk2(o[0][e], o[1][e]); a.y = pk2(o[2][e], o[3][e]); a.z = pk2(o[4][e], o[5][e]); a.w = pk2(o[6][e], o[7][e]);
            *(u32x4*)(BT + ((size_t)chunk * 512 + (c0 - 2048) + e) * 128 + jb) = a; }
    }
}

__device__ __forceinline__ void cf_sample_item(const bf16_t* PROJ, int s, int c, const float* st, const float* cw, const float* cb, bf16_t* CONVOUT, float* state_out) {
    f32x2 xp[34], w[31];
    unsigned uv[4];
#pragma unroll
    for (int j = 0; j < 30; ++j) xp[j] = *(const f32x2*)(st + j * DM + c);
#pragma unroll
    for (int t = 0; t < 4; ++t) uv[t] = *(const unsigned*)(PROJ + (size_t)(MP + 4 * s + t) * NPROJ + CUCF + c);
#pragma unroll
    for (int i = 0; i < 31; ++i) w[i] = *(const f32x2*)(cw + i * DM + c);
    const f32x2 bias = *(const f32x2*)(cb + c);
#pragma unroll
    for (int t = 0; t < 4; ++t) { xp[30 + t].x = bf2f(uv[t] & 0xffffu); xp[30 + t].y = bf2f(uv[t] >> 16); }
#pragma unroll
    for (int t = 0; t < 4; ++t) { f32x2 acc = bias;
#pragma unroll
        for (int i = 0; i < 31; ++i) acc += xp[t + i] * w[i];
        *(unsigned*)(CONVOUT + (size_t)(MP + 4 * s + t) * DM + c) = pk2(acc.x, acc.y); }
#pragma unroll
    for (int i = 0; i < 30; ++i) *(f32x2*)(state_out + (size_t)i * DM + c) = xp[4 + i];
}

template <int J> struct CfLds {
    static __device__ __forceinline__ void run(float (&acc)[32], const float (&w)[31], const LAS float* us) {
        const float v = us[J * 512];
        constexpr int TLO = (J - 30 > 0) ? J - 30 : 0, THI = (J < 31) ? J : 31;
#pragma unroll
        for (int t = TLO; t <= THI; ++t) acc[t] += v * w[J - t];
        if constexpr (J + 1 < 62) CfLds<J + 1>::run(acc, w, us);
    }
};
__device__ __forceinline__ void cf_prompt_items(LAS unsigned char* lds, const bf16_t* PROJ, int it0, int itstride, int nitems, const float* cw, const float* cb, bf16_t* CONVOUT, float* pcfc) {
    const int tid = ltid(), w = __builtin_amdgcn_readfirstlane(tid >> 6), lane = tid & 63;
    LAS float* Us = (LAS float*)lds;
    if (it0 >= nitems) return;
    u32x4 av[8];
#define CF_LOAD(itx) do { const int r0_ = ((itx) >> 2) * 32, t0_ = r0_ % SEQ, cc_ = ((itx) & 3) * 512; \
        _Pragma("unroll") for (int i = 0; i < 8; ++i) { const int j = w + 8 * i, tt = j - 30; \
            if (j < 62 && t0_ + tt >= 0) av[i] = *(const u32x4*)(PROJ + (size_t)(r0_ + tt) * NPROJ + CUCF + cc_ + lane * 8); \
            else av[i] = (u32x4){0u, 0u, 0u, 0u}; } } while (0)
    CF_LOAD(it0);
    for (int it = it0; it < nitems; it += itstride) {
        const int row0 = (it >> 2) * 32, t0 = row0 % SEQ, b = row0 / SEQ, c0 = (it & 3) * 512;
        float* state_out = (t0 == SEQ - 32) ? pcfc + (size_t)b * 30 * DM : nullptr;
        float wv[31];
#pragma unroll
        for (int i = 0; i < 31; ++i) wv[i] = cw[i * DM + c0 + tid];
        const float bias = cb[c0 + tid];
#pragma unroll
        for (int i = 0; i < 8; ++i) { const int j = w + 8 * i;
            if (j < 62) { float a[8]; unpack8(av[i], a);
                const f32x4 u0 = (f32x4){a[0], a[1], a[2], a[3]}, u1 = (f32x4){a[4], a[5], a[6], a[7]};
                *(LAS f32x4*)(Us + j * 512 + lane * 8) = u0; *(LAS f32x4*)(Us + j * 512 + lane * 8 + 4) = u1;
                if (state_out && j >= 32) { float* sp = state_out + (size_t)(j - 32) * DM + c0 + lane * 8; *(f32x4*)sp = u0; *(f32x4*)(sp + 4) = u1; } } }
        LDS_BARRIER();
        if (it + itstride < nitems) CF_LOAD(it + itstride);
        float acc[32];
#pragma unroll
        for (int t = 0; t < 32; ++t) acc[t] = bias;
        CfLds<0>::run(acc, wv, Us + tid);
#pragma unroll
        for (int t = 0; t < 32; ++t) CONVOUT[(size_t)(row0 + t) * DM + c0 + tid] = (bf16_t)f2bf(acc[t]);
        LDS_BARRIER();
    }
#undef CF_LOAD
}

constexpr int LDP = 136;
constexpr int Q_B = 0, Q_BT = 34816, Q_X1 = 69632, Q_X2 = 87040, Q_H = 104448, Q_CS = 121856;

#define MFMA16(a, b, c) __builtin_amdgcn_mfma_f32_16x16x32_bf16((a), (b), (c), 0, 0, 0)

__device__ __forceinline__ void ssd_prompt(LAS unsigned char* lds, int b, int h, const bf16_t* XBC, const float* CS, const bf16_t* XT1, const bf16_t* XT2, const bf16_t* BT, bf16_t* MIX, float* p_ssm) {
    const int tid = ltid(), w = __builtin_amdgcn_readfirstlane(tid >> 6), lane = tid & 63, fr = lane & 15, fq = lane >> 4;
    const int g = h >> 3;
    const int rt = (w < 4) ? w : 11 - w;
    LAS bf16_t* Bs = (LAS bf16_t*)(lds + Q_B); LAS bf16_t* BTs = (LAS bf16_t*)(lds + Q_BT);
    LAS bf16_t* X1s = (LAS bf16_t*)(lds + Q_X1); LAS bf16_t* X2s = (LAS bf16_t*)(lds + Q_X2); LAS bf16_t* Hs = (LAS bf16_t*)(lds + Q_H);
    LAS float* css_all = (LAS float*)(lds + Q_CS);
    for (int i = tid; i < 64 * LDP / 2; i += 512) ((LAS unsigned*)Hs)[i] = 0u;
#pragma unroll
    for (int i = 0; i < 4; ++i) { const int j = tid + 512 * i; css_all[j] = CS[(size_t)(b * SEQ + j) * NH + h]; }
    f32x4 hacc[4];
#pragma unroll
    for (int pt = 0; pt < 4; ++pt) hacc[pt] = (f32x4){0.f, 0.f, 0.f, 0.f};
    u32x4 Bv[4], BTv[4], X1v[2], X2v[2]; bf16x8 afn[4];
#define SSD_PREFETCH(cidx) do { const int rb_ = b * SEQ + (cidx) * 128; const size_t ci_ = (size_t)(b * (SEQ / 128) + (cidx)); \
        _Pragma("unroll") for (int i = 0; i < 4; ++i) { const int idx = tid + 512 * i, rr = idx >> 4, ch = idx & 15; \
            Bv[i] = *(const u32x4*)(XBC + (size_t)(rb_ + rr) * XBCW + 2048 + g * 128 + ch * 8); BTv[i] = *(const u32x4*)(BT + (ci_ * 512 + g * 128 + rr) * 128 + ch * 8); } \
        _Pragma("unroll") for (int i = 0; i < 2; ++i) { const int idx = tid + 512 * i, rr = idx >> 4, ch = idx & 15; \
            X1v[i] = *(const u32x4*)(XT1 + (ci_ * DM + h * 64 + rr) * 128 + ch * 8); X2v[i] = *(const u32x4*)(XT2 + (ci_ * DM + h * 64 + rr) * 128 + ch * 8); } \
        _Pragma("unroll") for (int ks = 0; ks < 4; ++ks) afn[ks] = *(const bf16x8*)(XBC + (size_t)(rb_ + 16 * rt + fr) * XBCW + 2560 + g * 128 + ks * 32 + fq * 8); } while (0)
    SSD_PREFETCH(0);
    LDS_BARRIER();
    for (int c = 0; c < SEQ / 128; ++c) {
        const int rowbase = b * SEQ + c * 128;
        LAS float* css = css_all + c * 128;
        const float cs_last = css[127];
#pragma unroll
        for (int i = 0; i < 4; ++i) { const int idx = tid + 512 * i, rr = idx >> 4, ch = idx & 15;
            *(LAS u32x4*)(Bs + rr * LDP + ch * 8) = Bv[i]; *(LAS u32x4*)(BTs + rr * LDP + ch * 8) = BTv[i]; }
#pragma unroll
        for (int i = 0; i < 2; ++i) { const int idx = tid + 512 * i, rr = idx >> 4, ch = idx & 15;
            *(LAS u32x4*)(X1s + rr * LDP + ch * 8) = X1v[i]; *(LAS u32x4*)(X2s + rr * LDP + ch * 8) = X2v[i]; }
        bf16x8 afr[4];
#pragma unroll
        for (int ks = 0; ks < 4; ++ks) afr[ks] = afn[ks];
        if (c + 1 < SEQ / 128) SSD_PREFETCH(c + 1);
        LDS_BARRIER();
        u32x2 cbm[8];
        const float csi = css[16 * rt + fr];
#pragma unroll
        for (int jt = 0; jt < 8; ++jt) {
            cbm[jt] = (u32x2){0u, 0u};
            if (jt <= rt) {
                f32x4 a4 = (f32x4){0.f, 0.f, 0.f, 0.f};
#pragma unroll
                for (int ks = 0; ks < 4; ++ks) { const bf16x8 bb = *(const LAS bf16x8*)(Bs + (16 * jt + fr) * LDP + ks * 32 + fq * 8); a4 = MFMA16(bb, afr[ks], a4); }
                const f32x4 csj = *(const LAS f32x4*)(css + 16 * jt + 4 * fq);
                const int i = 16 * rt + fr, j0 = 16 * jt + 4 * fq;
#pragma unroll
                for (int r = 0; r < 4; ++r) a4[r] = (j0 + r <= i) ? a4[r] * __expf(csi - csj[r]) : 0.f;
                cbm[jt].x = pk2(a4[0], a4[1]); cbm[jt].y = pk2(a4[2], a4[3]);
            }
        }
        LDS_BARRIER();
        LAS bf16_t* Ms = Bs;
#pragma unroll
        for (int jt = 0; jt < 8; ++jt) if (jt <= (rt | 1)) {
            *(LAS u32x2*)(Ms + (16 * rt + fr) * LDP + 16 * jt + 4 * fq) = cbm[jt];
        }
        asm volatile("s_waitcnt lgkmcnt(0)" ::: "memory");
        f32x4 yacc[4];
#pragma unroll
        for (int pt = 0; pt < 4; ++pt) yacc[pt] = (f32x4){0.f, 0.f, 0.f, 0.f};
#pragma unroll
        for (int ks = 0; ks < 4; ++ks)
#pragma unroll
            for (int pt = 0; pt < 4; ++pt) { const bf16x8 bb = *(const LAS bf16x8*)(Hs + (16 * pt + fr) * LDP + ks * 32 + fq * 8); yacc[pt] = MFMA16(bb, afr[ks], yacc[pt]); }
        { const float e = __expf(csi);
#pragma unroll
          for (int pt = 0; pt < 4; ++pt) yacc[pt] *= e; }
#pragma unroll
        for (int ks = 0; ks < 4; ++ks) if (ks <= (rt >> 1)) {
            const bf16x8 am = *(const LAS bf16x8*)(Ms + (16 * rt + fr) * LDP + ks * 32 + fq * 8);
#pragma unroll
            for (int pt = 0; pt < 4; ++pt) { const bf16x8 bb = *(const LAS bf16x8*)(X1s + (16 * pt + fr) * LDP + ks * 32 + fq * 8); yacc[pt] = MFMA16(bb, am, yacc[pt]); }
        }
#pragma unroll
        for (int pt = 0; pt < 4; ++pt) { u32x2 pk; pk.x = pk2(yacc[pt][0], yacc[pt][1]); pk.y = pk2(yacc[pt][2], yacc[pt][3]);
            *(u32x2*)(MIX + (size_t)(rowbase + 16 * rt + fr) * DMIX + h * 64 + 16 * pt + 4 * fq) = pk; }
        { const float dl = __expf(cs_last);
#pragma unroll
          for (int pt = 0; pt < 4; ++pt) hacc[pt] *= dl; }
#pragma unroll
        for (int ks = 0; ks < 4; ++ks) { const bf16x8 bb = *(const LAS bf16x8*)(BTs + (16 * w + fr) * LDP + ks * 32 + fq * 8);
#pragma unroll
            for (int pt = 0; pt < 4; ++pt) { const bf16x8 aa = *(const LAS bf16x8*)(X2s + (16 * pt + fr) * LDP + ks * 32 + fq * 8); hacc[pt] = MFMA16(bb, aa, hacc[pt]); } }
        LDS_BARRIER();
#pragma unroll
        for (int pt = 0; pt < 4; ++pt) { u32x2 pk; pk.x = pk2(hacc[pt][0], hacc[pt][1]); pk.y = pk2(hacc[pt][2], hacc[pt][3]);
            *(LAS u32x2*)(Hs + (16 * pt + fr) * LDP + 16 * w + 4 * fq) = pk; }
    }
#undef SSD_PREFETCH
#pragma unroll
    for (int pt = 0; pt < 4; ++pt) *(f32x4*)(p_ssm + ((size_t)(b * NH + h) * HP + 16 * pt + fr) * NS + 16 * w + 4 * fq) = hacc[pt];
    LDS_BARRIER();
}

__device__ __forceinline__ void ssd_sample_items(LAS unsigned char* lds, int it0, int itstride, int nitems, const bf16_t* XBC, const float* DT, const float* a_log,
                                                 const float* state_in, bf16_t* MIX, float* s_ssm) {
    const int tid = ltid(), w = __builtin_amdgcn_readfirstlane(tid >> 6), lane = tid & 63, nl = lane & 31, half = lane >> 5;
    LAS float* Xs = (LAS float*)lds;
    if (it0 >= nitems) return;
    f32x4 nx[16];
    { const int b = it0 >> 2, g = it0 & 3, h = g * 8 + w; const float* sp = state_in + (size_t)(b * NH + h) * HP * NS;
#pragma unroll
      for (int k = 0; k < 16; ++k) nx[k] = *(const f32x4*)(sp + k * 256 + lane * 4); }
    for (int it = it0; it < nitems; it += itstride) {
        const int b = it >> 2, g = it & 3, h = g * 8 + w;
        u32x2 Bp[4], Cp[4]; float dtv[4];
#pragma unroll
        for (int t = 0; t < 4; ++t) { const size_t row = (size_t)(MP + 4 * b + t);
            Xs[t * 512 + tid] = bf2f(XBC[row * XBCW + g * 512 + tid]);
            Bp[t] = *(const u32x2*)(XBC + row * XBCW + 2048 + g * 128 + 4 * nl); Cp[t] = *(const u32x2*)(XBC + row * XBCW + 2560 + g * 128 + 4 * nl);
            dtv[t] = DT[row * NH + h]; }
        const float A = -__expf(a_log[h]);
        LDS_BARRIER();
#pragma unroll
        for (int hh = 0; hh < 2; ++hh) {
            f32x4 st[16];
#pragma unroll
            for (int k = 0; k < 16; ++k) st[k] = nx[k];
            {
                const int itn = it + itstride;
                if (hh == 0) { const float* sp = state_in + (size_t)(b * NH + h) * HP * NS + 4096;
#pragma unroll
                    for (int k = 0; k < 16; ++k) nx[k] = *(const f32x4*)(sp + k * 256 + lane * 4); }
                else if (itn < nitems) { const int bn = itn >> 2, gn = itn & 3; const float* sp = state_in + (size_t)(bn * NH + gn * 8 + w) * HP * NS;
#pragma unroll
                    for (int k = 0; k < 16; ++k) nx[k] = *(const f32x4*)(sp + k * 256 + lane * 4); }
            }
            float yv[4];
#pragma unroll
            for (int t = 0; t < 4; ++t) {
                const float dt = dtv[t]; const float da = __expf(dt * A);
                const f32x4 Bt = (f32x4){bf2f(Bp[t].x & 0xffffu), bf2f(Bp[t].x >> 16), bf2f(Bp[t].y & 0xffffu), bf2f(Bp[t].y >> 16)} * dt;
                const f32x4 Ct = (f32x4){bf2f(Cp[t].x & 0xffffu), bf2f(Cp[t].x >> 16), bf2f(Cp[t].y & 0xffffu), bf2f(Cp[t].y >> 16)};
                float part[8];
                { const bool up8 = (nl & 8) != 0;
#pragma unroll
                  for (int i = 0; i < 8; ++i) {
                    const float x0 = Xs[t * 512 + w * 64 + 32 * hh + 2 * i + half], x1 = Xs[t * 512 + w * 64 + 32 * hh + 2 * (i + 8) + half];
                    st[i] = st[i] * da + Bt * x0; st[i + 8] = st[i + 8] * da + Bt * x1;
                    const f32x4 q0 = Ct * st[i], q1 = Ct * st[i + 8];
                    const float p0 = (q0.x + q0.y) + (q0.z + q0.w), p1 = (q1.x + q1.y) + (q1.z + q1.w);
                    const float send = up8 ? p0 : p1, keep = up8 ? p1 : p0; part[i] = keep + __shfl_xor(send, 8); } }
#define BFLY(o) do { const bool up = (nl & (o)) != 0; _Pragma("unroll") for (int i = 0; i < (o); ++i) { \
                    const float send = up ? part[i] : part[i + (o)]; const float keep = up ? part[i + (o)] : part[i]; part[i] = keep + __shfl_xor(send, (o)); } } while (0)
                BFLY(4); BFLY(2); BFLY(1);
#undef BFLY
                yv[t] = part[0] + __shfl_xor(part[0], 16);
            }
            const int pout = 32 * hh + 2 * (nl & 15) + half;
            if ((nl & 16) == 0) {
#pragma unroll
                for (int t = 0; t < 4; ++t) MIX[(size_t)(MP + 4 * b + t) * DMIX + h * 64 + pout] = (bf16_t)f2bf(yv[t]);
            }
            float* op = s_ssm + (size_t)(b * NH + h) * HP * NS + hh * 4096;
#pragma unroll
            for (int k = 0; k < 16; ++k) *(f32x4*)(op + k * 256 + lane * 4) = st[k];
        }
        LDS_BARRIER();
    }
}

__device__ __forceinline__ void mix_finalize_ssd(size_t row, bf16_t* MIX, const bf16_t* XBC, const bf16_t* PROJ, const float* d_skip, const float* ssd_norm_w, int lane, bf16_t* ssd_dst) {
    bf16_t* mp = MIX + row * DMIX;
    {
        u32x4 yv[4], xv[4], zv[4]; float dsk[4];
#pragma unroll
        for (int k = 0; k < 4; ++k) { const int c = (k * 64 + lane) * 8;
            yv[k] = *(const u32x4*)(mp + c); xv[k] = *(const u32x4*)(XBC + row * XBCW + c); zv[k] = *(const u32x4*)(PROJ + row * NPROJ + CZ + c);
            dsk[k] = d_skip[c >> 6]; }
        float s = 0.f;
#pragma unroll
        for (int k = 0; k < 4; ++k) { float f[8], xf[8], zf[8]; unpack8(yv[k], f); unpack8(xv[k], xf); unpack8(zv[k], zf);
#pragma unroll
            for (int e = 0; e < 8; ++e) { f[e] = (f[e] + dsk[k] * xf[e]) * siluf_(zf[e]); s += f[e] * f[e]; }
            yv[k] = pack8(f); }
        const float r = rsqrtf(wave_sum(s) * (1.f / DM) + EPS);
#pragma unroll 1
        for (int k = 0; k < 4; ++k) { const int c = (k * 64 + lane) * 8;
            const f32x4 w0 = *(const f32x4*)(ssd_norm_w + c), w1 = *(const f32x4*)(ssd_norm_w + c + 4);
            const u32x4 yk = (k == 0) ? yv[0] : (k == 1) ? yv[1] : (k == 2) ? yv[2] : yv[3];
            float f[8]; unpack8(yk, f);
            float o[8]; o[0] = f[0] * r * w0.x; o[1] = f[1] * r * w0.y; o[2] = f[2] * r * w0.z; o[3] = f[3] * r * w0.w;
            o[4] = f[4] * r * w1.x; o[5] = f[5] * r * w1.y; o[6] = f[6] * r * w1.z; o[7] = f[7] * r * w1.w;
            *(u32x4*)(ssd_dst + c) = pack8(o); }
    }
}
__device__ __forceinline__ void mix_finalize_conformer(size_t row, bf16_t* MIX, const bf16_t* CONVOUT, const float* ln_w, const float* ln_b, int lane) {
    bf16_t* mp = MIX + row * DMIX;
    {
        const bf16_t* cp = CONVOUT + row * DM;
        f32x4 v[8], ww[8], bb[8];
#pragma unroll
        for (int k = 0; k < 8; ++k) { const u32x2 cv = *(const u32x2*)(cp + (k * 64 + lane) * 4); v[k] = (f32x4){bf2f(cv.x & 0xffffu), bf2f(cv.x >> 16), bf2f(cv.y & 0xffffu), bf2f(cv.y >> 16)};
            ww[k] = *(const f32x4*)(ln_w + (k * 64 + lane) * 4); bb[k] = *(const f32x4*)(ln_b + (k * 64 + lane) * 4); }
        float s = 0.f;
#pragma unroll
        for (int k = 0; k < 8; ++k) s += (v[k].x + v[k].y) + (v[k].z + v[k].w);
        const float mean = wave_sum(s) * (1.f / DM); float q = 0.f;
#pragma unroll
        for (int k = 0; k < 8; ++k) { v[k] = v[k] - mean; q += (v[k].x * v[k].x + v[k].y * v[k].y) + (v[k].z * v[k].z + v[k].w * v[k].w); }
        const float rstd = rsqrtf(wave_sum(q) * (1.f / DM) + EPS);
#pragma unroll
        for (int k = 0; k < 8; ++k) {
            const f32x4 o = v[k] * rstd * ww[k] + bb[k];
            u32x2 pk; pk.x = pk2(siluf_(o.x), siluf_(o.y)); pk.y = pk2(siluf_(o.z), siluf_(o.w));
            *(u32x2*)(mp + DM + (k * 64 + lane) * 4) = pk; }
    }
}

template <int NT, bool SAMPLE>
__device__ __forceinline__ void ffn_item(const bf16_t* U, int row0, bool has_hist, const float* st, int cgi, const float* w, const float* bias, bf16_t* ACT, float* state_out) {
    const int c0 = cgi * 8;
    float wg[3][8], wv[3][8], bg[8], bvv[8], g0[8], g1[8], v0[8], v1[8];
#define LD8(dst, ptr) do { const f32x4 a_ = *(const f32x4*)(ptr), b_ = *(const f32x4*)((ptr) + 4); dst[0] = a_.x; dst[1] = a_.y; dst[2] = a_.z; dst[3] = a_.w; dst[4] = b_.x; dst[5] = b_.y; dst[6] = b_.z; dst[7] = b_.w; } while (0)
#pragma unroll
    for (int i = 0; i < 3; ++i) { LD8(wg[i], w + i * FF2 + c0); LD8(wv[i], w + i * FF2 + FF + c0); }
    LD8(bg, bias + c0); LD8(bvv, bias + FF + c0);
    if (SAMPLE) {
        LD8(g0, st + 0 * FF2 + c0); LD8(g1, st + 1 * FF2 + c0); LD8(v0, st + 0 * FF2 + FF + c0); LD8(v1, st + 1 * FF2 + FF + c0);
    } else if (has_hist) {
        unpack8(*(const u32x4*)(U + (size_t)(row0 - 2) * FF2 + c0), g0); unpack8(*(const u32x4*)(U + (size_t)(row0 - 1) * FF2 + c0), g1);
        unpack8(*(const u32x4*)(U + (size_t)(row0 - 2) * FF2 + FF + c0), v0); unpack8(*(const u32x4*)(U + (size_t)(row0 - 1) * FF2 + FF + c0), v1);
    } else {
#pragma unroll
        for (int e = 0; e < 8; ++e) { g0[e] = 0.f; g1[e] = 0.f; v0[e] = 0.f; v1[e] = 0.f; }
    }
#undef LD8
    u32x4 rg[NT], rv[NT];
#pragma unroll
    for (int t = 0; t < NT; ++t) { rg[t] = *(const u32x4*)(U + (size_t)(row0 + t) * FF2 + c0); rv[t] = *(const u32x4*)(U + (size_t)(row0 + t) * FF2 + FF + c0); }
#pragma unroll
    for (int t = 0; t < NT; ++t) {
        float cg_[8], cv_[8], o[8];
        unpack8(rg[t], cg_); unpack8(rv[t], cv_);
#pragma unroll
        for (int e = 0; e < 8; ++e) {
            const float gg = g0[e] * wg[0][e] + g1[e] * wg[1][e] + cg_[e] * wg[2][e] + bg[e];
            const float vv = v0[e] * wv[0][e] + v1[e] * wv[1][e] + cv_[e] * wv[2][e] + bvv[e];
            o[e] = siluf_(gg) * vv; g0[e] = g1[e]; g1[e] = cg_[e]; v0[e] = v1[e]; v1[e] = cv_[e]; }
        *(u32x4*)(ACT + (size_t)(row0 + t) * FF + c0) = pack8(o);
    }
    if (state_out) {
#define ST8(ptr, src) do { *(f32x4*)(ptr) = (f32x4){src[0], src[1], src[2], src[3]}; *(f32x4*)((ptr) + 4) = (f32x4){src[4], src[5], src[6], src[7]}; } while (0)
        ST8(state_out + 0 * FF2 + c0, g0); ST8(state_out + 1 * FF2 + c0, g1); ST8(state_out + 0 * FF2 + FF + c0, v0); ST8(state_out + 1 * FF2 + FF + c0, v1);
#undef ST8
    }
}


#define XB_TMO      128
#define XB_XCNT(j)  (256  + 64 * (j))
#define XB_XSUB(j)  (1280 + 64 * (j))
#define XB_XGEN(j)  (2304 + 64 * (j))
#define XB_TOP      3328
#define XB_TOPGEN   3392
#define XCD_BAR_WORDS 3456
#define XB_SPIN_CAP (1u << 18)
__device__ __forceinline__ unsigned xb_ld(unsigned* p)              { return __hip_atomic_load(p, __ATOMIC_RELAXED, __HIP_MEMORY_SCOPE_AGENT); }
__device__ __forceinline__ unsigned xb_add(unsigned* p, unsigned v) { return __hip_atomic_fetch_add(p, v, __ATOMIC_RELAXED, __HIP_MEMORY_SCOPE_AGENT); }
__device__ __forceinline__ unsigned xb_xcc_id() { return (unsigned)__builtin_amdgcn_s_getreg((3 << 11) | 20) & 0xFu; }
#define XB_SPIN(cond, bar) do { unsigned _sp = 0; while (cond) { __builtin_amdgcn_s_sleep(1); \
    if ((++_sp & 255u) == 0u) { if (xb_ld(&(bar)[XB_TMO])) break; if (_sp > XB_SPIN_CAP) { atomicAdd(&(bar)[XB_TMO], 1u); break; } } } } while (0)
struct XcdBarrier { unsigned* bar; unsigned x; volatile LAS unsigned* st; };
__device__ __forceinline__ XcdBarrier xcd_barrier_post(unsigned* bar, volatile LAS unsigned* st) {
    XcdBarrier b; b.bar = bar; b.x = xb_xcc_id(); b.st = st;
    if (threadIdx.x == 0) (void)xb_add(&bar[XB_XCNT(b.x)], 1u);
    return b;
}
__device__ __forceinline__ void xcd_barrier_complete(unsigned* bar, unsigned x, unsigned& nloc, unsigned& nx) {
    const unsigned G = gridDim.x * gridDim.y * gridDim.z;
    unsigned sum, cnt, mine, sp = 0u;
    for (;;) {
        sum = 0u; cnt = 0u; mine = 0u;
#pragma unroll
        for (unsigned j = 0; j < 16; ++j) { const unsigned c = xb_ld(&bar[XB_XCNT(j)]); sum += c; cnt += (c > 0u) ? 1u : 0u; mine = (j == x) ? c : mine; }
        if (sum == G) break;
        __builtin_amdgcn_s_sleep(1);
        if ((++sp & 255u) == 0u) { if (xb_ld(&bar[XB_TMO])) break; if (sp > XB_SPIN_CAP) { atomicAdd(&bar[XB_TMO], 1u); break; } }
    }
    nloc = mine > 0u ? mine : 1u; nx = cnt > 0u ? cnt : 1u;
}
__device__ __forceinline__ void xcd_barrier(const XcdBarrier& b) {
    asm volatile("s_waitcnt vmcnt(0)" ::: "memory");
    __syncthreads();
    if (threadIdx.x == 0) {
        unsigned* bar = b.bar;
        __builtin_amdgcn_s_waitcnt(0);
        unsigned nloc = b.st[0], nx = b.st[1];
        if (nloc == 0u) { xcd_barrier_complete(bar, b.x, nloc, nx); b.st[0] = nloc; b.st[1] = nx; }
        const unsigned old = xb_add(&bar[XB_XSUB(b.x)], 1u);
        const unsigned gen = old / nloc;
        if (old + 1u == (gen + 1u) * nloc) {
            __builtin_amdgcn_fence(__ATOMIC_RELEASE, "agent");
            asm volatile("s_waitcnt vmcnt(0)" ::: "memory");
            const unsigned og = xb_add(&bar[XB_TOP], 1u);
            const unsigned tg = og / nx;
            if (og + 1u == (tg + 1u) * nx) xb_add(&bar[XB_TOPGEN], 1u);
            else XB_SPIN(xb_ld(&bar[XB_TOPGEN]) == tg, bar);
            __builtin_amdgcn_fence(__ATOMIC_ACQUIRE, "agent");
            xb_add(&bar[XB_XGEN(b.x)], 1u);
            asm volatile("s_waitcnt vmcnt(0)" ::: "memory");
        } else {
            XB_SPIN(xb_ld(&bar[XB_XGEN(b.x)]) == gen, bar);
            __builtin_amdgcn_fence(__ATOMIC_ACQUIRE, "agent");
            asm volatile("s_waitcnt vmcnt(0)" ::: "memory");
        }
    }
    __syncthreads();
}

struct Args { const float* in[25]; float* out_p; unsigned char* ws_p; int ph_lo, ph_hi, li, pad; };
constexpr int N_PHASES = 11;
typedef const __attribute__((address_space(4))) Args* KArgs;
__device__ __forceinline__ KArgs ka_get() { KArgs p = (KArgs)__builtin_amdgcn_kernarg_segment_ptr(); asm volatile("" : "+s"(p)); return p; }

__global__ void __launch_bounds__(512, 2) mk_fwd(Args args) {
    extern __shared__ __attribute__((aligned(16))) unsigned char lds_raw[];
    LAS unsigned char* lds = (LAS unsigned char*)lds_raw;
    const int tid = ltid(), lane = tid & 63, wave = __builtin_amdgcn_readfirstlane(tid >> 6);
    const int G = gridDim.x, bx = blockIdx.x;
    const int lo = args.ph_lo, hi = args.ph_hi;
#define x_prompt ((const float*)KA->in[0])
#define x_sample ((const float*)KA->in[1])
#define state_ssm ((const float*)KA->in[2])
#define state_ssdc ((const float*)KA->in[3])
#define state_cfc ((const float*)KA->in[4])
#define state_ffc ((const float*)KA->in[5])
#define norm_mix_w ((const float*)KA->in[6])
#define w_in ((const float*)KA->in[7])
#define ssd_conv_w ((const float*)KA->in[8])
#define ssd_conv_b ((const float*)KA->in[9])
#define dt_bias ((const float*)KA->in[10])
#define a_log ((const float*)KA->in[11])
#define d_skip ((const float*)KA->in[12])
#define ssd_norm_w ((const float*)KA->in[13])
#define cf_conv_w ((const float*)KA->in[14])
#define cf_conv_b ((const float*)KA->in[15])
#define cf_ln_w ((const float*)KA->in[16])
#define cf_ln_b ((const float*)KA->in[17])
#define w_out ((const float*)KA->in[18])
#define norm_ffn_w ((const float*)KA->in[19])
#define w_up ((const float*)KA->in[20])
#define ffn_conv_w ((const float*)KA->in[21])
#define ffn_conv_b ((const float*)KA->in[22])
#define w_down ((const float*)KA->in[23])
#define norm_final_w ((const float*)KA->in[24])
#define out ((float*)KA->out_p)
#define ws ((unsigned char*)KA->ws_p)
#define WinT ((bf16_t*)(ws + WS_WIN))
#define WoutT ((bf16_t*)(ws + WS_WOUT))
#define WupT ((bf16_t*)(ws + WS_WUP))
#define WdnT ((bf16_t*)(ws + WS_WDN))
#define XN ((bf16_t*)(ws + WS_XN))
#define DT ((float*)(ws + WS_DT))
#define PROJ ((bf16_t*)(ws + WS_PROJ))
#define XBC ((bf16_t*)(ws + WS_XBC))
#define U ((bf16_t*)(ws + WS_U))
#define CONVOUT ((bf16_t*)(ws + WS_CONV))
#define MIX ((bf16_t*)(ws + WS_MIX))
#define ACT ((bf16_t*)(ws + WS_ACT))
#define PART ((float*)(ws + WS_RA))
    constexpr int S2 = 8, S4 = 7;

#ifndef PHASE_MASK
#define PHASE_MASK 0x7ff
#endif
#define IN(k) (((PHASE_MASK >> (k)) & 1) && lo <= (k) && (k) < hi)
    volatile LAS unsigned* bst = (volatile LAS unsigned*)(lds + LDS_BYTES - 64);
    if (tid < 2) bst[tid] = 0u;
    __syncthreads();
    const KArgs KA0 = ka_get();
    const XcdBarrier gbar = xcd_barrier_post((unsigned*)((unsigned char*)KA0->ws_p + WS_CTL) + (args.li & 0xff) * XCD_BAR_WORDS, bst);
    const int psel = args.li >> 8;
    if (args.pad != 0) cg::this_grid().sync();
#define SEAM(k) do { if (IN(k) && IN((k) + 1)) xcd_barrier(gbar); } while (0)

    if (IN(0)) { const KArgs KA = ka_get(); const int tid = ltid(), lane = tid & 63, wave = __builtin_amdgcn_readfirstlane(tid >> 6); (void)lane; (void)wave;
        LAS float* scr = (LAS float*)(lds + wave * 16384);
        const int gw = bx * 8 + wave, NGW = G * 8;
        constexpr int I_IN = (DM / 64) * (9248 / 32), I_OUT = (DMIX / 64) * (DM / 32), I_UP = (DM / 64) * (FF2 / 32), I_DN = (FF / 64) * (DM / 32);
        for (int it = gw; it < I_IN + I_OUT + I_UP + I_DN; it += NGW) {
            int r = it;
            if (r < I_IN) { const int nblk = 9248 / 32, kb = r / nblk, nb = r % nblk; p0_transpose_item(w_in, DM, 9248, WinT, 64 * kb, 32 * nb, win_dest_row(32 * nb), scr, lane); continue; } r -= I_IN;
            if (r < I_OUT) { const int nblk = DM / 32, kb = r / nblk, nb = r % nblk; p0_transpose_item(w_out, DMIX, DM, WoutT, 64 * kb, 32 * nb, 32 * nb, scr, lane); continue; } r -= I_OUT;
            if (r < I_UP) { const int nblk = FF2 / 32, kb = r / nblk, nb = r % nblk; p0_transpose_item(w_up, DM, FF2, WupT, 64 * kb, 32 * nb, 32 * nb, scr, lane, norm_ffn_w); continue; } r -= I_UP;
            { const int nblk = DM / 32, kb = r / nblk, nb = r % nblk; p0_transpose_item(w_down, FF, DM, WdnT, 64 * kb, 32 * nb, 32 * nb, scr, lane); }
        }
        for (int m = gw; m < MT; m += NGW) { const float* xr = (m < MP) ? x_prompt + (size_t)m * DM : x_sample + (size_t)(m - MP) * DM; rms_row_to_bf16(xr, norm_mix_w, XN + (size_t)m * DM, lane); }
    }
    SEAM(0);
    if (IN(1)) { const KArgs KA = ka_get(); const int tid = ltid(), lane = tid & 63, wave = __builtin_amdgcn_readfirstlane(tid >> 6); (void)lane; (void)wave;
        pg8::Gemm g{XN, WinT, MT, NPROJ, DM}; pg8::StaticOrder S; S.init(MT, NPROJ, G, bx, DM);
        pg8::EpiBf16 E{PROJ, NPROJ, nullptr, CCF / 256, CUCF};
        pg8::gemm_phase<pg8::EpiBf16, pg8::StaticOrder, true, true>(lds, g, S, E);
    }
    SEAM(1);
    if (IN(2)) { const KArgs KA = ka_get(); const int tid = ltid(), lane = tid & 63, wave = __builtin_amdgcn_readfirstlane(tid >> 6); (void)lane; (void)wave;
        bf16_t* XT1 = (bf16_t*)(ws + WS_XT1); bf16_t* XT2 = (bf16_t*)((unsigned char*)out + OS_XT2); bf16_t* BT = (bf16_t*)((unsigned char*)out + OS_BT); float* CS = (float*)((unsigned char*)out + OS_CS);
        {   const int gw = bx * 8 + wave, NGW = G * 8;
            for (int it = gw; it < 64 * NH + (MS * NH) / 64; it += NGW) {
                if (it < 64 * NH) { const int ci = it >> 5, h = it & 31, rb = ci * 128;
                    const float bias = dt_bias[h], A = -__expf(a_log[h]);
                    const float v0 = bf2f(PROJ[(size_t)(rb + 2 * lane) * NPROJ + CDT + h]) + bias, v1 = bf2f(PROJ[(size_t)(rb + 2 * lane + 1) * NPROJ + CDT + h]) + bias;
                    const float d0 = fmaxf(v0, 0.f) + log1pf(__expf(-fabsf(v0))), d1 = fmaxf(v1, 0.f) + log1pf(__expf(-fabsf(v1)));
                    const float a1 = d1 * A; float sc = d0 * A + a1;
#pragma unroll
                    for (int o = 1; o < 64; o <<= 1) { const float t = __shfl_up(sc, o); if (lane >= o) sc += t; }
                    DT[(size_t)(rb + 2 * lane) * NH + h] = d0; DT[(size_t)(rb + 2 * lane + 1) * NH + h] = d1;
                    CS[(size_t)(rb + 2 * lane) * NH + h] = sc - a1; CS[(size_t)(rb + 2 * lane + 1) * NH + h] = sc; }
                else { const int e = (it - 64 * NH) * 64 + lane, row = MP + (e >> 5), h = e & 31;
                    const float v = bf2f(PROJ[(size_t)row * NPROJ + CDT + h]) + dt_bias[h];
                    DT[(size_t)row * NH + h] = fmaxf(v, 0.f) + log1pf(__expf(-fabsf(v))); }
            }
        }
        if (psel != 1) {
            cf_prompt_items(lds, PROJ, bx, G, 1024, cf_conv_w, cf_conv_b, CONVOUT, out + O_PCFC);
            for (int it2 = bx; it2 < 256; it2 += G) { const int s = it2 >> 1, c = (it2 & 1) * 1024 + tid * 2;
                cf_sample_item(PROJ, s, c, state_cfc + (size_t)s * 30 * DM, cf_conv_w, cf_conv_b, CONVOUT, out + O_SCFC + (size_t)s * 30 * DM); }
        }
        xcd_barrier(gbar);
        const int gt = bx * 512 + tid, NGT = G * 512;
        if (psel != 2) for (int it = gt; it < (MP / 8) * 384; it += NGT) {
            const int cq = it & 7, tgl = (it >> 3) & 7, rest = it >> 6; const int cgi = (rest % 48) * 8 + cq, tg = (rest / 48) * 8 + tgl; const int row0 = tg * 8, t0 = row0 % SEQ, b = row0 / SEQ;
            ssdconv_prompt_item(PROJ, row0, t0 > 0, cgi, ssd_conv_w, ssd_conv_b, XBC, (t0 == SEQ - 8) ? out + O_PSSDC + (size_t)b * 3 * XBCW : nullptr, DT, CS, XT1, XT2, BT); }
        for (int it = gt; it < DB * 384; it += NGT) { const int cgi = it % 384, s = it / 384;
            ssdconv_item<4, true>(PROJ, MP + 4 * s, true, state_ssdc + (size_t)s * 3 * XBCW, cgi, ssd_conv_w, ssd_conv_b, XBC, out + O_SSSDC + (size_t)s * 3 * XBCW); }
    }
    SEAM(2);
    if (IN(3)) { const KArgs KA = ka_get(); const int tid = ltid(), lane = tid & 63, wave = __builtin_amdgcn_readfirstlane(tid >> 6); (void)lane; (void)wave;
        const bf16_t* XT1 = (const bf16_t*)(ws + WS_XT1); const bf16_t* XT2 = (const bf16_t*)((unsigned char*)out + OS_XT2); const bf16_t* BT = (const bf16_t*)((unsigned char*)out + OS_BT); const float* CS = (const float*)((unsigned char*)out + OS_CS);
        const int npb = (G >= 256) ? 128 : (G / 2 > 0 ? G / 2 : 1);
        if (bx < npb) { if (psel != 2) for (int it = bx; it < NB * NH; it += npb) ssd_prompt(lds, it >> 5, it & 31, XBC, CS, XT1, XT2, BT, MIX, out + O_PSSM); }
        else { if (psel != 1) ssd_sample_items(lds, bx - npb, G - npb, DB * NG, XBC, DT, a_log, state_ssm, MIX, out + O_SSSM);
            if (psel == 0) for (int m = (bx - npb) * 8 + wave; m < MT; m += (G - npb) * 8) mix_finalize_conformer((size_t)m, MIX, CONVOUT, cf_ln_w, cf_ln_b, lane); }
    }
    SEAM(3);
    if (IN(4)) { const KArgs KA = ka_get(); const int tid = ltid(), lane = tid & 63, wave = __builtin_amdgcn_readfirstlane(tid >> 6); (void)lane; (void)wave;
        for (int m = bx * 8 + wave; m < MT; m += G * 8) mix_finalize_ssd((size_t)m, MIX, XBC, PROJ, d_skip, ssd_norm_w, lane, (psel == 3) ? XN + (size_t)m * DM : MIX + (size_t)m * DMIX);
    }
    SEAM(4);
    if (IN(5)) { const KArgs KA = ka_get(); const int tid = ltid(), lane = tid & 63, wave = __builtin_amdgcn_readfirstlane(tid >> 6); (void)lane; (void)wave;
        pg8::Gemm g{MIX, WoutT, MT, DM, DMIX}; pg8::SplitOrder S; S.init(DMIX, G, bx, S2, 8);
        pg8::EpiX1 E{x_prompt, XN, (float*)(ws + WS_CTL + CTL_SSQ1), PART, psel == 3};
        pg8::gemm_phase<pg8::EpiX1, pg8::SplitOrder, true, true>(lds, g, S, E);
    }
    SEAM(5);
    if (IN(6)) { const KArgs KA = ka_get(); const int tid = ltid(), lane = tid & 63, wave = __builtin_amdgcn_readfirstlane(tid >> 6); (void)lane; (void)wave;
        float* SSQ1 = (float*)(ws + WS_CTL + CTL_SSQ1);
        for (int m = MP + bx * 8 + wave; m < MT; m += G * 8) {
            const float* base = x_sample + (size_t)(m - MP) * DM; const float* part = PART + (size_t)(m - MP) * DM;
            f32x4 v[8];
#pragma unroll
            for (int j = 0; j < 8; ++j) v[j] = *(const f32x4*)(base + (j * 64 + lane) * 4);
            for (int sp = 0; sp < S2; ++sp) {
#pragma unroll
                for (int j = 0; j < 8; ++j) v[j] += *(const f32x4*)(part + (size_t)sp * MS * DM + (j * 64 + lane) * 4); }
            float sq = 0.f;
#pragma unroll
            for (int j = 0; j < 8; ++j) sq += (v[j].x * v[j].x + v[j].y * v[j].y) + (v[j].z * v[j].z + v[j].w * v[j].w);
            sq = wave_sum(sq);
            if (lane == 0) SSQ1[m] = sq;
#pragma unroll
            for (int j = 0; j < 8; ++j) { u32x2 o; o.x = pk2(v[j].x, v[j].y); o.y = pk2(v[j].z, v[j].w); *(u32x2*)(XN + (size_t)m * DM + (j * 64 + lane) * 4) = o; }
        }
    }
    SEAM(6);
    if (IN(7)) { const KArgs KA = ka_get(); const int tid = ltid(), lane = tid & 63, wave = __builtin_amdgcn_readfirstlane(tid >> 6); (void)lane; (void)wave;
        pg8::Gemm g{XN, WupT, MT, FF2, DM}; pg8::StaticOrder S; S.init(MT, FF2, G, bx, DM);
        pg8::EpiBf16 E{U, FF2, (const float*)(ws + WS_CTL + CTL_SSQ1), -1, 0};
        pg8::gemm_phase<pg8::EpiBf16, pg8::StaticOrder, true, true>(lds, g, S, E);
    }
    SEAM(7);
    if (IN(8)) { const KArgs KA = ka_get(); const int tid = ltid(), lane = tid & 63, wave = __builtin_amdgcn_readfirstlane(tid >> 6); (void)lane; (void)wave;
        const int gt = bx * 512 + tid, NGT = G * 512;
        for (int it = gt; it < (MP / 8) * 688; it += NGT) { const int cgi = it % 688, tg = it / 688; const int row0 = tg * 8, t0 = row0 % SEQ, b = row0 / SEQ;
            ffn_item<8, false>(U, row0, t0 > 0, nullptr, cgi, ffn_conv_w, ffn_conv_b, ACT, (t0 == SEQ - 8) ? out + O_PFFC + (size_t)b * 2 * FF2 : nullptr); }
        for (int it = gt; it < DB * 688; it += NGT) { const int cgi = it % 688, s = it / 688;
            ffn_item<4, true>(U, MP + 4 * s, true, state_ffc + (size_t)s * 2 * FF2, cgi, ffn_conv_w, ffn_conv_b, ACT, out + O_SFFC + (size_t)s * 2 * FF2); }
    }
    SEAM(8);
    if (IN(9)) { const KArgs KA = ka_get(); const int tid = ltid(), lane = tid & 63, wave = __builtin_amdgcn_readfirstlane(tid >> 6); (void)lane; (void)wave;
        pg8::Gemm g{ACT, WdnT, MT, DM, FF}; pg8::SplitOrder S; S.init(FF, G, bx, S4, 12);
        pg8::EpiResF32 E{XN, out + O_Y, PART, psel == 3};
        pg8::gemm_phase<pg8::EpiResF32, pg8::SplitOrder, true, true>(lds, g, S, E);
    }
    SEAM(9);
    if (IN(10)) { const KArgs KA = ka_get(); const int tid = ltid(), lane = tid & 63, wave = __builtin_amdgcn_readfirstlane(tid >> 6); (void)lane; (void)wave;
        for (int m = bx * 8 + wave; m < MT; m += G * 8) {
            float* xr = out + O_Y + (size_t)m * DM;
            f32x4 v[8], ww[8];
#pragma unroll
            for (int j = 0; j < 8; ++j) { const u32x2 b = *(const u32x2*)(XN + (size_t)m * DM + (j * 64 + lane) * 4); v[j] = (f32x4){bf2f(b.x & 0xffffu), bf2f(b.x >> 16), bf2f(b.y & 0xffffu), bf2f(b.y >> 16)};
                ww[j] = *(const f32x4*)(norm_final_w + (j * 64 + lane) * 4); }
            if (m >= MP) { const float* part = PART + (size_t)(m - MP) * DM;
                for (int sp = 0; sp < S4; ++sp) {
#pragma unroll
                    for (int j = 0; j < 8; ++j) v[j] += *(const f32x4*)(part + (size_t)sp * MS * DM + (j * 64 + lane) * 4); } }
            float s = 0.f;
#pragma unroll
            for (int j = 0; j < 8; ++j) s += (v[j].x * v[j].x + v[j].y * v[j].y) + (v[j].z * v[j].z + v[j].w * v[j].w);
            const float r = rsqrtf(wave_sum(s) * (1.f / DM) + EPS);
#pragma unroll
            for (int j = 0; j < 8; ++j) *(f32x4*)(xr + (j * 64 + lane) * 4) = v[j] * r * ww[j];
        }
    }
#undef IN
#undef SEAM
}
#undef x_prompt
#undef x_sample
#undef state_ssm
#undef state_ssdc
#undef state_cfc
#undef state_ffc
#undef norm_mix_w
#undef w_in
#undef ssd_conv_w
#undef ssd_conv_b
#undef dt_bias
#undef a_log
#undef d_skip
#undef ssd_norm_w
#undef cf_conv_w
#undef cf_conv_b
#undef cf_ln_w
#undef cf_ln_b
#undef w_out
#undef norm_ffn_w
#undef w_up
#undef ffn_conv_w
#undef ffn_conv_b
#undef w_down
#undef norm_final_w
#undef out
#undef ws
#undef WinT
#undef WoutT
#undef WupT
#undef WdnT
#undef XN
#undef DT
#undef PROJ
#undef XBC
#undef U
#undef CONVOUT
#undef MIX
#undef ACT
#undef PART


extern "C" void kernel_launch(void* const* d_in, const int* in_sizes, int n_in, void* d_out, int out_size, void* d_ws, size_t ws_size, hipStream_t stream) {
    static int grid = 0;
    if (grid == 0) {
        if (n_in != 25 || (size_t)out_size != O_END || ws_size < WS_END) {
            fprintf(stderr, "kernel_launch: shape mismatch: n_in %d out %d (want %zu) ws %zu (need %zu)\n", n_in, out_size, (size_t)O_END, ws_size, (size_t)WS_END); grid = -1; return; }
        int dev = 0, cus = 0, per_cu = 0;
        hipGetDevice(&dev);
        hipDeviceGetAttribute(&cus, hipDeviceAttributeMultiprocessorCount, dev);
        if (hipFuncSetAttribute((const void*)mk_fwd, hipFuncAttributeMaxDynamicSharedMemorySize, LDS_BYTES) != hipSuccess) { fprintf(stderr, "kernel_launch: hipFuncSetAttribute failed\n"); grid = -1; return; }
        if (hipOccupancyMaxActiveBlocksPerMultiprocessor(&per_cu, (const void*)mk_fwd, 512, LDS_BYTES) != hipSuccess || per_cu < 1) { fprintf(stderr, "kernel_launch: occupancy query %d\n", per_cu); per_cu = 1; }
        (void)hipGetLastError();
        grid = cus * per_cu;
    }
    if (grid < 0) return;
    Args a{};
    for (int i = 0; i < 25; ++i) a.in[i] = (const float*)d_in[i];
    a.out_p = (float*)d_out; a.ws_p = (unsigned char*)d_ws;
#ifndef PROBE_SEL
#define PROBE_SEL 0
#endif
#ifndef PROBE_PHASE
#define PROBE_PHASE -1
#endif
    int ranges[3][2]; int nr = 0;
    if (PROBE_PHASE < 0) { ranges[0][0] = 0; ranges[0][1] = N_PHASES; nr = 1; }
    else { ranges[0][0] = 0; ranges[0][1] = PROBE_PHASE + 1; ranges[1][0] = PROBE_PHASE; ranges[1][1] = PROBE_PHASE + 1; nr = 2;
           if (PROBE_PHASE + 1 < N_PHASES) { ranges[2][0] = PROBE_PHASE + 1; ranges[2][1] = N_PHASES; nr = 3; } }
    if (hipMemsetAsync((char*)d_ws + WS_CTL, 0, CTL_BYTES, stream) != hipSuccess) { fprintf(stderr, "kernel_launch: memset failed\n"); return; }
    for (int i = 0; i < nr; ++i) {
        a.ph_lo = ranges[i][0]; a.ph_hi = ranges[i][1]; a.li = i | ((i == 1) ? (PROBE_SEL << 8) : 0);
        void* kargs[] = {&a};
        hipError_t e = hipLaunchCooperativeKernel((const void*)mk_fwd, dim3(grid), dim3(512), kargs, LDS_BYTES, stream);
        if (e != hipSuccess) fprintf(stderr, "kernel_launch: cooperative launch failed: %s (grid %d)\n", hipGetErrorString(e), grid);
    }
}
```

```cpp
#include <hip/hip_runtime.h>
#include <hip/hip_cooperative_groups.h>
#include <cstdio>
#include <cstdint>
namespace cg = cooperative_groups;

#ifndef MK_N_LAUNCHES
#define MK_N_LAUNCHES 1
#endif

#define LAS __attribute__((address_space(3)))
typedef unsigned short bf16_t;
typedef short bf16x8 __attribute__((ext_vector_type(8)));
typedef float f32x4 __attribute__((ext_vector_type(4)));
typedef float f32x2 __attribute__((ext_vector_type(2)));
typedef unsigned u32x4 __attribute__((ext_vector_type(4)));
typedef unsigned u32x2 __attribute__((ext_vector_type(2)));

constexpr int DM = 2048;
constexpr int MP = 8192, MS = 512, MT = MP + MS;
constexpr int SEQ = 2048, NB = 4, DB = 128, DSEQ = 4;
constexpr int NH = 32, HP = 64, NS = 128, NG = 4;
constexpr int XBCW = 3072;
constexpr int NPROJ = 9472;
constexpr int CZ = 0, CXBC = 2048, CCF = 5120, CDT = 9216;
constexpr int CUCF = 5120;
constexpr int DMIX = 4096, FF = 5504, FF2 = 11008;
constexpr float EPS = 1e-5f;

constexpr size_t O_Y = 0;
constexpr size_t O_PSSM = (size_t)MT * DM;
constexpr size_t O_PSSDC = O_PSSM + (size_t)NB * NH * HP * NS;
constexpr size_t O_PCFC = O_PSSDC + (size_t)NB * 3 * XBCW;
constexpr size_t O_PFFC = O_PCFC + (size_t)NB * 30 * DM;
constexpr size_t O_SSSM = O_PFFC + (size_t)NB * 2 * FF2;
constexpr size_t O_SSSDC = O_SSSM + (size_t)DB * NH * HP * NS;
constexpr size_t O_SCFC = O_SSSDC + (size_t)DB * 3 * XBCW;
constexpr size_t O_SFFC = O_SCFC + (size_t)DB * 30 * DM;
constexpr size_t O_END = O_SFFC + (size_t)DB * 2 * FF2;

constexpr size_t al256(size_t x) { return (x + 255) & ~(size_t)255; }
constexpr size_t WS_WIN = 0;
constexpr size_t WS_WOUT = WS_WIN + al256((size_t)NPROJ * DM * 2);
constexpr size_t WS_WUP = WS_WOUT + al256((size_t)DM * DMIX * 2);
constexpr size_t WS_WDN = WS_WUP + al256((size_t)FF2 * DM * 2);
constexpr size_t WS_XN = WS_WDN + al256((size_t)DM * FF * 2);
constexpr size_t WS_DT = WS_XN + al256((size_t)MT * DM * 2);
constexpr size_t WS_RA = WS_DT + al256((size_t)MT * NH * 4);
constexpr size_t WS_PROJ = WS_RA;
constexpr size_t WS_XBC = WS_PROJ + al256((size_t)MT * NPROJ * 2);
constexpr size_t WS_U = WS_RA;
constexpr size_t WS_RB = WS_XBC + al256((size_t)MT * XBCW * 2);
constexpr size_t WS_CONV = WS_RB;
constexpr size_t WS_MIX = WS_CONV + al256((size_t)MT * DM * 4);
constexpr size_t WS_ACT = WS_RB;
constexpr size_t WS_CTL = WS_MIX + al256((size_t)MT * DMIX * 2);
constexpr size_t CTL_BYTES = 131072;
constexpr size_t CTL_SSQ1 = 65536;
constexpr size_t WS_END = WS_CTL + CTL_BYTES;
static_assert((size_t)MT * FF2 * 2 <= WS_RB - WS_RA, "U overlay");
static_assert((size_t)MT * FF * 2 <= WS_END - WS_RB, "ACT overlay");

constexpr size_t WS_XT1 = WS_XN;
constexpr size_t OS_XT2 = 0, OS_BT = OS_XT2 + (size_t)MP * DM * 2, OS_CS = OS_BT + (size_t)64 * 512 * 128 * 2;
static_assert((size_t)MP * DM * 2 <= (size_t)MT * DM * 2 && OS_CS + (size_t)MP * NH * 4 <= (size_t)MT * DM * 4, "ssd scratch maps");
constexpr int LDS_BYTES = 147456;

__device__ __forceinline__ int ltid() { int t = threadIdx.x; asm volatile("" : "+v"(t)); return t; }
__device__ __forceinline__ float bf2f(unsigned h) { return __uint_as_float(h << 16); }
__device__ __forceinline__ unsigned f2bf(float f) { unsigned u = __float_as_uint(f); return (u + 0x7fffu + ((u >> 16) & 1u)) >> 16; }
__device__ __forceinline__ unsigned pk2(float lo, float hi) { unsigned r; asm("v_cvt_pk_bf16_f32 %0, %1, %2" : "=v"(r) : "v"(lo), "v"(hi)); return r; }
__device__ __forceinline__ float sigmoidf_(float x) { return __builtin_amdgcn_rcpf(1.f + __expf(-x)); }
__device__ __forceinline__ float siluf_(float x) { return x * __builtin_amdgcn_rcpf(1.f + __expf(-x)); }
#define LDS_BARRIER() do { asm volatile("s_waitcnt lgkmcnt(0)" ::: "memory"); __builtin_amdgcn_s_barrier(); asm volatile("" ::: "memory"); } while (0)
__device__ __forceinline__ float wave_sum(float v) {
#pragma unroll
    for (int o = 1; o < 64; o <<= 1) v += __shfl_xor(v, o);
    return v;
}
__device__ __forceinline__ void unpack8(const u32x4 v, float (&o)[8]) {
    o[0] = bf2f(v.x & 0xffffu); o[1] = bf2f(v.x >> 16); o[2] = bf2f(v.y & 0xffffu); o[3] = bf2f(v.y >> 16);
    o[4] = bf2f(v.z & 0xffffu); o[5] = bf2f(v.z >> 16); o[6] = bf2f(v.w & 0xffffu); o[7] = bf2f(v.w >> 16);
}
__device__ __forceinline__ u32x4 pack8(const float (&o)[8]) {
    u32x4 v; v.x = pk2(o[0], o[1]); v.y = pk2(o[2], o[3]); v.z = pk2(o[4], o[5]); v.w = pk2(o[6], o[7]); return v;
}

namespace pg8 {
#define PG8_LAS __attribute__((address_space(3)))
constexpr int BM = 256, BK = 64, HALF = 128, HTB = HALF * BK * 2, STAGE_BYTES = 8 * HTB, NXCD = 8, WGM = 8;
__host__ __device__ __forceinline__ int lds_byte(int r, int c) { const int st = (r >> 4) * 2 + (c >> 5), rr = r & 15, cc = c & 31, ob = rr * 64 + cc * 2; return st * 1024 + (ob ^ (((ob >> 9) & 1) << 5)); }
__host__ __device__ __forceinline__ void stage_rc(int b, int& R, int& C) { const int st = b / 1024, sb = b % 1024, swz = sb ^ (((sb >> 9) & 1) << 5); R = (st >> 1) * 16 + swz / 64; C = (st & 1) * 32 + (swz % 64) / 2; }
__host__ __device__ __forceinline__ int perm32(int rho) { const int n = rho >> 4, i = rho & 15; return 8 * (i >> 2) + 4 * n + (i & 3); }

struct Unit { int pm, pn, kt0, nkt, split; };
struct Gemm { const bf16_t* A; const bf16_t* Bt; int M, N, K; };
__host__ __device__ __forceinline__ unsigned long long pack_fields(int pm, int pn, int kt0, int nkt, int split) {
    return (unsigned long long)pm | ((unsigned long long)pn << 8) | ((unsigned long long)kt0 << 16) | ((unsigned long long)nkt << 24) | ((unsigned long long)(split + 1) << 32) | (1ull << 40); }
__host__ __device__ __forceinline__ unsigned long long pack_unit(const Unit& u) { return pack_fields(u.pm, u.pn, u.kt0, u.nkt, u.split); }
#define UP_PM(p) ((int)((p) & 0xff))
#define UP_PN(p) ((int)(((p) >> 8) & 0xff))
#define UP_KT0(p) ((int)(((p) >> 16) & 0xff))
#define UP_NKT(p) ((int)(((p) >> 24) & 0xff))
#define UP_SPLIT(p) ((int)(((p) >> 32) & 0xff) - 1)

struct StaticOrder {
    int nM, nN, nwg, G, c, nkt;
    __host__ __device__ void init(int M, int N, int G_, int c_, int K) { nM = M / BM; nN = N / BM; nwg = nM * nN; G = G_; c = c_; nkt = K / BK; }
    __host__ __device__ __forceinline__ bool next(int i, Unit& u) const {
        const long L = (long)i * G + c; if (L >= nwg) return false;
        int wgid = (int)L; { const int q = nwg / NXCD, r = nwg % NXCD, xcd = wgid % NXCD, off = wgid / NXCD; wgid = (xcd < r ? xcd * (q + 1) : r * (q + 1) + (xcd - r) * q) + off; }
        const int nig = WGM * nN, gid = wgid / nig, fm = gid * WGM, gsz = (nM - fm) < WGM ? (nM - fm) : WGM;
        u.pm = fm + ((wgid % nig) % gsz); u.pn = (wgid % nig) / gsz; u.kt0 = 0; u.nkt = nkt; u.split = -1; return true;
    }
    __host__ __device__ __forceinline__ unsigned long long nextp(int i) const { Unit u; if (!next(i, u)) return 0ull; return pack_unit(u); }
    __device__ __forceinline__ void a_ready(const Unit&) const {}
    __device__ __forceinline__ void done(const Unit&) const {}
};
struct SplitOrder {
    StaticOrder P; int G, c, S, base, total;
    __host__ __device__ void init(int K, int G_, int c_, int S_, int base_) { P.init(MP, DM, G_, c_, K); G = G_; c = c_; S = S_; base = base_; total = K / BK; }
    __host__ __device__ __forceinline__ bool next(int i, Unit& u) const {
        const long L = (long)i * G + c;
        if (L < P.nwg) {
            int wgid = (int)L; { const int q = P.nwg / NXCD, r = P.nwg % NXCD, xcd = wgid % NXCD, off = wgid / NXCD; wgid = (xcd < r ? xcd * (q + 1) : r * (q + 1) + (xcd - r) * q) + off; }
            const int nig = WGM * P.nN, gid = wgid / nig, fm = gid * WGM, gsz = (P.nM - fm) < WGM ? (P.nM - fm) : WGM;
            u.pm = fm + ((wgid % nig) % gsz); u.pn = (wgid % nig) / gsz; u.kt0 = 0; u.nkt = total; u.split = -1; return true;
        }
        const int l2 = (int)(L - P.nwg); if (l2 >= 16 * S) return false;
        u.pn = l2 & 7; u.pm = MP / BM + ((l2 >> 3) & 1); u.split = l2 >> 4; u.kt0 = u.split * base; u.nkt = (u.split == S - 1) ? total - base * (S - 1) : base; return true;
    }
    __host__ __device__ __forceinline__ unsigned long long nextp(int i) const {
        const long L = (long)i * G + c;
        if (L < P.nwg) {
            int wgid = (int)L; { const int q = P.nwg / NXCD, r = P.nwg % NXCD, xcd = wgid % NXCD, off = wgid / NXCD; wgid = (xcd < r ? xcd * (q + 1) : r * (q + 1) + (xcd - r) * q) + off; }
            const int nig = WGM * P.nN, gid = wgid / nig, fm = gid * WGM, gsz = (P.nM - fm) < WGM ? (P.nM - fm) : WGM;
            return pack_fields(fm + ((wgid % nig) % gsz), (wgid % nig) / gsz, 0, total, -1);
        }
        const int l2 = (int)(L - P.nwg); if (l2 >= 16 * S) return 0ull;
        const int sp = l2 >> 4;
        return pack_fields(MP / BM + ((l2 >> 3) & 1), l2 & 7, sp * base, (sp == S - 1) ? total - base * (S - 1) : base, sp);
    }
    __device__ __forceinline__ void a_ready(const Unit&) const {}
    __device__ __forceinline__ void done(const Unit&) const {}
};

__device__ __forceinline__ unsigned cvt_pk_bf16(float lo, float hi) { unsigned r; asm volatile("v_cvt_pk_bf16_f32 %0, %1, %2" : "=v"(r) : "v"(lo), "v"(hi)); return r; }

struct EpiBf16 {
    static constexpr bool PERM = true, AFTER_DRAIN = false;
    bf16_t* O; int ldc; const float* ssq; int glu0, glu_col;
    __device__ __forceinline__ void operator()(const f32x4 (&acc)[2][2][4][2], const Unit& u, int wr, int wc, int fr, int fq) const {
        const int row0 = u.pm * BM + wr * 64 + fr;
        if (glu0 >= 0 && u.pn >= glu0 && u.pn < glu0 + 16) {
            const int col0 = glu_col + 128 * (u.pn - glu0) + wc * 32 + 8 * fq;
#pragma unroll
            for (int ai = 0; ai < 2; ++ai)
#pragma unroll
                for (int m = 0; m < 4; ++m) { float o[8];
#pragma unroll
                    for (int n = 0; n < 2; ++n)
#pragma unroll
                        for (int j = 0; j < 4; ++j) { const float a = acc[ai][0][m][n][j], g = acc[ai][1][m][n][j]; o[4 * n + j] = a * __builtin_amdgcn_rcpf(1.f + __expf(-g)); }
                    u32x4 w; w.x = cvt_pk_bf16(o[0], o[1]); w.y = cvt_pk_bf16(o[2], o[3]); w.z = cvt_pk_bf16(o[4], o[5]); w.w = cvt_pk_bf16(o[6], o[7]);
                    *(u32x4*)(O + (size_t)(row0 + ai * HALF + m * 16) * ldc + col0) = w; }
            return;
        }
        const int col0 = u.pn * BM + wc * 32 + 8 * fq;
        float rs[2][4];
#pragma unroll
        for (int ai = 0; ai < 2; ++ai)
#pragma unroll
            for (int m = 0; m < 4; ++m) rs[ai][m] = ssq ? rsqrtf(ssq[row0 + ai * HALF + m * 16] * (1.f / DM) + EPS) : 1.f;
#pragma unroll
        for (int ai = 0; ai < 2; ++ai)
#pragma unroll
            for (int m = 0; m < 4; ++m) { bf16_t* rowp = O + (size_t)(row0 + ai * HALF + m * 16) * ldc + col0;
#pragma unroll
                for (int bj = 0; bj < 2; ++bj) { const f32x4 v0 = acc[ai][bj][m][0] * rs[ai][m], v1 = acc[ai][bj][m][1] * rs[ai][m];
                    u32x4 w; w.x = cvt_pk_bf16(v0[0], v0[1]); w.y = cvt_pk_bf16(v0[2], v0[3]); w.z = cvt_pk_bf16(v1[0], v1[1]); w.w = cvt_pk_bf16(v1[2], v1[3]);
                    *(u32x4*)(rowp + bj * HALF) = w; } }
    }
};
struct EpiX1 {
    static constexpr bool PERM = true, AFTER_DRAIN = false;
    const float* baseP; bf16_t* X1B; float* ssq; float* part; int probe_repeat;
    __device__ __forceinline__ void operator()(const f32x4 (&acc)[2][2][4][2], const Unit& u, int wr, int wc, int fr, int fq) const {
        const int row0 = u.pm * BM + wr * 64 + fr; const int col0 = u.pn * BM + wc * 32 + 8 * fq;
        if (u.split >= 0) {
            float* pp = part + ((size_t)u.split * MS + (row0 - MP)) * DM;
#pragma unroll
            for (int ai = 0; ai < 2; ++ai)
#pragma unroll
                for (int m = 0; m < 4; ++m) { const size_t ro = (size_t)(ai * HALF + m * 16) * DM + col0;
#pragma unroll
                    for (int bj = 0; bj < 2; ++bj) { *(f32x4*)(pp + ro + bj * HALF) = acc[ai][bj][m][0]; *(f32x4*)(pp + ro + bj * HALF + 4) = acc[ai][bj][m][1]; } }
            return;
        }
        const float* bp = baseP + (size_t)row0 * DM;
        bf16_t* op = X1B + (size_t)row0 * DM;
#pragma unroll
        for (int ai = 0; ai < 2; ++ai)
#pragma unroll
            for (int mp = 0; mp < 2; ++mp) {
                f32x4 bv[2][2][2];
#pragma unroll
                for (int mm = 0; mm < 2; ++mm)
#pragma unroll
                    for (int bj = 0; bj < 2; ++bj) { const size_t ro = (size_t)(ai * HALF + (2 * mp + mm) * 16) * DM + col0 + bj * HALF;
                        bv[mm][bj][0] = *(const f32x4*)(bp + ro); bv[mm][bj][1] = *(const f32x4*)(bp + ro + 4); }
#pragma unroll
                for (int mm = 0; mm < 2; ++mm) { float sq = 0.f;
#pragma unroll
                    for (int bj = 0; bj < 2; ++bj) { const size_t ro = (size_t)(ai * HALF + (2 * mp + mm) * 16) * DM + col0 + bj * HALF;
                        const f32x4 v0 = bv[mm][bj][0] + acc[ai][bj][2 * mp + mm][0], v1 = bv[mm][bj][1] + acc[ai][bj][2 * mp + mm][1];
                        sq += (v0[0] * v0[0] + v0[1] * v0[1]) + (v0[2] * v0[2] + v0[3] * v0[3]) + (v1[0] * v1[0] + v1[1] * v1[1]) + (v1[2] * v1[2] + v1[3] * v1[3]);
                        u32x4 w; w.x = cvt_pk_bf16(v0[0], v0[1]); w.y = cvt_pk_bf16(v0[2], v0[3]); w.z = cvt_pk_bf16(v1[0], v1[1]); w.w = cvt_pk_bf16(v1[2], v1[3]);
                        *(u32x4*)(op + ro) = w; }
                    sq += __shfl_xor(sq, 16); sq += __shfl_xor(sq, 32);
                    if (fq == 0 && !probe_repeat) atomicAdd(ssq + row0 + ai * HALF + (2 * mp + mm) * 16, sq); }
                asm volatile("" ::: "memory"); }
    }
};
struct EpiResF32 {
    static constexpr bool PERM = true, AFTER_DRAIN = false;
    bf16_t* X1B; float* out; float* part; int probe_repeat;
    __device__ __forceinline__ void operator()(const f32x4 (&acc)[2][2][4][2], const Unit& u, int wr, int wc, int fr, int fq) const {
        const int row0 = u.pm * BM + wr * 64 + fr; const int col0 = u.pn * BM + wc * 32 + 8 * fq;
        if (u.split >= 0) {
            float* pp = part + ((size_t)u.split * MS + (row0 - MP)) * DM;
#pragma unroll
            for (int ai = 0; ai < 2; ++ai)
#pragma unroll
                for (int m = 0; m < 4; ++m) { const size_t ro = (size_t)(ai * HALF + m * 16) * DM + col0;
#pragma unroll
                    for (int bj = 0; bj < 2; ++bj) { *(f32x4*)(pp + ro + bj * HALF) = acc[ai][bj][m][0]; *(f32x4*)(pp + ro + bj * HALF + 4) = acc[ai][bj][m][1]; } }
            return;
        }
        bf16_t* bp = X1B + (size_t)row0 * DM;
        bf16_t* wp = probe_repeat ? (bf16_t*)out + (size_t)row0 * DM : bp;
#pragma unroll
        for (int ai = 0; ai < 2; ++ai) {
            u32x4 bv[4][2];
#pragma unroll
            for (int m = 0; m < 4; ++m)
#pragma unroll
                for (int bj = 0; bj < 2; ++bj) bv[m][bj] = *(const u32x4*)(bp + (size_t)(ai * HALF + m * 16) * DM + col0 + bj * HALF);
#pragma unroll
            for (int m = 0; m < 4; ++m)
#pragma unroll
                for (int bj = 0; bj < 2; ++bj) { const size_t ro = (size_t)(ai * HALF + m * 16) * DM + col0 + bj * HALF; float b[8]; unpack8(bv[m][bj], b);
                    const f32x4 v0 = (f32x4){b[0], b[1], b[2], b[3]} + acc[ai][bj][m][0], v1 = (f32x4){b[4], b[5], b[6], b[7]} + acc[ai][bj][m][1];
                    u32x4 w; w.x = cvt_pk_bf16(v0[0], v0[1]); w.y = cvt_pk_bf16(v0[2], v0[3]); w.z = cvt_pk_bf16(v1[0], v1[1]); w.w = cvt_pk_bf16(v1[2], v1[3]);
                    *(u32x4*)(wp + ro) = w; }
            asm volatile("" ::: "memory"); }
    }
};

template <class Epi, class Sched, bool ALIGN_EPI = false, bool SP2 = false>
__device__ __forceinline__ void gemm_phase(PG8_LAS unsigned char* lds, const Gemm g, const Sched& S, const Epi& E) {
    const int tid = ltid(), wid = __builtin_amdgcn_readfirstlane(tid >> 6), lane = tid & 63, wr = wid >> 2, wc = wid & 3, fr = lane & 15, fq = lane >> 4;
    const int K = g.K;
    unsigned voffA[2], voffB[2];
#pragma unroll
    for (int i = 0; i < 2; ++i) { int R, C; stage_rc(tid * 16 + i * 8192, R, C); const int Rb = Epi::PERM ? ((R & ~31) + perm32(R & 31)) : R;
        voffA[i] = (unsigned)(R * K + C) * 2u; voffB[i] = (unsigned)(Rb * K + C) * 2u; }
    const size_t kstep = (size_t)(BK * 2);
    const size_t hstep = (size_t)HALF * K * 2;
    const size_t tstep = 2 * hstep;
    const unsigned ldsw = (unsigned)wid * 1024u;
    const int aoff = lds_byte(wr * 64 + fr, fq * 8), boff = lds_byte(wc * 32 + fr, fq * 8);
#define PG8_SA(b, h) (((b) * 2 + (h)) * HTB)
#define PG8_SB(b, h) ((4 + (b) * 2 + (h)) * HTB)
#define PG8_STAGE(bufoff, gbase, voff) do { _Pragma("unroll") for (int _i = 0; _i < 2; ++_i) \
        __builtin_amdgcn_global_load_lds((const unsigned*)((const char*)(gbase) + (voff)[_i]), (PG8_LAS unsigned*)(lds + (bufoff) + ldsw + _i * 8192), 16, 0, 0); } while (0)
#define PG8_LDA(dst, b, h) do { _Pragma("unroll") for (int m = 0; m < 4; ++m) _Pragma("unroll") for (int k = 0; k < 2; ++k) dst[m][k] = *(const PG8_LAS bf16x8*)(lds + PG8_SA(b, h) + aoff + m * 2048 + k * 1024); } while (0)
#define PG8_LDB(dst, b, h) do { _Pragma("unroll") for (int n = 0; n < 2; ++n) _Pragma("unroll") for (int k = 0; k < 2; ++k) dst[n][k] = *(const PG8_LAS bf16x8*)(lds + PG8_SB(b, h) + boff + n * 2048 + k * 1024); } while (0)
#define PG8_MMA(ai, bj, At, Bt) do { __builtin_amdgcn_s_setprio(1); _Pragma("unroll") for (int m = 0; m < 4; ++m) _Pragma("unroll") for (int n = 0; n < 2; ++n) _Pragma("unroll") for (int k = 0; k < 2; ++k) \
        acc[ai][bj][m][n] = __builtin_amdgcn_mfma_f32_16x16x32_bf16(Bt[n][k], At[m][k], acc[ai][bj][m][n], 0, 0, 0); __builtin_amdgcn_s_setprio(0); } while (0)
#define PG8_WAIT_V(n) asm volatile("s_waitcnt vmcnt(" #n ")" ::: "memory")
#define PG8_WAIT_L(n) asm volatile("s_waitcnt lgkmcnt(" #n ")" ::: "memory")
#define PG8_BAR __builtin_amdgcn_s_barrier()
#define PG8_SCHED __builtin_amdgcn_sched_barrier(0)
    unsigned long long cur = S.nextp(0), nxt; int ui = 0;
    if (!cur) return;
    f32x4 acc[2][2][4][2];
#pragma unroll
    for (int a = 0; a < 2; ++a)
#pragma unroll
        for (int b = 0; b < 2; ++b)
#pragma unroll
            for (int m = 0; m < 4; ++m)
#pragma unroll
                for (int n = 0; n < 2; ++n) acc[a][b][m][n] = (f32x4){0.f, 0.f, 0.f, 0.f};
    bf16x8 At[4][2], B0[2][2], B1[2][2];
    const char* cA = (const char*)g.A + (size_t)UP_PM(cur) * tstep + (size_t)UP_KT0(cur) * kstep; const char* cB = (const char*)g.Bt + (size_t)UP_PN(cur) * tstep + (size_t)UP_KT0(cur) * kstep;
    if constexpr (SP2) {
        PG8_STAGE(PG8_SB(0, 0), cB, voffB); PG8_STAGE(PG8_SB(0, 1), cB + hstep, voffB); PG8_STAGE(PG8_SA(0, 0), cA, voffA); PG8_STAGE(PG8_SA(0, 1), cA + hstep, voffA);
        if (wr == 1) PG8_BAR;
        PG8_WAIT_V(2); PG8_BAR;
        PG8_STAGE(PG8_SB(1, 0), cB + kstep, voffB); PG8_STAGE(PG8_SA(1, 0), cA + kstep, voffA); PG8_STAGE(PG8_SB(1, 1), cB + hstep + kstep, voffB);
        PG8_WAIT_V(6); PG8_BAR;
    } else {
        PG8_STAGE(PG8_SB(0, 0), cB, voffB); PG8_STAGE(PG8_SA(0, 0), cA, voffA); PG8_STAGE(PG8_SB(0, 1), cB + hstep, voffB); PG8_STAGE(PG8_SA(0, 1), cA + hstep, voffA);
        if (wr == 1) PG8_BAR;
        PG8_WAIT_V(4); PG8_BAR;
        PG8_STAGE(PG8_SB(1, 0), cB + kstep, voffB); PG8_STAGE(PG8_SA(1, 0), cA + kstep, voffA); PG8_STAGE(PG8_SB(1, 1), cB + hstep + kstep, voffB);
        PG8_WAIT_V(6); PG8_BAR;
    }
    for (;;) {
        nxt = S.nextp(ui + 1); const bool has_next = (nxt != 0ull);
        const char* nA = has_next ? (const char*)g.A + (size_t)UP_PM(nxt) * tstep + (size_t)UP_KT0(nxt) * kstep : cA; const char* nB = has_next ? (const char*)g.Bt + (size_t)UP_PN(nxt) * tstep + (size_t)UP_KT0(nxt) * kstep : cB;
        const int nt = UP_NKT(cur);
        for (int t = 0; t < nt; t += 2) {
            const bool last = (t == nt - 2);
            const char* a1 = cA + (size_t)(t + 1) * kstep;
            const char* a2 = last ? nA : cA + (size_t)(t + 2) * kstep; const char* b2 = last ? nB : cB + (size_t)(t + 2) * kstep;
            const char* a3 = a2 + kstep; const char* b3 = b2 + kstep;
            if constexpr (SP2) {
            PG8_LDB(B0, 0, 0); PG8_LDB(B1, 0, 1); PG8_SCHED; PG8_LDA(At, 0, 0); PG8_STAGE(PG8_SA(1, 1), a1 + hstep, voffA);
            PG8_WAIT_V(8); PG8_WAIT_L(0); PG8_BAR; PG8_MMA(0, 0, At, B0); PG8_MMA(0, 1, At, B1); PG8_BAR; PG8_SCHED;
            PG8_LDA(At, 0, 1); PG8_STAGE(PG8_SB(0, 0), b2, voffB); PG8_STAGE(PG8_SB(0, 1), b2 + hstep, voffB); PG8_STAGE(PG8_SA(0, 0), a2, voffA);
            PG8_WAIT_V(8); PG8_WAIT_L(0); PG8_BAR; PG8_MMA(1, 0, At, B0); PG8_MMA(1, 1, At, B1); PG8_BAR; PG8_SCHED;
            PG8_LDB(B0, 1, 0); PG8_LDB(B1, 1, 1); PG8_SCHED; PG8_LDA(At, 1, 0); PG8_STAGE(PG8_SA(0, 1), a2 + hstep, voffA);
            PG8_WAIT_V(8); PG8_WAIT_L(0); PG8_BAR; PG8_MMA(0, 0, At, B0); PG8_MMA(0, 1, At, B1); PG8_BAR; PG8_SCHED;
            PG8_LDA(At, 1, 1); PG8_STAGE(PG8_SB(1, 0), b3, voffB); PG8_STAGE(PG8_SB(1, 1), b3 + hstep, voffB); PG8_STAGE(PG8_SA(1, 0), a3, voffA);
            PG8_WAIT_V(8); PG8_WAIT_L(0); PG8_BAR; PG8_MMA(1, 0, At, B0); PG8_MMA(1, 1, At, B1); PG8_BAR; PG8_SCHED;
            } else {
            PG8_LDB(B0, 0, 0); PG8_SCHED; PG8_LDA(At, 0, 0); PG8_STAGE(PG8_SA(1, 1), a1 + hstep, voffA);
            PG8_WAIT_L(8); PG8_BAR; PG8_WAIT_L(0); PG8_MMA(0, 0, At, B0); PG8_BAR; PG8_SCHED;
            PG8_LDB(B1, 0, 1); PG8_STAGE(PG8_SB(0, 0), b2, voffB);
            PG8_BAR; PG8_WAIT_L(0); PG8_MMA(0, 1, At, B1); PG8_BAR;
            PG8_LDA(At, 0, 1); PG8_STAGE(PG8_SA(0, 0), a2, voffA);
            PG8_BAR; PG8_WAIT_L(0); PG8_MMA(1, 0, At, B0); PG8_BAR; PG8_SCHED;
            PG8_STAGE(PG8_SB(0, 1), b2 + hstep, voffB);
            PG8_WAIT_V(6); PG8_BAR; PG8_MMA(1, 1, At, B1); PG8_BAR;
            PG8_LDB(B0, 1, 0); PG8_SCHED; PG8_LDA(At, 1, 0); PG8_STAGE(PG8_SA(0, 1), a2 + hstep, voffA);
            PG8_WAIT_L(8); PG8_BAR; PG8_WAIT_L(0); PG8_MMA(0, 0, At, B0); PG8_BAR; PG8_SCHED;
            PG8_LDB(B1, 1, 1); PG8_STAGE(PG8_SB(1, 0), b3, voffB);
            PG8_BAR; PG8_WAIT_L(0); PG8_MMA(0, 1, At, B1); PG8_BAR;
            PG8_LDA(At, 1, 1); PG8_STAGE(PG8_SA(1, 0), a3, voffA);
            PG8_BAR; PG8_WAIT_L(0); PG8_MMA(1, 0, At, B0); PG8_BAR; PG8_SCHED;
            PG8_STAGE(PG8_SB(1, 1), b3 + hstep, voffB);
            PG8_WAIT_V(6); PG8_BAR; PG8_MMA(1, 1, At, B1); PG8_BAR;
            }
        }
        if constexpr (ALIGN_EPI) { if (wr == 0) PG8_BAR; }
        { Unit cu; cu.pm = UP_PM(cur); cu.pn = UP_PN(cur); cu.kt0 = UP_KT0(cur); cu.nkt = UP_NKT(cur); cu.split = UP_SPLIT(cur); E(acc, cu, wr, wc, fr, fq); }
        if (!has_next) break;
#pragma unroll
        for (int a = 0; a < 2; ++a)
#pragma unroll
            for (int b = 0; b < 2; ++b)
#pragma unroll
                for (int m = 0; m < 4; ++m)
#pragma unroll
                    for (int n = 0; n < 2; ++n) acc[a][b][m][n] = (f32x4){0.f, 0.f, 0.f, 0.f};
        cur = nxt; cA = nA; cB = nB; ++ui;
        if constexpr (ALIGN_EPI) { if (wr == 1) PG8_BAR; }
    }
    PG8_WAIT_V(0);
    if constexpr (!ALIGN_EPI) { if (wr == 0) PG8_BAR; }
    PG8_BAR;
#undef PG8_SA
#undef PG8_SB
#undef PG8_STAGE
#undef PG8_LDA
#undef PG8_LDB
#undef PG8_MMA
#undef PG8_WAIT_V
#undef PG8_WAIT_L
#undef PG8_BAR
#undef PG8_SCHED
}
}

__device__ __forceinline__ void p0_transpose_item(const float* W, int K, int N, bf16_t* WT, int k0, int n0, int drow0, LAS float* scr, int lane, const float* kscale = nullptr) {
    const float ks = kscale ? kscale[k0 + lane] : 1.f;
#pragma unroll 8
    for (int i = 0; i < 32; ++i) { const int kk = 2 * i + (lane >> 5); scr[kk * 33 + (lane & 31)] = W[(size_t)(k0 + kk) * N + n0 + (lane & 31)] * __shfl(ks, kk); }
    asm volatile("s_waitcnt lgkmcnt(0)" ::: "memory");
    const int c = lane & 7;
#pragma unroll
    for (int j = 0; j < 4; ++j) { const int n = (lane >> 3) + 8 * j; const LAS float* s = scr + (8 * c) * 33 + n;
        u32x4 o; o.x = pk2(s[0 * 33], s[1 * 33]); o.y = pk2(s[2 * 33], s[3 * 33]); o.z = pk2(s[4 * 33], s[5 * 33]); o.w = pk2(s[6 * 33], s[7 * 33]);
        *(u32x4*)(WT + (size_t)(drow0 + n) * K + k0 + 8 * c) = o; }
    asm volatile("s_waitcnt lgkmcnt(0)" ::: "memory");
}
__device__ __forceinline__ int win_dest_row(int n0) {
    if (n0 < 5120) return n0;
    if (n0 < 5152) return CDT + (n0 - 5120);
    if (n0 < 7200) { const int c = n0 - 5152; return CCF + 256 * (c >> 7) + (c & 127); }
    { const int c = n0 - 7200; return CCF + 256 * (c >> 7) + 128 + (c & 127); }
}
__device__ __forceinline__ void rms_row_to_bf16(const float* xrow, const float* w, bf16_t* orow, int lane) {
    f32x4 v[8], ww[8]; float s = 0.f;
#pragma unroll
    for (int j = 0; j < 8; ++j) { v[j] = *(const f32x4*)(xrow + (j * 64 + lane) * 4); ww[j] = *(const f32x4*)(w + (j * 64 + lane) * 4); }
#pragma unroll
    for (int j = 0; j < 8; ++j) s += (v[j].x * v[j].x + v[j].y * v[j].y) + (v[j].z * v[j].z + v[j].w * v[j].w);
    const float r = rsqrtf(wave_sum(s) * (1.f / DM) + EPS);
#pragma unroll
    for (int j = 0; j < 8; ++j) {
        u32x2 o; o.x = pk2(v[j].x * r * ww[j].x, v[j].y * r * ww[j].y); o.y = pk2(v[j].z * r * ww[j].z, v[j].w * r * ww[j].w);
        *(u32x2*)(orow + (j * 64 + lane) * 4) = o; }
}

template <int NT, bool SAMPLE>
__device__ __forceinline__ void ssdconv_item(const bf16_t* PROJ, int row0, bool has_hist, const float* st, int cgi, const float* w, const float* bias, bf16_t* XBC, float* state_out) {
    const int c0 = cgi * 8;
    float wv[4][8], bv[8], h0[8], h1[8], h2[8];
#pragma unroll
    for (int i = 0; i < 4; ++i) { const f32x4 a = *(const f32x4*)(w + i * XBCW + c0), b = *(const f32x4*)(w + i * XBCW + c0 + 4);
        wv[i][0] = a.x; wv[i][1] = a.y; wv[i][2] = a.z; wv[i][3] = a.w; wv[i][4] = b.x; wv[i][5] = b.y; wv[i][6] = b.z; wv[i][7] = b.w; }
    { const f32x4 a = *(const f32x4*)(bias + c0), b = *(const f32x4*)(bias + c0 + 4);
      bv[0] = a.x; bv[1] = a.y; bv[2] = a.z; bv[3] = a.w; bv[4] = b.x; bv[5] = b.y; bv[6] = b.z; bv[7] = b.w; }
    if (SAMPLE) {
#pragma unroll
        for (int e = 0; e < 8; ++e) { h0[e] = st[0 * XBCW + c0 + e]; h1[e] = st[1 * XBCW + c0 + e]; h2[e] = st[2 * XBCW + c0 + e]; }
    } else if (has_hist) {
        unpack8(*(const u32x4*)(PROJ + (size_t)(row0 - 3) * NPROJ + CXBC + c0), h0);
        unpack8(*(const u32x4*)(PROJ + (size_t)(row0 - 2) * NPROJ + CXBC + c0), h1);
        unpack8(*(const u32x4*)(PROJ + (size_t)(row0 - 1) * NPROJ + CXBC + c0), h2);
    } else {
#pragma unroll
        for (int e = 0; e < 8; ++e) { h0[e] = 0.f; h1[e] = 0.f; h2[e] = 0.f; }
    }
    u32x4 rows[NT];
#pragma unroll
    for (int t = 0; t < NT; ++t) rows[t] = *(const u32x4*)(PROJ + (size_t)(row0 + t) * NPROJ + CXBC + c0);
#pragma unroll
    for (int t = 0; t < NT; ++t) {
        float cur[8], o[8];
        unpack8(rows[t], cur);
#pragma unroll
        for (int e = 0; e < 8; ++e) { float v = h0[e] * wv[0][e] + h1[e] * wv[1][e] + h2[e] * wv[2][e] + cur[e] * wv[3][e] + bv[e]; o[e] = siluf_(v); h0[e] = h1[e]; h1[e] = h2[e]; h2[e] = cur[e]; }
        *(u32x4*)(XBC + (size_t)(row0 + t) * XBCW + c0) = pack8(o);
    }
    if (state_out) {
        *(f32x4*)(state_out + 0 * XBCW + c0) = (f32x4){h0[0], h0[1], h0[2], h0[3]}; *(f32x4*)(state_out + 0 * XBCW + c0 + 4) = (f32x4){h0[4], h0[5], h0[6], h0[7]};
        *(f32x4*)(state_out + 1 * XBCW + c0) = (f32x4){h1[0], h1[1], h1[2], h1[3]}; *(f32x4*)(state_out + 1 * XBCW + c0 + 4) = (f32x4){h1[4], h1[5], h1[6], h1[7]};
        *(f32x4*)(state_out + 2 * XBCW + c0) = (f32x4){h2[0], h2[1], h2[2], h2[3]}; *(f32x4*)(state_out + 2 * XBCW + c0 + 4) = (f32x4){h2[4], h2[5], h2[6], h2[7]};
    }
}

__device__ __forceinline__ void ssdconv_prompt_item(const bf16_t* PROJ, int row0, bool has_hist, int cgi, const float* w, const float* bias, bf16_t* XBC, float* state_out,
                                                    const float* DT, const float* CS, bf16_t* XT1, bf16_t* XT2, bf16_t* BT) {
    const int c0 = cgi * 8;
    float wv[4][8], bv[8], h0[8], h1[8], h2[8];
#pragma unroll
    for (int i = 0; i < 4; ++i) { const f32x4 a = *(const f32x4*)(w + i * XBCW + c0), b = *(const f32x4*)(w + i * XBCW + c0 + 4);
        wv[i][0] = a.x; wv[i][1] = a.y; wv[i][2] = a.z; wv[i][3] = a.w; wv[i][4] = b.x; wv[i][5] = b.y; wv[i][6] = b.z; wv[i][7] = b.w; }
    { const f32x4 a = *(const f32x4*)(bias + c0), b = *(const f32x4*)(bias + c0 + 4);
      bv[0] = a.x; bv[1] = a.y; bv[2] = a.z; bv[3] = a.w; bv[4] = b.x; bv[5] = b.y; bv[6] = b.z; bv[7] = b.w; }
    u32x4 rows[8], hr[3];
#pragma unroll
    for (int t = 0; t < 8; ++t) rows[t] = *(const u32x4*)(PROJ + (size_t)(row0 + t) * NPROJ + CXBC + c0);
    if (has_hist) {
#pragma unroll
        for (int i = 0; i < 3; ++i) hr[i] = *(const u32x4*)(PROJ + (size_t)(row0 - 3 + i) * NPROJ + CXBC + c0);
    } else {
#pragma unroll
        for (int i = 0; i < 3; ++i) hr[i] = (u32x4){0u, 0u, 0u, 0u};
    }
    const bool isx = cgi < 256, isb = (cgi >= 256 && cgi < 320);
    float f1[8], f2[8];
    if (isx) { const int h = cgi >> 3; const float csl = CS[(size_t)((row0 & ~127) + 127) * NH + h];
#pragma unroll
        for (int t = 0; t < 8; ++t) { const float d = DT[(size_t)(row0 + t) * NH + h]; const float c = CS[(size_t)(row0 + t) * NH + h]; f1[t] = d; f2[t] = d * __expf(csl - c); } }
    unpack8(hr[0], h0); unpack8(hr[1], h1); unpack8(hr[2], h2);
    float o[8][8];
#pragma unroll
    for (int t = 0; t < 8; ++t) {
        float cur[8];
        unpack8(rows[t], cur);
#pragma unroll
        for (int e = 0; e < 8; ++e) { float v = h0[e] * wv[0][e] + h1[e] * wv[1][e] + h2[e] * wv[2][e] + cur[e] * wv[3][e] + bv[e]; o[t][e] = siluf_(v); h0[e] = h1[e]; h1[e] = h2[e]; h2[e] = cur[e]; }
        *(u32x4*)(XBC + (size_t)(row0 + t) * XBCW + c0) = pack8(o[t]);
    }
    if (state_out) {
        *(f32x4*)(state_out + 0 * XBCW + c0) = (f32x4){h0[0], h0[1], h0[2], h0[3]}; *(f32x4*)(state_out + 0 * XBCW + c0 + 4) = (f32x4){h0[4], h0[5], h0[6], h0[7]};
        *(f32x4*)(state_out + 1 * XBCW + c0) = (f32x4){h1[0], h1[1], h1[2], h1[3]}; *(f32x4*)(state_out + 1 * XBCW + c0 + 4) = (f32x4){h1[4], h1[5], h1[6], h1[7]};
        *(f32x4*)(state_out + 2 * XBCW + c0) = (f32x4){h2[0], h2[1], h2[2], h2[3]}; *(f32x4*)(state_out + 2 * XBCW + c0 + 4) = (f32x4){h2[4], h2[5], h2[6], h2[7]};
    }
    const int chunk = row0 >> 7, jb = row0 & 127;
    if (isx) {
#pragma unroll
        for (int e = 0; e < 8; ++e) { u32x4 a, b2;
            a.x = pk2(o[0][e] * f1[0], o[1][e] * f1[1]); a.y = pk2(o[2][e] * f1[2], o[3][e] * f1[3]); a.z = pk2(o[4][e] * f1[4], o[5][e] * f1[5]); a.w = pk2(o[6][e] * f1[6], o[7][e] * f1[7]);
            b2.x = pk2(o[0][e] * f2[0], o[1][e] * f2[1]); b2.y = pk2(o[2][e] * f2[2], o[3][e] * f2[3]); b2.z = pk2(o[4][e] * f2[4], o[5][e] * f2[5]); b2.w = pk2(o[6][e] * f2[6], o[7][e] * f2[7]);
            const size_t off = ((size_t)chunk * DM + c0 + e) * 128 + jb;
            *(u32x4*)(XT1 + off) = a; *(u32x4*)(XT2 + off) = b2; }
    } else if (isb) {
#pragma unroll
        for (int e = 0; e < 8; ++e) { u32x4 a;
            a.x = pk2(o[0][e], o[1][e]); a.y = pk2(o[2][e], o[3][e]); a.z = pk2(o[4][e], o[5][e]); a.w = pk2(o[6][e], o[7][e]);
            *(u32x4*)(BT + ((size_t)chunk * 512 + (c0 - 2048) + e) * 128 + jb) = a; }
    }
}

__device__ __forceinline__ void cf_sample_item(const bf16_t* PROJ, int s, int c, const float* st, const float* cw, const float* cb, bf16_t* CONVOUT, float* state_out) {
    f32x2 xp[34], w[31];
    unsigned uv[4];
#pragma unroll
    for (int j = 0; j < 30; ++j) xp[j] = *(const f32x2*)(st + j * DM + c);
#pragma unroll
    for (int t = 0; t < 4; ++t) uv[t] = *(const unsigned*)(PROJ + (size_t)(MP + 4 * s + t) * NPROJ + CUCF + c);
#pragma unroll
    for (int i = 0; i < 31; ++i) w[i] = *(const f32x2*)(cw + i * DM + c);
    const f32x2 bias = *(const f32x2*)(cb + c);
#pragma unroll
    for (int t = 0; t < 4; ++t) { xp[30 + t].x = bf2f(uv[t] & 0xffffu); xp[30 + t].y = bf2f(uv[t] >> 16); }
#pragma unroll
    for (int t = 0; t < 4; ++t) { f32x2 acc = bias;
#pragma unroll
        for (int i = 0; i < 31; ++i) acc += xp[t + i] * w[i];
        *(unsigned*)(CONVOUT + (size_t)(MP + 4 * s + t) * DM + c) = pk2(acc.x, acc.y); }
#pragma unroll
    for (int i = 0; i < 30; ++i) *(f32x2*)(state_out + (size_t)i * DM + c) = xp[4 + i];
}

template <int J> struct CfLds {
    static __device__ __forceinline__ void run(float (&acc)[32], const float (&w)[31], const LAS float* us) {
        const float v = us[J * 512];
        constexpr int TLO = (J - 30 > 0) ? J - 30 : 0, THI = (J < 31) ? J : 31;
#pragma unroll
        for (int t = TLO; t <= THI; ++t) acc[t] += v * w[J - t];
        if constexpr (J + 1 < 62) CfLds<J + 1>::run(acc, w, us);
    }
};
__device__ __forceinline__ void cf_prompt_items(LAS unsigned char* lds, const bf16_t* PROJ, int it0, int itstride, int nitems, const float* cw, const float* cb, bf16_t* CONVOUT, float* pcfc) {
    const int tid = ltid(), w = __builtin_amdgcn_readfirstlane(tid >> 6), lane = tid & 63;
    LAS float* Us = (LAS float*)lds;
    if (it0 >= nitems) return;
    u32x4 av[8];
#define CF_LOAD(itx) do { const int r0_ = ((itx) >> 2) * 32, t0_ = r0_ % SEQ, cc_ = ((itx) & 3) * 512; \
        _Pragma("unroll") for (int i = 0; i < 8; ++i) { const int j = w + 8 * i, tt = j - 30; \
            if (j < 62 && t0_ + tt >= 0) av[i] = *(const u32x4*)(PROJ + (size_t)(r0_ + tt) * NPROJ + CUCF + cc_ + lane * 8); \
            else av[i] = (u32x4){0u, 0u, 0u, 0u}; } } while (0)
    CF_LOAD(it0);
    for (int it = it0; it < nitems; it += itstride) {
        const int row0 = (it >> 2) * 32, t0 = row0 % SEQ, b = row0 / SEQ, c0 = (it & 3) * 512;
        float* state_out = (t0 == SEQ - 32) ? pcfc + (size_t)b * 30 * DM : nullptr;
        float wv[31];
#pragma unroll
        for (int i = 0; i < 31; ++i) wv[i] = cw[i * DM + c0 + tid];
        const float bias = cb[c0 + tid];
#pragma unroll
        for (int i = 0; i < 8; ++i) { const int j = w + 8 * i;
            if (j < 62) { float a[8]; unpack8(av[i], a);
                const f32x4 u0 = (f32x4){a[0], a[1], a[2], a[3]}, u1 = (f32x4){a[4], a[5], a[6], a[7]};
                *(LAS f32x4*)(Us + j * 512 + lane * 8) = u0; *(LAS f32x4*)(Us + j * 512 + lane * 8 + 4) = u1;
                if (state_out && j >= 32) { float* sp = state_out + (size_t)(j - 32) * DM + c0 + lane * 8; *(f32x4*)sp = u0; *(f32x4*)(sp + 4) = u1; } } }
        LDS_BARRIER();
        if (it + itstride < nitems) CF_LOAD(it + itstride);
        float acc[32];
#pragma unroll
        for (int t = 0; t < 32; ++t) acc[t] = bias;
        CfLds<0>::run(acc, wv, Us + tid);
#pragma unroll
        for (int t = 0; t < 32; ++t) CONVOUT[(size_t)(row0 + t) * DM + c0 + tid] = (bf16_t)f2bf(acc[t]);
        LDS_BARRIER();
    }
#undef CF_LOAD
}

constexpr int LDP = 136;
constexpr int Q_B = 0, Q_BT = 34816, Q_X1 = 69632, Q_X2 = 87040, Q_H = 104448, Q_CS = 121856;

#define MFMA16(a, b, c) __builtin_amdgcn_mfma_f32_16x16x32_bf16((a), (b), (c), 0, 0, 0)

__device__ __forceinline__ void ssd_prompt(LAS unsigned char* lds, int b, int h, const bf16_t* XBC, const float* CS, const bf16_t* XT1, const bf16_t* XT2, const bf16_t* BT, bf16_t* MIX, float* p_ssm) {
    const int tid = ltid(), w = __builtin_amdgcn_readfirstlane(tid >> 6), lane = tid & 63, fr = lane & 15, fq = lane >> 4;
    const int g = h >> 3;
    const int rt = (w < 4) ? w : 11 - w;
    LAS bf16_t* Bs = (LAS bf16_t*)(lds + Q_B); LAS bf16_t* BTs = (LAS bf16_t*)(lds + Q_BT);
    LAS bf16_t* X1s = (LAS bf16_t*)(lds + Q_X1); LAS bf16_t* X2s = (LAS bf16_t*)(lds + Q_X2); LAS bf16_t* Hs = (LAS bf16_t*)(lds + Q_H);
    LAS float* css_all = (LAS float*)(lds + Q_CS);
    for (int i = tid; i < 64 * LDP / 2; i += 512) ((LAS unsigned*)Hs)[i] = 0u;
#pragma unroll
    for (int i = 0; i < 4; ++i) { const int j = tid + 512 * i; css_all[j] = CS[(size_t)(b * SEQ + j) * NH + h]; }
    f32x4 hacc[4];
#pragma unroll
    for (int pt = 0; pt < 4; ++pt) hacc[pt] = (f32x4){0.f, 0.f, 0.f, 0.f};
    u32x4 Bv[4], BTv[4], X1v[2], X2v[2]; bf16x8 afn[4];
#define SSD_PREFETCH(cidx) do { const int rb_ = b * SEQ + (cidx) * 128; const size_t ci_ = (size_t)(b * (SEQ / 128) + (cidx)); \
        _Pragma("unroll") for (int i = 0; i < 4; ++i) { const int idx = tid + 512 * i, rr = idx >> 4, ch = idx & 15; \
            Bv[i] = *(const u32x4*)(XBC + (size_t)(rb_ + rr) * XBCW + 2048 + g * 128 + ch * 8); BTv[i] = *(const u32x4*)(BT + (ci_ * 512 + g * 128 + rr) * 128 + ch * 8); } \
        _Pragma("unroll") for (int i = 0; i < 2; ++i) { const int idx = tid + 512 * i, rr = idx >> 4, ch = idx & 15; \
            X1v[i] = *(const u32x4*)(XT1 + (ci_ * DM + h * 64 + rr) * 128 + ch * 8); X2v[i] = *(const u32x4*)(XT2 + (ci_ * DM + h * 64 + rr) * 128 + ch * 8); } \
        _Pragma("unroll") for (int ks = 0; ks < 4; ++ks) afn[ks] = *(const bf16x8*)(XBC + (size_t)(rb_ + 16 * rt + fr) * XBCW + 2560 + g * 128 + ks * 32 + fq * 8); } while (0)
    SSD_PREFETCH(0);
    LDS_BARRIER();
    for (int c = 0; c < SEQ / 128; ++c) {
        const int rowbase = b * SEQ + c * 128;
        LAS float* css = css_all + c * 128;
        const float cs_last = css[127];
#pragma unroll
        for (int i = 0; i < 4; ++i) { const int idx = tid + 512 * i, rr = idx >> 4, ch = idx & 15;
            *(LAS u32x4*)(Bs + rr * LDP + ch * 8) = Bv[i]; *(LAS u32x4*)(BTs + rr * LDP + ch * 8) = BTv[i]; }
#pragma unroll
        for (int i = 0; i < 2; ++i) { const int idx = tid + 512 * i, rr = idx >> 4, ch = idx & 15;
            *(LAS u32x4*)(X1s + rr * LDP + ch * 8) = X1v[i]; *(LAS u32x4*)(X2s + rr * LDP + ch * 8) = X2v[i]; }
        bf16x8 afr[4];
#pragma unroll
        for (int ks = 0; ks < 4; ++ks) afr[ks] = afn[ks];
        if (c + 1 < SEQ / 128) SSD_PREFETCH(c + 1);
        LDS_BARRIER();
        u32x2 cbm[8];
        const float csi = css[16 * rt + fr];
#pragma unroll
        for (int jt = 0; jt < 8; ++jt) {
            cbm[jt] = (u32x2){0u, 0u};
            if (jt <= rt) {
                f32x4 a4 = (f32x4){0.f, 0.f, 0.f, 0.f};
#pragma unroll
                for (int ks = 0; ks < 4; ++ks) { const bf16x8 bb = *(const LAS bf16x8*)(Bs + (16 * jt + fr) * LDP + ks * 32 + fq * 8); a4 = MFMA16(bb, afr[ks], a4); }
                const f32x4 csj = *(const LAS f32x4*)(css + 16 * jt + 4 * fq);
                const int i = 16 * rt + fr, j0 = 16 * jt + 4 * fq;
#pragma unroll
                for (int r = 0; r < 4; ++r) a4[r] = (j0 + r <= i) ? a4[r] * __expf(csi - csj[r]) : 0.f;
                cbm[jt].x = pk2(a4[0], a4[1]); cbm[jt].y = pk2(a4[2], a4[3]);
            }
        }
        LDS_BARRIER();
        LAS bf16_t* Ms = Bs;
#pragma unroll
        for (int jt = 0; jt < 8; ++jt) if (jt <= (rt | 1)) {
            *(LAS u32x2*)(Ms + (16 * rt + fr) * LDP + 16 * jt + 4 * fq) = cbm[jt];
        }
        asm volatile("s_waitcnt lgkmcnt(0)" ::: "memory");
        f32x4 yacc[4];
#pragma unroll
        for (int pt = 0; pt < 4; ++pt) yacc[pt] = (f32x4){0.f, 0.f, 0.f, 0.f};
#pragma unroll
        for (int ks = 0; ks < 4; ++ks)
#pragma unroll
            for (int pt = 0; pt < 4; ++pt) { const bf16x8 bb = *(const LAS bf16x8*)(Hs + (16 * pt + fr) * LDP + ks * 32 + fq * 8); yacc[pt] = MFMA16(bb, afr[ks], yacc[pt]); }
        { const float e = __expf(csi);
#pragma unroll
          for (int pt = 0; pt < 4; ++pt) yacc[pt] *= e; }
#pragma unroll
        for (int ks = 0; ks < 4; ++ks) if (ks <= (rt >> 1)) {
            const bf16x8 am = *(const LAS bf16x8*)(Ms + (16 * rt + fr) * LDP + ks * 32 + fq * 8);
#pragma unroll
            for (int pt = 0; pt < 4; ++pt) { const bf16x8 bb = *(const LAS bf16x8*)(X1s + (16 * pt + fr) * LDP + ks * 32 + fq * 8); yacc[pt] = MFMA16(bb, am, yacc[pt]); }
        }
#pragma unroll
        for (int pt = 0; pt < 4; ++pt) { u32x2 pk; pk.x = pk2(yacc[pt][0], yacc[pt][1]); pk.y = pk2(yacc[pt][2], yacc[pt][3]);
            *(u32x2*)(MIX + (size_t)(rowbase + 16 * rt + fr) * DMIX + h * 64 + 16 * pt + 4 * fq) = pk; }
        { const float dl = __expf(cs_last);
#pragma unroll
          for (int pt = 0; pt < 4; ++pt) hacc[pt] *= dl; }
#pragma unroll
        for (int ks = 0; ks < 4; ++ks) { const bf16x8 bb = *(const LAS bf16x8*)(BTs + (16 * w + fr) * LDP + ks * 32 + fq * 8);
#pragma unroll
            for (int pt = 0; pt < 4; ++pt) { const bf16x8 aa = *(const LAS bf16x8*)(X2s + (16 * pt + fr) * LDP + ks * 32 + fq * 8); hacc[pt] = MFMA16(bb, aa, hacc[pt]); } }
        LDS_BARRIER();
#pragma unroll
        for (int pt = 0; pt < 4; ++pt) { u32x2 pk; pk.x = pk2(hacc[pt][0], hacc[pt][1]); pk.y = pk2(hacc[pt][2], hacc[pt][3]);
            *(LAS u32x2*)(Hs + (16 * pt + fr) * LDP + 16 * w + 4 * fq) = pk; }
    }
#undef SSD_PREFETCH
#pragma unroll
    for (int pt = 0; pt < 4; ++pt) *(f32x4*)(p_ssm + ((size_t)(b * NH + h) * HP + 16 * pt + fr) * NS + 16 * w + 4 * fq) = hacc[pt];
    LDS_BARRIER();
}

__device__ __forceinline__ void ssd_sample_items(LAS unsigned char* lds, int it0, int itstride, int nitems, const bf16_t* XBC, const float* DT, const float* a_log,
                                                 const float* state_in, bf16_t* MIX, float* s_ssm) {
    const int tid = ltid(), w = __builtin_amdgcn_readfirstlane(tid >> 6), lane = tid & 63, nl = lane & 31, half = lane >> 5;
    LAS float* Xs = (LAS float*)lds;
    if (it0 >= nitems) return;
    f32x4 nx[16];
    { const int b = it0 >> 2, g = it0 & 3, h = g * 8 + w; const float* sp = state_in + (size_t)(b * NH + h) * HP * NS;
#pragma unroll
      for (int k = 0; k < 16; ++k) nx[k] = *(const f32x4*)(sp + k * 256 + lane * 4); }
    for (int it = it0; it < nitems; it += itstride) {
        const int b = it >> 2, g = it & 3, h = g * 8 + w;
        u32x2 Bp[4], Cp[4]; float dtv[4];
#pragma unroll
        for (int t = 0; t < 4; ++t) { const size_t row = (size_t)(MP + 4 * b + t);
            Xs[t * 512 + tid] = bf2f(XBC[row * XBCW + g * 512 + tid]);
            Bp[t] = *(const u32x2*)(XBC + row * XBCW + 2048 + g * 128 + 4 * nl); Cp[t] = *(const u32x2*)(XBC + row * XBCW + 2560 + g * 128 + 4 * nl);
            dtv[t] = DT[row * NH + h]; }
        const float A = -__expf(a_log[h]);
        LDS_BARRIER();
#pragma unroll
        for (int hh = 0; hh < 2; ++hh) {
            f32x4 st[16];
#pragma unroll
            for (int k = 0; k < 16; ++k) st[k] = nx[k];
            {
                const int itn = it + itstride;
                if (hh == 0) { const float* sp = state_in + (size_t)(b * NH + h) * HP * NS + 4096;
#pragma unroll
                    for (int k = 0; k < 16; ++k) nx[k] = *(const f32x4*)(sp + k * 256 + lane * 4); }
                else if (itn < nitems) { const int bn = itn >> 2, gn = itn & 3; const float* sp = state_in + (size_t)(bn * NH + gn * 8 + w) * HP * NS;
#pragma unroll
                    for (int k = 0; k < 16; ++k) nx[k] = *(const f32x4*)(sp + k * 256 + lane * 4); }
            }
            float yv[4];
#pragma unroll
            for (int t = 0; t < 4; ++t) {
                const float dt = dtv[t]; const float da = __expf(dt * A);
                const f32x4 Bt = (f32x4){bf2f(Bp[t].x & 0xffffu), bf2f(Bp[t].x >> 16), bf2f(Bp[t].y & 0xffffu), bf2f(Bp[t].y >> 16)} * dt;
                const f32x4 Ct = (f32x4){bf2f(Cp[t].x & 0xffffu), bf2f(Cp[t].x >> 16), bf2f(Cp[t].y & 0xffffu), bf2f(Cp[t].y >> 16)};
                float part[8];
                { const bool up8 = (nl & 8) != 0;
#pragma unroll
                  for (int i = 0; i < 8; ++i) {
                    const float x0 = Xs[t * 512 + w * 64 + 32 * hh + 2 * i + half], x1 = Xs[t * 512 + w * 64 + 32 * hh + 2 * (i + 8) + half];
                    st[i] = st[i] * da + Bt * x0; st[i + 8] = st[i + 8] * da + Bt * x1;
                    const f32x4 q0 = Ct * st[i], q1 = Ct * st[i + 8];
                    const float p0 = (q0.x + q0.y) + (q0.z + q0.w), p1 = (q1.x + q1.y) + (q1.z + q1.w);
                    const float send = up8 ? p0 : p1, keep = up8 ? p1 : p0; part[i] = keep + __shfl_xor(send, 8); } }
#define BFLY(o) do { const bool up = (nl & (o)) != 0; _Pragma("unroll") for (int i = 0; i < (o); ++i) { \
                    const float send = up ? part[i] : part[i + (o)]; const float keep = up ? part[i + (o)] : part[i]; part[i] = keep + __shfl_xor(send, (o)); } } while (0)
                BFLY(4); BFLY(2); BFLY(1);
#undef BFLY
                yv[t] = part[0] + __shfl_xor(part[0], 16);
            }
            const int pout = 32 * hh + 2 * (nl & 15) + half;
            if ((nl & 16) == 0) {
#pragma unroll
                for (int t = 0; t < 4; ++t) MIX[(size_t)(MP + 4 * b + t) * DMIX + h * 64 + pout] = (bf16_t)f2bf(yv[t]);
            }
            float* op = s_ssm + (size_t)(b * NH + h) * HP * NS + hh * 4096;
#pragma unroll
            for (int k = 0; k < 16; ++k) *(f32x4*)(op + k * 256 + lane * 4) = st[k];
        }
        LDS_BARRIER();
    }
}

__device__ __forceinline__ void mix_finalize_ssd(size_t row, bf16_t* MIX, const bf16_t* XBC, const bf16_t* PROJ, const float* d_skip, const float* ssd_norm_w, int lane, bf16_t* ssd_dst) {
    bf16_t* mp = MIX + row * DMIX;
    {
        u32x4 yv[4], xv[4], zv[4]; float dsk[4];
#pragma unroll
        for (int k = 0; k < 4; ++k) { const int c = (k * 64 + lane) * 8;
            yv[k] = *(const u32x4*)(mp + c); xv[k] = *(const u32x4*)(XBC + row * XBCW + c); zv[k] = *(const u32x4*)(PROJ + row * NPROJ + CZ + c);
            dsk[k] = d_skip[c >> 6]; }
        float s = 0.f;
#pragma unroll
        for (int k = 0; k < 4; ++k) { float f[8], xf[8], zf[8]; unpack8(yv[k], f); unpack8(xv[k], xf); unpack8(zv[k], zf);
#pragma unroll
            for (int e = 0; e < 8; ++e) { f[e] = (f[e] + dsk[k] * xf[e]) * siluf_(zf[e]); s += f[e] * f[e]; }
            yv[k] = pack8(f); }
        const float r = rsqrtf(wave_sum(s) * (1.f / DM) + EPS);
#pragma unroll 1
        for (int k = 0; k < 4; ++k) { const int c = (k * 64 + lane) * 8;
            const f32x4 w0 = *(const f32x4*)(ssd_norm_w + c), w1 = *(const f32x4*)(ssd_norm_w + c + 4);
            const u32x4 yk = (k == 0) ? yv[0] : (k == 1) ? yv[1] : (k == 2) ? yv[2] : yv[3];
            float f[8]; unpack8(yk, f);
            float o[8]; o[0] = f[0] * r * w0.x; o[1] = f[1] * r * w0.y; o[2] = f[2] * r * w0.z; o[3] = f[3] * r * w0.w;
            o[4] = f[4] * r * w1.x; o[5] = f[5] * r * w1.y; o[6] = f[6] * r * w1.z; o[7] = f[7] * r * w1.w;
            *(u32x4*)(ssd_dst + c) = pack8(o); }
    }
}
__device__ __forceinline__ void mix_finalize_conformer(size_t row, bf16_t* MIX, const bf16_t* CONVOUT, const float* ln_w, const float* ln_b, int lane) {
    bf16_t* mp = MIX + row * DMIX;
    {
        const bf16_t* cp = CONVOUT + row * DM;
        f32x4 v[8], ww[8], bb[8];
#pragma unroll
        for (int k = 0; k < 8; ++k) { const u32x2 cv = *(const u32x2*)(cp + (k * 64 + lane) * 4); v[k] = (f32x4){bf2f(cv.x & 0xffffu), bf2f(cv.x >> 16), bf2f(cv.y & 0xffffu), bf2f(cv.y >> 16)};
            ww[k] = *(const f32x4*)(ln_w + (k * 64 + lane) * 4); bb[k] = *(const f32x4*)(ln_b + (k * 64 + lane) * 4); }
        float s = 0.f;
#pragma unroll
        for (int k = 0; k < 8; ++k) s += (v[k].x + v[k].y) + (v[k].z + v[k].w);
        const float mean = wave_sum(s) * (1.f / DM); float q = 0.f;
#pragma unroll
        for (int k = 0; k < 8; ++k) { v[k] = v[k] - mean; q += (v[k].x * v[k].x + v[k].y * v[k].y) + (v[k].z * v[k].z + v[k].w * v[k].w); }
        const float rstd = rsqrtf(wave_sum(q) * (1.f / DM) + EPS);
#pragma unroll
        for (int k = 0; k < 8; ++k) {
            const f32x4 o = v[k] * rstd * ww[k] + bb[k];
            u32x2 pk; pk.x = pk2(siluf_(o.x), siluf_(o.y)); pk.y = pk2(siluf_(o.z), siluf_(o.w));
            *(u32x2*)(mp + DM + (k * 64 + lane) * 4) = pk; }
    }
}

template <int NT, bool SAMPLE>
__device__ __forceinline__ void ffn_item(const bf16_t* U, int row0, bool has_hist, const float* st, int cgi, const float* w, const float* bias, bf16_t* ACT, float* state_out) {
    const int c0 = cgi * 8;
    float wg[3][8], wv[3][8], bg[8], bvv[8], g0[8], g1[8], v0[8], v1[8];
#define LD8(dst, ptr) do { const f32x4 a_ = *(const f32x4*)(ptr), b_ = *(const f32x4*)((ptr) + 4); dst[0] = a_.x; dst[1] = a_.y; dst[2] = a_.z; dst[3] = a_.w; dst[4] = b_.x; dst[5] = b_.y; dst[6] = b_.z; dst[7] = b_.w; } while (0)
#pragma unroll
    for (int i = 0; i < 3; ++i) { LD8(wg[i], w + i * FF2 + c0); LD8(wv[i], w + i * FF2 + FF + c0); }
    LD8(bg, bias + c0); LD8(bvv, bias + FF + c0);
    if (SAMPLE) {
        LD8(g0, st + 0 * FF2 + c0); LD8(g1, st + 1 * FF2 + c0); LD8(v0, st + 0 * FF2 + FF + c0); LD8(v1, st + 1 * FF2 + FF + c0);
    } else if (has_hist) {
        unpack8(*(const u32x4*)(U + (size_t)(row0 - 2) * FF2 + c0), g0); unpack8(*(const u32x4*)(U + (size_t)(row0 - 1) * FF2 + c0), g1);
        unpack8(*(const u32x4*)(U + (size_t)(row0 - 2) * FF2 + FF + c0), v0); unpack8(*(const u32x4*)(U + (size_t)(row0 - 1) * FF2 + FF + c0), v1);
    } else {
#pragma unroll
        for (int e = 0; e < 8; ++e) { g0[e] = 0.f; g1[e] = 0.f; v0[e] = 0.f; v1[e] = 0.f; }
    }
#undef LD8
    u32x4 rg[NT], rv[NT];
#pragma unroll
    for (int t = 0; t < NT; ++t) { rg[t] = *(const u32x4*)(U + (size_t)(row0 + t) * FF2 + c0); rv[t] = *(const u32x4*)(U + (size_t)(row0 + t) * FF2 + FF + c0); }
#pragma unroll
    for (int t = 0; t < NT; ++t) {
        float cg_[8], cv_[8], o[8];
        unpack8(rg[t], cg_); unpack8(rv[t], cv_);
#pragma unroll
        for (int e = 0; e < 8; ++e) {
            const float gg = g0[e] * wg[0][e] + g1[e] * wg[1][e] + cg_[e] * wg[2][e] + bg[e];
            const float vv = v0[e] * wv[0][e] + v1[e] * wv[1][e] + cv_[e] * wv[2][e] + bvv[e];
            o[e] = siluf_(gg) * vv; g0[e] = g1[e]; g1[e] = cg_[e]; v0[e] = v1[e]; v1[e] = cv_[e]; }
        *(u32x4*)(ACT + (size_t)(row0 + t) * FF + c0) = pack8(o);
    }
    if (state_out) {
#define ST8(ptr, src) do { *(f32x4*)(ptr) = (f32x4){src[0], src[1], src[2], src[3]}; *(f32x4*)((ptr) + 4) = (f32x4){src[4], src[5], src[6], src[7]}; } while (0)
        ST8(state_out + 0 * FF2 + c0, g0); ST8(state_out + 1 * FF2 + c0, g1); ST8(state_out + 0 * FF2 + FF + c0, v0); ST8(state_out + 1 * FF2 + FF + c0, v1);
#undef ST8
    }
}


#define XB_TMO      128
#define XB_XCNT(j)  (256  + 64 * (j))
#define XB_XSUB(j)  (1280 + 64 * (j))
#define XB_XGEN(j)  (2304 + 64 * (j))
#define XB_TOP      3328
#define XB_TOPGEN   3392
#define XCD_BAR_WORDS 3456
#define XB_SPIN_CAP (1u << 18)
__device__ __forceinline__ unsigned xb_ld(unsigned* p)              { return __hip_atomic_load(p, __ATOMIC_RELAXED, __HIP_MEMORY_SCOPE_AGENT); }
__device__ __forceinline__ unsigned xb_add(unsigned* p, unsigned v) { return __hip_atomic_fetch_add(p, v, __ATOMIC_RELAXED, __HIP_MEMORY_SCOPE_AGENT); }
__device__ __forceinline__ unsigned xb_xcc_id() { return (unsigned)__builtin_amdgcn_s_getreg((3 << 11) | 20) & 0xFu; }
#define XB_SPIN(cond, bar) do { unsigned _sp = 0; while (cond) { __builtin_amdgcn_s_sleep(1); \
    if ((++_sp & 255u) == 0u) { if (xb_ld(&(bar)[XB_TMO])) break; if (_sp > XB_SPIN_CAP) { atomicAdd(&(bar)[XB_TMO], 1u); break; } } } } while (0)
struct XcdBarrier { unsigned* bar; unsigned x; volatile LAS unsigned* st; };
__device__ __forceinline__ XcdBarrier xcd_barrier_post(unsigned* bar, volatile LAS unsigned* st) {
    XcdBarrier b; b.bar = bar; b.x = xb_xcc_id(); b.st = st;
    if (threadIdx.x == 0) (void)xb_add(&bar[XB_XCNT(b.x)], 1u);
    return b;
}
__device__ __forceinline__ void xcd_barrier_complete(unsigned* bar, unsigned x, unsigned& nloc, unsigned& nx) {
    const unsigned G = gridDim.x * gridDim.y * gridDim.z;
    unsigned sum, cnt, mine, sp = 0u;
    for (;;) {
        sum = 0u; cnt = 0u; mine = 0u;
#pragma unroll
        for (unsigned j = 0; j < 16; ++j) { const unsigned c = xb_ld(&bar[XB_XCNT(j)]); sum += c; cnt += (c > 0u) ? 1u : 0u; mine = (j == x) ? c : mine; }
        if (sum == G) break;
        __builtin_amdgcn_s_sleep(1);
        if ((++sp & 255u) == 0u) { if (xb_ld(&bar[XB_TMO])) break; if (sp > XB_SPIN_CAP) { atomicAdd(&bar[XB_TMO], 1u); break; } }
    }
    nloc = mine > 0u ? mine : 1u; nx = cnt > 0u ? cnt : 1u;
}
__device__ __forceinline__ void xcd_barrier(const XcdBarrier& b) {
    asm volatile("s_waitcnt vmcnt(0)" ::: "memory");
    __syncthreads();
    if (threadIdx.x == 0) {
        unsigned* bar = b.bar;
        __builtin_amdgcn_s_waitcnt(0);
        unsigned nloc = b.st[0], nx = b.st[1];
        if (nloc == 0u) { xcd_barrier_complete(bar, b.x, nloc, nx); b.st[0] = nloc; b.st[1] = nx; }
        const unsigned old = xb_add(&bar[XB_XSUB(b.x)], 1u);
        const unsigned gen = old / nloc;
        if (old + 1u == (gen + 1u) * nloc) {
            __builtin_amdgcn_fence(__ATOMIC_RELEASE, "agent");
            asm volatile("s_waitcnt vmcnt(0)" ::: "memory");
            const unsigned og = xb_add(&bar[XB_TOP], 1u);
            const unsigned tg = og / nx;
            if (og + 1u == (tg + 1u) * nx) xb_add(&bar[XB_TOPGEN], 1u);
            else XB_SPIN(xb_ld(&bar[XB_TOPGEN]) == tg, bar);
            __builtin_amdgcn_fence(__ATOMIC_ACQUIRE, "agent");
            xb_add(&bar[XB_XGEN(b.x)], 1u);
            asm volatile("s_waitcnt vmcnt(0)" ::: "memory");
        } else {
            XB_SPIN(xb_ld(&bar[XB_XGEN(b.x)]) == gen, bar);
            __builtin_amdgcn_fence(__ATOMIC_ACQUIRE, "agent");
            asm volatile("s_waitcnt vmcnt(0)" ::: "memory");
        }
    }
    __syncthreads();
}

struct Args { const float* in[25]; float* out_p; unsigned char* ws_p; int ph_lo, ph_hi, li, pad; };
constexpr int N_PHASES = 11;
typedef const __attribute__((address_space(4))) Args* KArgs;
__device__ __forceinline__ KArgs ka_get() { KArgs p = (KArgs)__builtin_amdgcn_kernarg_segment_ptr(); asm volatile("" : "+s"(p)); return p; }

__global__ void __launch_bounds__(512, 2) mk_fwd(Args args) {
    extern __shared__ __attribute__((aligned(16))) unsigned char lds_raw[];
    LAS unsigned char* lds = (LAS unsigned char*)lds_raw;
    const int tid = ltid(), lane = tid & 63, wave = __builtin_amdgcn_readfirstlane(tid >> 6);
    const int G = gridDim.x, bx = blockIdx.x;
    const int lo = args.ph_lo, hi = args.ph_hi;
#define x_prompt ((const float*)KA->in[0])
#define x_sample ((const float*)KA->in[1])
#define state_ssm ((const float*)KA->in[2])
#define state_ssdc ((const float*)KA->in[3])
#define state_cfc ((const float*)KA->in[4])
#define state_ffc ((const float*)KA->in[5])
#define norm_mix_w ((const float*)KA->in[6])
#define w_in ((const float*)KA->in[7])
#define ssd_conv_w ((const float*)KA->in[8])
#define ssd_conv_b ((const float*)KA->in[9])
#define dt_bias ((const float*)KA->in[10])
#define a_log ((const float*)KA->in[11])
#define d_skip ((const float*)KA->in[12])
#define ssd_norm_w ((const float*)KA->in[13])
#define cf_conv_w ((const float*)KA->in[14])
#define cf_conv_b ((const float*)KA->in[15])
#define cf_ln_w ((const float*)KA->in[16])
#define cf_ln_b ((const float*)KA->in[17])
#define w_out ((const float*)KA->in[18])
#define norm_ffn_w ((const float*)KA->in[19])
#define w_up ((const float*)KA->in[20])
#define ffn_conv_w ((const float*)KA->in[21])
#define ffn_conv_b ((const float*)KA->in[22])
#define w_down ((const float*)KA->in[23])
#define norm_final_w ((const float*)KA->in[24])
#define out ((float*)KA->out_p)
#define ws ((unsigned char*)KA->ws_p)
#define WinT ((bf16_t*)(ws + WS_WIN))
#define WoutT ((bf16_t*)(ws + WS_WOUT))
#define WupT ((bf16_t*)(ws + WS_WUP))
#define WdnT ((bf16_t*)(ws + WS_WDN))
#define XN ((bf16_t*)(ws + WS_XN))
#define DT ((float*)(ws + WS_DT))
#define PROJ ((bf16_t*)(ws + WS_PROJ))
#define XBC ((bf16_t*)(ws + WS_XBC))
#define U ((bf16_t*)(ws + WS_U))
#define CONVOUT ((bf16_t*)(ws + WS_CONV))
#define MIX ((bf16_t*)(ws + WS_MIX))
#define ACT ((bf16_t*)(ws + WS_ACT))
#define PART ((float*)(ws + WS_RA))
    constexpr int S2 = 8, S4 = 7;

#ifndef PHASE_MASK
#define PHASE_MASK 0x7ff
#endif
#define IN(k) (((PHASE_MASK >> (k)) & 1) && lo <= (k) && (k) < hi)
    volatile LAS unsigned* bst = (volatile LAS unsigned*)(lds + LDS_BYTES - 64);
    if (tid < 2) bst[tid] = 0u;
    __syncthreads();
    const KArgs KA0 = ka_get();
    const XcdBarrier gbar = xcd_barrier_post((unsigned*)((unsigned char*)KA0->ws_p + WS_CTL) + (args.li & 0xff) * XCD_BAR_WORDS, bst);
    const int psel = args.li >> 8;
    if (args.pad != 0) cg::this_grid().sync();
#define SEAM(k) do { if (IN(k) && IN((k) + 1)) xcd_barrier(gbar); } while (0)

    if (IN(0)) { const KArgs KA = ka_get(); const int tid = ltid(), lane = tid & 63, wave = __builtin_amdgcn_readfirstlane(tid >> 6); (void)lane; (void)wave;
        LAS float* scr = (LAS float*)(lds + wave * 16384);
        const int gw = bx * 8 + wave, NGW = G * 8;
        constexpr int I_IN = (DM / 64) * (9248 / 32), I_OUT = (DMIX / 64) * (DM / 32), I_UP = (DM / 64) * (FF2 / 32), I_DN = (FF / 64) * (DM / 32);
        for (int it = gw; it < I_IN + I_OUT + I_UP + I_DN; it += NGW) {
            int r = it;
            if (r < I_IN) { const int nblk = 9248 / 32, kb = r / nblk, nb = r % nblk; p0_transpose_item(w_in, DM, 9248, WinT, 64 * kb, 32 * nb, win_dest_row(32 * nb), scr, lane); continue; } r -= I_IN;
            if (r < I_OUT) { const int nblk = DM / 32, kb = r / nblk, nb = r % nblk; p0_transpose_item(w_out, DMIX, DM, WoutT, 64 * kb, 32 * nb, 32 * nb, scr, lane); continue; } r -= I_OUT;
            if (r < I_UP) { const int nblk = FF2 / 32, kb = r / nblk, nb = r % nblk; p0_transpose_item(w_up, DM, FF2, WupT, 64 * kb, 32 * nb, 32 * nb, scr, lane, norm_ffn_w); continue; } r -= I_UP;
            { const int nblk = DM / 32, kb = r / nblk, nb = r % nblk; p0_transpose_item(w_down, FF, DM, WdnT, 64 * kb, 32 * nb, 32 * nb, scr, lane); }
        }
        for (int m = gw; m < MT; m += NGW) { const float* xr = (m < MP) ? x_prompt + (size_t)m * DM : x_sample + (size_t)(m - MP) * DM; rms_row_to_bf16(xr, norm_mix_w, XN + (size_t)m * DM, lane); }
    }
    SEAM(0);
    if (IN(1)) { const KArgs KA = ka_get(); const int tid = ltid(), lane = tid & 63, wave = __builtin_amdgcn_readfirstlane(tid >> 6); (void)lane; (void)wave;
        pg8::Gemm g{XN, WinT, MT, NPROJ, DM}; pg8::StaticOrder S; S.init(MT, NPROJ, G, bx, DM);
        pg8::EpiBf16 E{PROJ, NPROJ, nullptr, CCF / 256, CUCF};
        pg8::gemm_phase<pg8::EpiBf16, pg8::StaticOrder, true, true>(lds, g, S, E);
    }
    SEAM(1);
    if (IN(2)) { const KArgs KA = ka_get(); const int tid = ltid(), lane = tid & 63, wave = __builtin_amdgcn_readfirstlane(tid >> 6); (void)lane; (void)wave;
        bf16_t* XT1 = (bf16_t*)(ws + WS_XT1); bf16_t* XT2 = (bf16_t*)((unsigned char*)out + OS_XT2); bf16_t* BT = (bf16_t*)((unsigned char*)out + OS_BT); float* CS = (float*)((unsigned char*)out + OS_CS);
        {   const int gw = bx * 8 + wave, NGW = G * 8;
            for (int it = gw; it < 64 * NH + (MS * NH) / 64; it += NGW) {
                if (it < 64 * NH) { const int ci = it >> 5, h = it & 31, rb = ci * 128;
                    const float bias = dt_bias[h], A = -__expf(a_log[h]);
                    const float v0 = bf2f(PROJ[(size_t)(rb + 2 * lane) * NPROJ + CDT + h]) + bias, v1 = bf2f(PROJ[(size_t)(rb + 2 * lane + 1) * NPROJ + CDT + h]) + bias;
                    const float d0 = fmaxf(v0, 0.f) + log1pf(__expf(-fabsf(v0))), d1 = fmaxf(v1, 0.f) + log1pf(__expf(-fabsf(v1)));
                    const float a1 = d1 * A; float sc = d0 * A + a1;
#pragma unroll
                    for (int o = 1; o < 64; o <<= 1) { const float t = __shfl_up(sc, o); if (lane >= o) sc += t; }
                    DT[(size_t)(rb + 2 * lane) * NH + h] = d0; DT[(size_t)(rb + 2 * lane + 1) * NH + h] = d1;
                    CS[(size_t)(rb + 2 * lane) * NH + h] = sc - a1; CS[(size_t)(rb + 2 * lane + 1) * NH + h] = sc; }
                else { const int e = (it - 64 * NH) * 64 + lane, row = MP + (e >> 5), h = e & 31;
                    const float v = bf2f(PROJ[(size_t)row * NPROJ + CDT + h]) + dt_bias[h];
                    DT[(size_t)row * NH + h] = fmaxf(v, 0.f) + log1pf(__expf(-fabsf(v))); }
            }
        }
        if (psel != 1) {
            cf_prompt_items(lds, PROJ, bx, G, 1024, cf_conv_w, cf_conv_b, CONVOUT, out + O_PCFC);
            for (int it2 = bx; it2 < 256; it2 += G) { const int s = it2 >> 1, c = (it2 & 1) * 1024 + tid * 2;
                cf_sample_item(PROJ, s, c, state_cfc + (size_t)s * 30 * DM, cf_conv_w, cf_conv_b, CONVOUT, out + O_SCFC + (size_t)s * 30 * DM); }
        }
        xcd_barrier(gbar);
        const int gt = bx * 512 + tid, NGT = G * 512;
        if (psel != 2) for (int it = gt; it < (MP / 8) * 384; it += NGT) {
            const int cq = it & 7, tgl = (it >> 3) & 7, rest = it >> 6; const int cgi = (rest % 48) * 8 + cq, tg = (rest / 48) * 8 + tgl; const int row0 = tg * 8, t0 = row0 % SEQ, b = row0 / SEQ;
            ssdconv_prompt_item(PROJ, row0, t0 > 0, cgi, ssd_conv_w, ssd_conv_b, XBC, (t0 == SEQ - 8) ? out + O_PSSDC + (size_t)b * 3 * XBCW : nullptr, DT, CS, XT1, XT2, BT); }
        for (int it = gt; it < DB * 384; it += NGT) { const int cgi = it % 384, s = it / 384;
            ssdconv_item<4, true>(PROJ, MP + 4 * s, true, state_ssdc + (size_t)s * 3 * XBCW, cgi, ssd_conv_w, ssd_conv_b, XBC, out + O_SSSDC + (size_t)s * 3 * XBCW); }
    }
    SEAM(2);
    if (IN(3)) { const KArgs KA = ka_get(); const int tid = ltid(), lane = tid & 63, wave = __builtin_amdgcn_readfirstlane(tid >> 6); (void)lane; (void)wave;
        const bf16_t* XT1 = (const bf16_t*)(ws + WS_XT1); const bf16_t* XT2 = (const bf16_t*)((unsigned char*)out + OS_XT2); const bf16_t* BT = (const bf16_t*)((unsigned char*)out + OS_BT); const float* CS = (const float*)((unsigned char*)out + OS_CS);
        const int npb = (G >= 256) ? 128 : (G / 2 > 0 ? G / 2 : 1);
        if (bx < npb) { if (psel != 2) for (int it = bx; it < NB * NH; it += npb) ssd_prompt(lds, it >> 5, it & 31, XBC, CS, XT1, XT2, BT, MIX, out + O_PSSM); }
        else { if (psel != 1) ssd_sample_items(lds, bx - npb, G - npb, DB * NG, XBC, DT, a_log, state_ssm, MIX, out + O_SSSM);
            if (psel == 0) for (int m = (bx - npb) * 8 + wave; m < MT; m += (G - npb) * 8) mix_finalize_conformer((size_t)m, MIX, CONVOUT, cf_ln_w, cf_ln_b, lane); }
    }
    SEAM(3);
    if (IN(4)) { const KArgs KA = ka_get(); const int tid = ltid(), lane = tid & 63, wave = __builtin_amdgcn_readfirstlane(tid >> 6); (void)lane; (void)wave;
        for (int m = bx * 8 + wave; m < MP; m += G * 8) mix_finalize_ssd((size_t)m, MIX, XBC, PROJ, d_skip, ssd_norm_w, lane, (psel == 3) ? XN + (size_t)m * DM : MIX + (size_t)m * DMIX);
        LAS float* red = (LAS float*)lds;
        for (int m0 = MP + 2 * bx; m0 < MT; m0 += 2 * G) {
            const size_t m = (size_t)(m0 + (wave >> 2)); const int q = wave & 3, c = q * 512 + lane * 8;
            bf16_t* mp = MIX + m * DMIX;
            const u32x4 yv = *(const u32x4*)(mp + c), xv = *(const u32x4*)(XBC + m * XBCW + c), zv = *(const u32x4*)(PROJ + m * NPROJ + CZ + c);
            const float dsk = d_skip[c >> 6]; const f32x4 w0 = *(const f32x4*)(ssd_norm_w + c), w1 = *(const f32x4*)(ssd_norm_w + c + 4);
            float f[8], xf[8], zf[8]; unpack8(yv, f); unpack8(xv, xf); unpack8(zv, zf);
            float sq = 0.f;
#pragma unroll
            for (int e = 0; e < 8; ++e) { f[e] = (f[e] + dsk * xf[e]) * siluf_(zf[e]); sq += f[e] * f[e]; }
            sq = wave_sum(sq);
            if (lane == 0) red[wave] = sq;
            LDS_BARRIER();
            const float tot = red[(wave & 4) + 0] + red[(wave & 4) + 1] + red[(wave & 4) + 2] + red[(wave & 4) + 3];
            const float r = rsqrtf(tot * (1.f / DM) + EPS);
            float o[8]; o[0] = f[0] * r * w0.x; o[1] = f[1] * r * w0.y; o[2] = f[2] * r * w0.z; o[3] = f[3] * r * w0.w; o[4] = f[4] * r * w1.x; o[5] = f[5] * r * w1.y; o[6] = f[6] * r * w1.z; o[7] = f[7] * r * w1.w;
            bf16_t* dst = (psel == 3) ? XN + m * DM : mp;
            *(u32x4*)(dst + c) = pack8(o);
            LDS_BARRIER();
        }
    }
    SEAM(4);
    if (IN(5)) { const KArgs KA = ka_get(); const int tid = ltid(), lane = tid & 63, wave = __builtin_amdgcn_readfirstlane(tid >> 6); (void)lane; (void)wave;
        pg8::Gemm g{MIX, WoutT, MT, DM, DMIX}; pg8::SplitOrder S; S.init(DMIX, G, bx, S2, 8);
        pg8::EpiX1 E{x_prompt, XN, (float*)(ws + WS_CTL + CTL_SSQ1), PART, psel == 3};
        pg8::gemm_phase<pg8::EpiX1, pg8::SplitOrder, true, true>(lds, g, S, E);
    }
    SEAM(5);
    if (IN(6)) { const KArgs KA = ka_get(); const int tid = ltid(), lane = tid & 63, wave = __builtin_amdgcn_readfirstlane(tid >> 6); (void)lane; (void)wave;
        float* SSQ1 = (float*)(ws + WS_CTL + CTL_SSQ1);
        for (int m = MP + bx * 8 + wave; m < MT; m += G * 8) {
            const float* base = x_sample + (size_t)(m - MP) * DM; const float* part = PART + (size_t)(m - MP) * DM;
            f32x4 v[8];
#pragma unroll
            for (int j = 0; j < 8; ++j) v[j] = *(const f32x4*)(base + (j * 64 + lane) * 4);
            for (int sp = 0; sp < S2; ++sp) {
#pragma unroll
                for (int j = 0; j < 8; ++j) v[j] += *(const f32x4*)(part + (size_t)sp * MS * DM + (j * 64 + lane) * 4); }
            float sq = 0.f;
#pragma unroll
            for (int j = 0; j < 8; ++j) sq += (v[j].x * v[j].x + v[j].y * v[j].y) + (v[j].z * v[j].z + v[j].w * v[j].w);
            sq = wave_sum(sq);
            if (lane == 0) SSQ1[m] = sq;
#pragma unroll
            for (int j = 0; j < 8; ++j) { u32x2 o; o.x = pk2(v[j].x, v[j].y); o.y = pk2(v[j].z, v[j].w); *(u32x2*)(XN + (size_t)m * DM + (j * 64 + lane) * 4) = o; }
        }
    }
    SEAM(6);
    if (IN(7)) { const KArgs KA = ka_get(); const int tid = ltid(), lane = tid & 63, wave = __builtin_amdgcn_readfirstlane(tid >> 6); (void)lane; (void)wave;
        pg8::Gemm g{XN, WupT, MT, FF2, DM}; pg8::StaticOrder S; S.init(MT, FF2, G, bx, DM);
        pg8::EpiBf16 E{U, FF2, (const float*)(ws + WS_CTL + CTL_SSQ1), -1, 0};
        pg8::gemm_phase<pg8::EpiBf16, pg8::StaticOrder, true, true>(lds, g, S, E);
    }
    SEAM(7);
    if (IN(8)) { const KArgs KA = ka_get(); const int tid = ltid(), lane = tid & 63, wave = __builtin_amdgcn_readfirstlane(tid >> 6); (void)lane; (void)wave;
        const int gt = bx * 512 + tid, NGT = G * 512;
        for (int it = gt; it < (MP / 8) * 688; it += NGT) { const int cgi = it % 688, tg = it / 688; const int row0 = tg * 8, t0 = row0 % SEQ, b = row0 / SEQ;
            ffn_item<8, false>(U, row0, t0 > 0, nullptr, cgi, ffn_conv_w, ffn_conv_b, ACT, (t0 == SEQ - 8) ? out + O_PFFC + (size_t)b * 2 * FF2 : nullptr); }
        for (int it = gt; it < DB * 688; it += NGT) { const int cgi = it % 688, s = it / 688;
            ffn_item<4, true>(U, MP + 4 * s, true, state_ffc + (size_t)s * 2 * FF2, cgi, ffn_conv_w, ffn_conv_b, ACT, out + O_SFFC + (size_t)s * 2 * FF2); }
    }
    SEAM(8);
    if (IN(9)) { const KArgs KA = ka_get(); const int tid = ltid(), lane = tid & 63, wave = __builtin_amdgcn_readfirstlane(tid >> 6); (void)lane; (void)wave;
        pg8::Gemm g{ACT, WdnT, MT, DM, FF}; pg8::SplitOrder S; S.init(FF, G, bx, S4, 12);
        pg8::EpiResF32 E{XN, out + O_Y, PART, psel == 3};
        pg8::gemm_phase<pg8::EpiResF32, pg8::SplitOrder, true, true>(lds, g, S, E);
    }
    SEAM(9);
    if (IN(10)) { const KArgs KA = ka_get(); const int tid = ltid(), lane = tid & 63, wave = __builtin_amdgcn_readfirstlane(tid >> 6); (void)lane; (void)wave;
        for (int m = bx * 8 + wave; m < MP; m += G * 8) {
            float* xr = out + O_Y + (size_t)m * DM;
            f32x4 v[8], ww[8];
#pragma unroll
            for (int j = 0; j < 8; ++j) { const u32x2 b = *(const u32x2*)(XN + (size_t)m * DM + (j * 64 + lane) * 4); v[j] = (f32x4){bf2f(b.x & 0xffffu), bf2f(b.x >> 16), bf2f(b.y & 0xffffu), bf2f(b.y >> 16)};
                ww[j] = *(const f32x4*)(norm_final_w + (j * 64 + lane) * 4); }
            float s = 0.f;
#pragma unroll
            for (int j = 0; j < 8; ++j) s += (v[j].x * v[j].x + v[j].y * v[j].y) + (v[j].z * v[j].z + v[j].w * v[j].w);
            const float r = rsqrtf(wave_sum(s) * (1.f / DM) + EPS);
#pragma unroll
            for (int j = 0; j < 8; ++j) *(f32x4*)(xr + (j * 64 + lane) * 4) = v[j] * r * ww[j];
        }
        LAS float* red = (LAS float*)lds;
        for (int m0 = MP + 2 * bx; m0 < MT; m0 += 2 * G) {
            const size_t m = (size_t)(m0 + (wave >> 2)); const int q = wave & 3, c = q * 512 + lane * 8;
            const u32x4 b = *(const u32x4*)(XN + m * DM + c);
            const f32x4 w0 = *(const f32x4*)(norm_final_w + c), w1 = *(const f32x4*)(norm_final_w + c + 4);
            float f[8]; unpack8(b, f);
            f32x4 v0 = (f32x4){f[0], f[1], f[2], f[3]}, v1 = (f32x4){f[4], f[5], f[6], f[7]};
            const float* part = PART + (m - MP) * DM + c;
            for (int sp = 0; sp < S4; ++sp) { v0 += *(const f32x4*)(part + (size_t)sp * MS * DM); v1 += *(const f32x4*)(part + (size_t)sp * MS * DM + 4); }
            float sq = (v0.x * v0.x + v0.y * v0.y) + (v0.z * v0.z + v0.w * v0.w) + (v1.x * v1.x + v1.y * v1.y) + (v1.z * v1.z + v1.w * v1.w);
            sq = wave_sum(sq);
            if (lane == 0) red[wave] = sq;
            LDS_BARRIER();
            const float tot = red[(wave & 4) + 0] + red[(wave & 4) + 1] + red[(wave & 4) + 2] + red[(wave & 4) + 3];
            const float r = rsqrtf(tot * (1.f / DM) + EPS);
            float* xr = out + O_Y + m * DM + c;
            *(f32x4*)xr = v0 * r * w0; *(f32x4*)(xr + 4) = v1 * r * w1;
            LDS_BARRIER();
        }
    }
#undef IN
#undef SEAM
}
#undef x_prompt
#undef x_sample
#undef state_ssm
#undef state_ssdc
#undef state_cfc
#undef state_ffc
#undef norm_mix_w
#undef w_in
#undef ssd_conv_w
#undef ssd_conv_b
#undef dt_bias
#undef a_log
#undef d_skip
#undef ssd_norm_w
#undef cf_conv_w
#undef cf_conv_b
#undef cf_ln_w
#undef cf_ln_b
#undef w_out
#undef norm_ffn_w
#undef w_up
#undef ffn_conv_w
#undef ffn_conv_b
#undef w_down
#undef norm_final_w
#undef out
#undef ws
#undef WinT
#undef WoutT
#undef WupT
#undef WdnT
#undef XN
#undef DT
#undef PROJ
#undef XBC
#undef U
#undef CONVOUT
#undef MIX
#undef ACT
#undef PART


extern "C" void kernel_launch(void* const* d_in, const int* in_sizes, int n_in, void* d_out, int out_size, void* d_ws, size_t ws_size, hipStream_t stream) {
    static int grid = 0;
    if (grid == 0) {
        if (n_in != 25 || (size_t)out_size != O_END || ws_size < WS_END) {
            fprintf(stderr, "kernel_launch: shape mismatch: n_in %d out %d (want %zu) ws %zu (need %zu)\n", n_in, out_size, (size_t)O_END, ws_size, (size_t)WS_END); grid = -1; return; }
        int dev = 0, cus = 0, per_cu = 0;
        hipGetDevice(&dev);
        hipDeviceGetAttribute(&cus, hipDeviceAttributeMultiprocessorCount, dev);
        if (hipFuncSetAttribute((const void*)mk_fwd, hipFuncAttributeMaxDynamicSharedMemorySize, LDS_BYTES) != hipSuccess) { fprintf(stderr, "kernel_launch: hipFuncSetAttribute failed\n"); grid = -1; return; }
        if (hipOccupancyMaxActiveBlocksPerMultiprocessor(&per_cu, (const void*)mk_fwd, 512, LDS_BYTES) != hipSuccess || per_cu < 1) { fprintf(stderr, "kernel_launch: occupancy query %d\n", per_cu); per_cu = 1; }
        (void)hipGetLastError();
        grid = cus * per_cu;
    }
    if (grid < 0) return;
    Args a{};
    for (int i = 0; i < 25; ++i) a.in[i] = (const float*)d_in[i];
    a.out_p = (float*)d_out; a.ws_p = (unsigned char*)d_ws;
#ifndef PROBE_SEL
#define PROBE_SEL 0
#endif
#ifndef PROBE_PHASE
#define PROBE_PHASE -1
#endif
    int ranges[3][2]; int nr = 0;
    if (PROBE_PHASE < 0) { ranges[0][0] = 0; ranges[0][1] = N_PHASES; nr = 1; }
    else { ranges[0][0] = 0; ranges[0][1] = PROBE_PHASE + 1; ranges[1][0] = PROBE_PHASE; ranges[1][1] = PROBE_PHASE + 1; nr = 2;
           if (PROBE_PHASE + 1 < N_PHASES) { ranges[2][0] = PROBE_PHASE + 1; ranges[2][1] = N_PHASES; nr = 3; } }
    if (hipMemsetAsync((char*)d_ws + WS_CTL, 0, CTL_BYTES, stream) != hipSuccess) { fprintf(stderr, "kernel_launch: memset failed\n"); return; }
    for (int i = 0; i < nr; ++i) {
        a.ph_lo = ranges[i][0]; a.ph_hi = ranges[i][1]; a.li = i | ((i == 1) ? (PROBE_SEL << 8) : 0);
        void* kargs[] = {&a};
        hipError_t e = hipLaunchCooperativeKernel((const void*)mk_fwd, dim3(grid), dim3(512), kargs, LDS_BYTES, stream);
        if (e != hipSuccess) fprintf(stderr, "kernel_launch: cooperative launch failed: %s (grid %d)\n", hipGetErrorString(e), grid);
    }
}
```

```cpp
#include <hip/hip_runtime.h>
#include <hip/hip_cooperative_groups.h>
#include <cstdio>
#include <cstdint>
namespace cg = cooperative_groups;

#ifndef MK_N_LAUNCHES
#define MK_N_LAUNCHES 1
#endif

#define LAS __attribute__((address_space(3)))
typedef unsigned short bf16_t;
typedef short bf16x8 __attribute__((ext_vector_type(8)));
typedef float f32x4 __attribute__((ext_vector_type(4)));
typedef float f32x2 __attribute__((ext_vector_type(2)));
typedef unsigned u32x4 __attribute__((ext_vector_type(4)));
typedef unsigned u32x2 __attribute__((ext_vector_type(2)));

constexpr int DM = 2048;
constexpr int MP = 8192, MS = 512, MT = MP + MS;
constexpr int SEQ = 2048, NB = 4, DB = 128, DSEQ = 4;
constexpr int NH = 32, HP = 64, NS = 128, NG = 4;
constexpr int XBCW = 3072;
constexpr int NPROJ = 9472;
constexpr int CZ = 0, CXBC = 2048, CCF = 5120, CDT = 9216;
constexpr int CUCF = 5120;
constexpr int DMIX = 4096, FF = 5504, FF2 = 11008;
constexpr float EPS = 1e-5f;

constexpr size_t O_Y = 0;
constexpr size_t O_PSSM = (size_t)MT * DM;
constexpr size_t O_PSSDC = O_PSSM + (size_t)NB * NH * HP * NS;
constexpr size_t O_PCFC = O_PSSDC + (size_t)NB * 3 * XBCW;
constexpr size_t O_PFFC = O_PCFC + (size_t)NB * 30 * DM;
constexpr size_t O_SSSM = O_PFFC + (size_t)NB * 2 * FF2;
constexpr size_t O_SSSDC = O_SSSM + (size_t)DB * NH * HP * NS;
constexpr size_t O_SCFC = O_SSSDC + (size_t)DB * 3 * XBCW;
constexpr size_t O_SFFC = O_SCFC + (size_t)DB * 30 * DM;
constexpr size_t O_END = O_SFFC + (size_t)DB * 2 * FF2;

constexpr size_t al256(size_t x) { return (x + 255) & ~(size_t)255; }
constexpr size_t WS_WIN = 0;
constexpr size_t WS_WOUT = WS_WIN + al256((size_t)NPROJ * DM * 2);
constexpr size_t WS_WUP = WS_WOUT + al256((size_t)DM * DMIX * 2);
constexpr size_t WS_WDN = WS_WUP + al256((size_t)FF2 * DM * 2);
constexpr size_t WS_XN = WS_WDN + al256((size_t)DM * FF * 2);
constexpr size_t WS_DT = WS_XN + al256((size_t)MT * DM * 2);
constexpr size_t WS_RA = WS_DT + al256((size_t)MT * NH * 4);
constexpr size_t WS_PROJ = WS_RA;
constexpr size_t WS_XBC = WS_PROJ + al256((size_t)MT * NPROJ * 2);
constexpr size_t WS_U = WS_RA;
constexpr size_t WS_RB = WS_XBC + al256((size_t)MT * XBCW * 2);
constexpr size_t WS_CONV = WS_RB;
constexpr size_t WS_MIX = WS_CONV + al256((size_t)MT * DM * 4);
constexpr size_t WS_ACT = WS_RB;
constexpr size_t WS_CTL = WS_MIX + al256((size_t)MT * DMIX * 2);
constexpr size_t CTL_BYTES = 131072;
constexpr size_t CTL_SSQ1 = 65536;
constexpr size_t WS_END = WS_CTL + CTL_BYTES;
static_assert((size_t)MT * FF2 * 2 <= WS_RB - WS_RA, "U overlay");
static_assert((size_t)MT * FF * 2 <= WS_END - WS_RB, "ACT overlay");

constexpr size_t WS_XT1 = WS_XN;
constexpr size_t OS_XT2 = 0, OS_BT = OS_XT2 + (size_t)MP * DM * 2, OS_CS = OS_BT + (size_t)64 * 512 * 128 * 2;
static_assert((size_t)MP * DM * 2 <= (size_t)MT * DM * 2 && OS_CS + (size_t)MP * NH * 4 <= (size_t)MT * DM * 4, "ssd scratch maps");
constexpr int LDS_BYTES = 147456;

__device__ __forceinline__ int ltid() { int t = threadIdx.x; asm volatile("" : "+v"(t)); return t; }
__device__ __forceinline__ float bf2f(unsigned h) { return __uint_as_float(h << 16); }
__device__ __forceinline__ unsigned f2bf(float f) { unsigned u = __float_as_uint(f); return (u + 0x7fffu + ((u >> 16) & 1u)) >> 16; }
__device__ __forceinline__ unsigned pk2(float lo, float hi) { unsigned r; asm("v_cvt_pk_bf16_f32 %0, %1, %2" : "=v"(r) : "v"(lo), "v"(hi)); return r; }
__device__ __forceinline__ float sigmoidf_(float x) { return __builtin_amdgcn_rcpf(1.f + __expf(-x)); }
__device__ __forceinline__ float siluf_(float x) { return x * __builtin_amdgcn_rcpf(1.f + __expf(-x)); }
#define LDS_BARRIER() do { asm volatile("s_waitcnt lgkmcnt(0)" ::: "memory"); __builtin_amdgcn_s_barrier(); asm volatile("" ::: "memory"); } while (0)
__device__ __forceinline__ float wave_sum(float v) {
#pragma unroll
    for (int o = 1; o < 64; o <<= 1) v += __shfl_xor(v, o);
    return v;
}
__device__ __forceinline__ void unpack8(const u32x4 v, float (&o)[8]) {
    o[0] = bf2f(v.x & 0xffffu); o[1] = bf2f(v.x >> 16); o[2] = bf2f(v.y & 0xffffu); o[3] = bf2f(v.y >> 16);
    o[4] = bf2f(v.z & 0xffffu); o[5] = bf2f(v.z >> 16); o[6] = bf2f(v.w & 0xffffu); o[7] = bf2f(v.w >> 16);
}
__device__ __forceinline__ u32x4 pack8(const float (&o)[8]) {
    u32x4 v; v.x = pk2(o[0], o[1]); v.y = pk2(o[2], o[3]); v.z = pk2(o[4], o[5]); v.w = pk2(o[6], o[7]); return v;
}

namespace pg8 {
#define PG8_LAS __attribute__((address_space(3)))
constexpr int BM = 256, BK = 64, HALF = 128, HTB = HALF * BK * 2, STAGE_BYTES = 8 * HTB, NXCD = 8, WGM = 8;
__host__ __device__ __forceinline__ int lds_byte(int r, int c) { const int st = (r >> 4) * 2 + (c >> 5), rr = r & 15, cc = c & 31, ob = rr * 64 + cc * 2; return st * 1024 + (ob ^ (((ob >> 9) & 1) << 5)); }
__host__ __device__ __forceinline__ void stage_rc(int b, int& R, int& C) { const int st = b / 1024, sb = b % 1024, swz = sb ^ (((sb >> 9) & 1) << 5); R = (st >> 1) * 16 + swz / 64; C = (st & 1) * 32 + (swz % 64) / 2; }
__host__ __device__ __forceinline__ int perm32(int rho) { const int n = rho >> 4, i = rho & 15; return 8 * (i >> 2) + 4 * n + (i & 3); }

struct Unit { int pm, pn, kt0, nkt, split; };
struct Gemm { const bf16_t* A; const bf16_t* Bt; int M, N, K; };
__host__ __device__ __forceinline__ unsigned long long pack_fields(int pm, int pn, int kt0, int nkt, int split) {
    return (unsigned long long)pm | ((unsigned long long)pn << 8) | ((unsigned long long)kt0 << 16) | ((unsigned long long)nkt << 24) | ((unsigned long long)(split + 1) << 32) | (1ull << 40); }
__host__ __device__ __forceinline__ unsigned long long pack_unit(const Unit& u) { return pack_fields(u.pm, u.pn, u.kt0, u.nkt, u.split); }
#define UP_PM(p) ((int)((p) & 0xff))
#define UP_PN(p) ((int)(((p) >> 8) & 0xff))
#define UP_KT0(p) ((int)(((p) >> 16) & 0xff))
#define UP_NKT(p) ((int)(((p) >> 24) & 0xff))
#define UP_SPLIT(p) ((int)(((p) >> 32) & 0xff) - 1)

struct StaticOrder {
    int nM, nN, nwg, G, c, nkt;
    __host__ __device__ void init(int M, int N, int G_, int c_, int K) { nM = M / BM; nN = N / BM; nwg = nM * nN; G = G_; c = c_; nkt = K / BK; }
    __host__ __device__ __forceinline__ bool next(int i, Unit& u) const {
        const long L = (long)i * G + c; if (L >= nwg) return false;
        int wgid = (int)L; { const int q = nwg / NXCD, r = nwg % NXCD, xcd = wgid % NXCD, off = wgid / NXCD; wgid = (xcd < r ? xcd * (q + 1) : r * (q + 1) + (xcd - r) * q) + off; }
        const int nig = WGM * nN, gid = wgid / nig, fm = gid * WGM, gsz = (nM - fm) < WGM ? (nM - fm) : WGM;
        u.pm = fm + ((wgid % nig) % gsz); u.pn = (wgid % nig) / gsz; u.kt0 = 0; u.nkt = nkt; u.split = -1; return true;
    }
    __host__ __device__ __forceinline__ unsigned long long nextp(int i) const { Unit u; if (!next(i, u)) return 0ull; return pack_unit(u); }
    __device__ __forceinline__ void a_ready(const Unit&) const {}
    __device__ __forceinline__ void done(const Unit&) const {}
};
struct SplitOrder {
    StaticOrder P; int G, c, S, base, total;
    __host__ __device__ void init(int K, int G_, int c_, int S_, int base_) { P.init(MP, DM, G_, c_, K); G = G_; c = c_; S = S_; base = base_; total = K / BK; }
    __host__ __device__ __forceinline__ bool next(int i, Unit& u) const {
        const long L = (long)i * G + c;
        if (L < P.nwg) {
            int wgid = (int)L; { const int q = P.nwg / NXCD, r = P.nwg % NXCD, xcd = wgid % NXCD, off = wgid / NXCD; wgid = (xcd < r ? xcd * (q + 1) : r * (q + 1) + (xcd - r) * q) + off; }
            const int nig = WGM * P.nN, gid = wgid / nig, fm = gid * WGM, gsz = (P.nM - fm) < WGM ? (P.nM - fm) : WGM;
            u.pm = fm + ((wgid % nig) % gsz); u.pn = (wgid % nig) / gsz; u.kt0 = 0; u.nkt = total; u.split = -1; return true;
        }
        const int l2 = (int)(L - P.nwg); if (l2 >= 16 * S) return false;
        u.pn = l2 & 7; u.pm = MP / BM + ((l2 >> 3) & 1); u.split = l2 >> 4; u.kt0 = u.split * base; u.nkt = (u.split == S - 1) ? total - base * (S - 1) : base; return true;
    }
    __host__ __device__ __forceinline__ unsigned long long nextp(int i) const {
        const long L = (long)i * G + c;
        if (L < P.nwg) {
            int wgid = (int)L; { const int q = P.nwg / NXCD, r = P.nwg % NXCD, xcd = wgid % NXCD, off = wgid / NXCD; wgid = (xcd < r ? xcd * (q + 1) : r * (q + 1) + (xcd - r) * q) + off; }
            const int nig = WGM * P.nN, gid = wgid / nig, fm = gid * WGM, gsz = (P.nM - fm) < WGM ? (P.nM - fm) : WGM;
            return pack_fields(fm + ((wgid % nig) % gsz), (wgid % nig) / gsz, 0, total, -1);
        }
        const int l2 = (int)(L - P.nwg); if (l2 >= 16 * S) return 0ull;
        const int sp = l2 >> 4;
        return pack_fields(MP / BM + ((l2 >> 3) & 1), l2 & 7, sp * base, (sp == S - 1) ? total - base * (S - 1) : base, sp);
    }
    __device__ __forceinline__ void a_ready(const Unit&) const {}
    __device__ __forceinline__ void done(const Unit&) const {}
};

__device__ __forceinline__ unsigned cvt_pk_bf16(float lo, float hi) { unsigned r; asm volatile("v_cvt_pk_bf16_f32 %0, %1, %2" : "=v"(r) : "v"(lo), "v"(hi)); return r; }

struct EpiBf16 {
    static constexpr bool PERM = true, AFTER_DRAIN = false;
    bf16_t* O; int ldc; const float* ssq; int glu0, glu_col;
    __device__ __forceinline__ void operator()(const f32x4 (&acc)[2][2][4][2], const Unit& u, int wr, int wc, int fr, int fq) const {
        const int row0 = u.pm * BM + wr * 64 + fr;
        if (glu0 >= 0 && u.pn >= glu0 && u.pn < glu0 + 16) {
            const int col0 = glu_col + 128 * (u.pn - glu0) + wc * 32 + 8 * fq;
#pragma unroll
            for (int ai = 0; ai < 2; ++ai)
#pragma unroll
                for (int m = 0; m < 4; ++m) { float o[8];
#pragma unroll
                    for (int n = 0; n < 2; ++n)
#pragma unroll
                        for (int j = 0; j < 4; ++j) { const float a = acc[ai][0][m][n][j], g = acc[ai][1][m][n][j]; o[4 * n + j] = a * __builtin_amdgcn_rcpf(1.f + __expf(-g)); }
                    u32x4 w; w.x = cvt_pk_bf16(o[0], o[1]); w.y = cvt_pk_bf16(o[2], o[3]); w.z = cvt_pk_bf16(o[4], o[5]); w.w = cvt_pk_bf16(o[6], o[7]);
                    *(u32x4*)(O + (size_t)(row0 + ai * HALF + m * 16) * ldc + col0) = w; }
            return;
        }
        const int col0 = u.pn * BM + wc * 32 + 8 * fq;
        float rs[2][4];
#pragma unroll
        for (int ai = 0; ai < 2; ++ai)
#pragma unroll
            for (int m = 0; m < 4; ++m) rs[ai][m] = ssq ? rsqrtf(ssq[row0 + ai * HALF + m * 16] * (1.f / DM) + EPS) : 1.f;
#pragma unroll
        for (int ai = 0; ai < 2; ++ai)
#pragma unroll
            for (int m = 0; m < 4; ++m) { bf16_t* rowp = O + (size_t)(row0 + ai * HALF + m * 16) * ldc + col0;
#pragma unroll
                for (int bj = 0; bj < 2; ++bj) { const f32x4 v0 = acc[ai][bj][m][0] * rs[ai][m], v1 = acc[ai][bj][m][1] * rs[ai][m];
                    u32x4 w; w.x = cvt_pk_bf16(v0[0], v0[1]); w.y = cvt_pk_bf16(v0[2], v0[3]); w.z = cvt_pk_bf16(v1[0], v1[1]); w.w = cvt_pk_bf16(v1[2], v1[3]);
                    *(u32x4*)(rowp + bj * HALF) = w; } }
    }
};
struct EpiX1 {
    static constexpr bool PERM = true, AFTER_DRAIN = false;
    const float* baseP; bf16_t* X1B; float* ssq; float* part; int probe_repeat;
    __device__ __forceinline__ void operator()(const f32x4 (&acc)[2][2][4][2], const Unit& u, int wr, int wc, int fr, int fq) const {
        const int row0 = u.pm * BM + wr * 64 + fr; const int col0 = u.pn * BM + wc * 32 + 8 * fq;
        if (u.split >= 0) {
            float* pp = part + ((size_t)u.split * MS + (row0 - MP)) * DM;
#pragma unroll
            for (int ai = 0; ai < 2; ++ai)
#pragma unroll
                for (int m = 0; m < 4; ++m) { const size_t ro = (size_t)(ai * HALF + m * 16) * DM + col0;
#pragma unroll
                    for (int bj = 0; bj < 2; ++bj) { *(f32x4*)(pp + ro + bj * HALF) = acc[ai][bj][m][0]; *(f32x4*)(pp + ro + bj * HALF + 4) = acc[ai][bj][m][1]; } }
            return;
        }
        const float* bp = baseP + (size_t)row0 * DM;
        bf16_t* op = X1B + (size_t)row0 * DM;
#pragma unroll
        for (int ai = 0; ai < 2; ++ai)
#pragma unroll
            for (int mp = 0; mp < 2; ++mp) {
                f32x4 bv[2][2][2];
#pragma unroll
                for (int mm = 0; mm < 2; ++mm)
#pragma unroll
                    for (int bj = 0; bj < 2; ++bj) { const size_t ro = (size_t)(ai * HALF + (2 * mp + mm) * 16) * DM + col0 + bj * HALF;
                        bv[mm][bj][0] = *(const f32x4*)(bp + ro); bv[mm][bj][1] = *(const f32x4*)(bp + ro + 4); }
#pragma unroll
                for (int mm = 0; mm < 2; ++mm) { float sq = 0.f;
#pragma unroll
                    for (int bj = 0; bj < 2; ++bj) { const size_t ro = (size_t)(ai * HALF + (2 * mp + mm) * 16) * DM + col0 + bj * HALF;
                        const f32x4 v0 = bv[mm][bj][0] + acc[ai][bj][2 * mp + mm][0], v1 = bv[mm][bj][1] + acc[ai][bj][2 * mp + mm][1];
                        sq += (v0[0] * v0[0] + v0[1] * v0[1]) + (v0[2] * v0[2] + v0[3] * v0[3]) + (v1[0] * v1[0] + v1[1] * v1[1]) + (v1[2] * v1[2] + v1[3] * v1[3]);
                        u32x4 w; w.x = cvt_pk_bf16(v0[0], v0[1]); w.y = cvt_pk_bf16(v0[2], v0[3]); w.z = cvt_pk_bf16(v1[0], v1[1]); w.w = cvt_pk_bf16(v1[2], v1[3]);
                        *(u32x4*)(op + ro) = w; }
                    sq += __shfl_xor(sq, 16); sq += __shfl_xor(sq, 32);
                    if (fq == 0 && !probe_repeat) atomicAdd(ssq + row0 + ai * HALF + (2 * mp + mm) * 16, sq); }
                asm volatile("" ::: "memory"); }
    }
};
struct EpiResF32 {
    static constexpr bool PERM = true, AFTER_DRAIN = false;
    bf16_t* X1B; float* out; float* part; int probe_repeat;
    __device__ __forceinline__ void operator()(const f32x4 (&acc)[2][2][4][2], const Unit& u, int wr, int wc, int fr, int fq) const {
        const int row0 = u.pm * BM + wr * 64 + fr; const int col0 = u.pn * BM + wc * 32 + 8 * fq;
        if (u.split >= 0) {
            float* pp = part + ((size_t)u.split * MS + (row0 - MP)) * DM;
#pragma unroll
            for (int ai = 0; ai < 2; ++ai)
#pragma unroll
                for (int m = 0; m < 4; ++m) { const size_t ro = (size_t)(ai * HALF + m * 16) * DM + col0;
#pragma unroll
                    for (int bj = 0; bj < 2; ++bj) { *(f32x4*)(pp + ro + bj * HALF) = acc[ai][bj][m][0]; *(f32x4*)(pp + ro + bj * HALF + 4) = acc[ai][bj][m][1]; } }
            return;
        }
        bf16_t* bp = X1B + (size_t)row0 * DM;
        bf16_t* wp = probe_repeat ? (bf16_t*)out + (size_t)row0 * DM : bp;
#pragma unroll
        for (int ai = 0; ai < 2; ++ai) {
            u32x4 bv[4][2];
#pragma unroll
            for (int m = 0; m < 4; ++m)
#pragma unroll
                for (int bj = 0; bj < 2; ++bj) bv[m][bj] = *(const u32x4*)(bp + (size_t)(ai * HALF + m * 16) * DM + col0 + bj * HALF);
#pragma unroll
            for (int m = 0; m < 4; ++m)
#pragma unroll
                for (int bj = 0; bj < 2; ++bj) { const size_t ro = (size_t)(ai * HALF + m * 16) * DM + col0 + bj * HALF; float b[8]; unpack8(bv[m][bj], b);
                    const f32x4 v0 = (f32x4){b[0], b[1], b[2], b[3]} + acc[ai][bj][m][0], v1 = (f32x4){b[4], b[5], b[6], b[7]} + acc[ai][bj][m][1];
                    u32x4 w; w.x = cvt_pk_bf16(v0[0], v0[1]); w.y = cvt_pk_bf16(v0[2], v0[3]); w.z = cvt_pk_bf16(v1[0], v1[1]); w.w = cvt_pk_bf16(v1[2], v1[3]);
                    *(u32x4*)(wp + ro) = w; }
            asm volatile("" ::: "memory"); }
    }
};

template <class Epi, class Sched, bool ALIGN_EPI = false, bool SP2 = false>
__device__ __forceinline__ void gemm_phase(PG8_LAS unsigned char* lds, const Gemm g, const Sched& S, const Epi& E) {
    const int tid = ltid(), wid = __builtin_amdgcn_readfirstlane(tid >> 6), lane = tid & 63, wr = wid >> 2, wc = wid & 3, fr = lane & 15, fq = lane >> 4;
    const int K = g.K;
    unsigned voffA[2], voffB[2];
#pragma unroll
    for (int i = 0; i < 2; ++i) { int R, C; stage_rc(tid * 16 + i * 8192, R, C); const int Rb = Epi::PERM ? ((R & ~31) + perm32(R & 31)) : R;
        voffA[i] = (unsigned)(R * K + C) * 2u; voffB[i] = (unsigned)(Rb * K + C) * 2u; }
    const size_t kstep = (size_t)(BK * 2);
    const size_t hstep = (size_t)HALF * K * 2;
    const size_t tstep = 2 * hstep;
    const unsigned ldsw = (unsigned)wid * 1024u;
    const int aoff = lds_byte(wr * 64 + fr, fq * 8), boff = lds_byte(wc * 32 + fr, fq * 8);
#define PG8_SA(b, h) (((b) * 2 + (h)) * HTB)
#define PG8_SB(b, h) ((4 + (b) * 2 + (h)) * HTB)
#define PG8_STAGE(bufoff, gbase, voff) do { _Pragma("unroll") for (int _i = 0; _i < 2; ++_i) \
        __builtin_amdgcn_global_load_lds((const unsigned*)((const char*)(gbase) + (voff)[_i]), (PG8_LAS unsigned*)(lds + (bufoff) + ldsw + _i * 8192), 16, 0, 0); } while (0)
#define PG8_LDA(dst, b, h) do { _Pragma("unroll") for (int m = 0; m < 4; ++m) _Pragma("unroll") for (int k = 0; k < 2; ++k) dst[m][k] = *(const PG8_LAS bf16x8*)(lds + PG8_SA(b, h) + aoff + m * 2048 + k * 1024); } while (0)
#define PG8_LDB(dst, b, h) do { _Pragma("unroll") for (int n = 0; n < 2; ++n) _Pragma("unroll") for (int k = 0; k < 2; ++k) dst[n][k] = *(const PG8_LAS bf16x8*)(lds + PG8_SB(b, h) + boff + n * 2048 + k * 1024); } while (0)
#define PG8_MMA(ai, bj, At, Bt) do { __builtin_amdgcn_s_setprio(1); _Pragma("unroll") for (int m = 0; m < 4; ++m) _Pragma("unroll") for (int n = 0; n < 2; ++n) _Pragma("unroll") for (int k = 0; k < 2; ++k) \
        acc[ai][bj][m][n] = __builtin_amdgcn_mfma_f32_16x16x32_bf16(Bt[n][k], At[m][k], acc[ai][bj][m][n], 0, 0, 0); __builtin_amdgcn_s_setprio(0); } while (0)
#define PG8_WAIT_V(n) asm volatile("s_waitcnt vmcnt(" #n ")" ::: "memory")
#define PG8_WAIT_L(n) asm volatile("s_waitcnt lgkmcnt(" #n ")" ::: "memory")
#define PG8_BAR __builtin_amdgcn_s_barrier()
#define PG8_SCHED __builtin_amdgcn_sched_barrier(0)
    unsigned long long cur = S.nextp(0), nxt; int ui = 0;
    if (!cur) return;
    f32x4 acc[2][2][4][2];
#pragma unroll
    for (int a = 0; a < 2; ++a)
#pragma unroll
        for (int b = 0; b < 2; ++b)
#pragma unroll
            for (int m = 0; m < 4; ++m)
#pragma unroll
                for (int n = 0; n < 2; ++n) acc[a][b][m][n] = (f32x4){0.f, 0.f, 0.f, 0.f};
    bf16x8 At[4][2], B0[2][2], B1[2][2];
    const char* cA = (const char*)g.A + (size_t)UP_PM(cur) * tstep + (size_t)UP_KT0(cur) * kstep; const char* cB = (const char*)g.Bt + (size_t)UP_PN(cur) * tstep + (size_t)UP_KT0(cur) * kstep;
    if constexpr (SP2) {
        PG8_STAGE(PG8_SB(0, 0), cB, voffB); PG8_STAGE(PG8_SB(0, 1), cB + hstep, voffB); PG8_STAGE(PG8_SA(0, 0), cA, voffA); PG8_STAGE(PG8_SA(0, 1), cA + hstep, voffA);
        if (wr == 1) PG8_BAR;
        PG8_WAIT_V(2); PG8_BAR;
        PG8_STAGE(PG8_SB(1, 0), cB + kstep, voffB); PG8_STAGE(PG8_SA(1, 0), cA + kstep, voffA); PG8_STAGE(PG8_SB(1, 1), cB + hstep + kstep, voffB);
        PG8_WAIT_V(6); PG8_BAR;
    } else {
        PG8_STAGE(PG8_SB(0, 0), cB, voffB); PG8_STAGE(PG8_SA(0, 0), cA, voffA); PG8_STAGE(PG8_SB(0, 1), cB + hstep, voffB); PG8_STAGE(PG8_SA(0, 1), cA + hstep, voffA);
        if (wr == 1) PG8_BAR;
        PG8_WAIT_V(4); PG8_BAR;
        PG8_STAGE(PG8_SB(1, 0), cB + kstep, voffB); PG8_STAGE(PG8_SA(1, 0), cA + kstep, voffA); PG8_STAGE(PG8_SB(1, 1), cB + hstep + kstep, voffB);
        PG8_WAIT_V(6); PG8_BAR;
    }
    for (;;) {
        nxt = S.nextp(ui + 1); const bool has_next = (nxt != 0ull);
        const char* nA = has_next ? (const char*)g.A + (size_t)UP_PM(nxt) * tstep + (size_t)UP_KT0(nxt) * kstep : cA; const char* nB = has_next ? (const char*)g.Bt + (size_t)UP_PN(nxt) * tstep + (size_t)UP_KT0(nxt) * kstep : cB;
        const int nt = UP_NKT(cur);
        for (int t = 0; t < nt; t += 2) {
            const bool last = (t == nt - 2);
            const char* a1 = cA + (size_t)(t + 1) * kstep;
            const char* a2 = last ? nA : cA + (size_t)(t + 2) * kstep; const char* b2 = last ? nB : cB + (size_t)(t + 2) * kstep;
            const char* a3 = a2 + kstep; const char* b3 = b2 + kstep;
            if constexpr (SP2) {
            PG8_LDB(B0, 0, 0); PG8_LDB(B1, 0, 1); PG8_SCHED; PG8_LDA(At, 0, 0); PG8_STAGE(PG8_SA(1, 1), a1 + hstep, voffA);
            PG8_WAIT_V(8); PG8_WAIT_L(0); PG8_BAR; PG8_MMA(0, 0, At, B0); PG8_MMA(0, 1, At, B1); PG8_BAR; PG8_SCHED;
            PG8_LDA(At, 0, 1); PG8_STAGE(PG8_SB(0, 0), b2, voffB); PG8_STAGE(PG8_SB(0, 1), b2 + hstep, voffB); PG8_STAGE(PG8_SA(0, 0), a2, voffA);
            PG8_WAIT_V(8); PG8_WAIT_L(0); PG8_BAR; PG8_MMA(1, 0, At, B0); PG8_MMA(1, 1, At, B1); PG8_BAR; PG8_SCHED;
            PG8_LDB(B0, 1, 0); PG8_LDB(B1, 1, 1); PG8_SCHED; PG8_LDA(At, 1, 0); PG8_STAGE(PG8_SA(0, 1), a2 + hstep, voffA);
            PG8_WAIT_V(8); PG8_WAIT_L(0); PG8_BAR; PG8_MMA(0, 0, At, B0); PG8_MMA(0, 1, At, B1); PG8_BAR; PG8_SCHED;
            PG8_LDA(At, 1, 1); PG8_STAGE(PG8_SB(1, 0), b3, voffB); PG8_STAGE(PG8_SB(1, 1), b3 + hstep, voffB); PG8_STAGE(PG8_SA(1, 0), a3, voffA);
            PG8_WAIT_V(8); PG8_WAIT_L(0); PG8_BAR; PG8_MMA(1, 0, At, B0); PG8_MMA(1, 1, At, B1); PG8_BAR; PG8_SCHED;
            } else {
            PG8_LDB(B0, 0, 0); PG8_SCHED; PG8_LDA(At, 0, 0); PG8_STAGE(PG8_SA(1, 1), a1 + hstep, voffA);
            PG8_WAIT_L(8); PG8_BAR; PG8_WAIT_L(0); PG8_MMA(0, 0, At, B0); PG8_BAR; PG8_SCHED;
            PG8_LDB(B1, 0, 1); PG8_STAGE(PG8_SB(0, 0), b2, voffB);
            PG8_BAR; PG8_WAIT_L(0); PG8_MMA(0, 1, At, B1); PG8_BAR;
            PG8_LDA(At, 0, 1); PG8_STAGE(PG8_SA(0, 0), a2, voffA);
            PG8_BAR; PG8_WAIT_L(0); PG8_MMA(1, 0, At, B0); PG8_BAR; PG8_SCHED;
            PG8_STAGE(PG8_SB(0, 1), b2 + hstep, voffB);
            PG8_WAIT_V(6); PG8_BAR; PG8_MMA(1, 1, At, B1); PG8_BAR;
            PG8_LDB(B0, 1, 0); PG8_SCHED; PG8_LDA(At, 1, 0); PG8_STAGE(PG8_SA(0, 1), a2 + hstep, voffA);
            PG8_WAIT_L(8); PG8_BAR; PG8_WAIT_L(0); PG8_MMA(0, 0, At, B0); PG8_BAR; PG8_SCHED;
            PG8_LDB(B1, 1, 1); PG8_STAGE(PG8_SB(1, 0), b3, voffB);
            PG8_BAR; PG8_WAIT_L(0); PG8_MMA(0, 1, At, B1); PG8_BAR;
            PG8_LDA(At, 1, 1); PG8_STAGE(PG8_SA(1, 0), a3, voffA);
            PG8_BAR; PG8_WAIT_L(0); PG8_MMA(1, 0, At, B0); PG8_BAR; PG8_SCHED;
            PG8_STAGE(PG8_SB(1, 1), b3 + hstep, voffB);
            PG8_WAIT_V(6); PG8_BAR; PG8_MMA(1, 1, At, B1); PG8_BAR;
            }
        }
        if constexpr (ALIGN_EPI) { if (wr == 0) PG8_BAR; }
        { Unit cu; cu.pm = UP_PM(cur); cu.pn = UP_PN(cur); cu.kt0 = UP_KT0(cur); cu.nkt = UP_NKT(cur); cu.split = UP_SPLIT(cur); E(acc, cu, wr, wc, fr, fq); }
        if (!has_next) break;
#pragma unroll
        for (int a = 0; a < 2; ++a)
#pragma unroll
            for (int b = 0; b < 2; ++b)
#pragma unroll
                for (int m = 0; m < 4; ++m)
#pragma unroll
                    for (int n = 0; n < 2; ++n) acc[a][b][m][n] = (f32x4){0.f, 0.f, 0.f, 0.f};
        cur = nxt; cA = nA; cB = nB; ++ui;
        if constexpr (ALIGN_EPI) { if (wr == 1) PG8_BAR; }
    }
    PG8_WAIT_V(0);
    if constexpr (!ALIGN_EPI) { if (wr == 0) PG8_BAR; }
    PG8_BAR;
#undef PG8_SA
#undef PG8_SB
#undef PG8_STAGE
#undef PG8_LDA
#undef PG8_LDB
#undef PG8_MMA
#undef PG8_WAIT_V
#undef PG8_WAIT_L
#undef PG8_BAR
#undef PG8_SCHED
}
}

__device__ __forceinline__ void p0_transpose_item(const float* W, int K, int N, bf16_t* WT, int k0, int n0, int drow0, LAS float* scr, int lane, const float* kscale = nullptr) {
    const float ks = kscale ? kscale[k0 + lane] : 1.f;
#pragma unroll 8
    for (int i = 0; i < 32; ++i) { const int kk = 2 * i + (lane >> 5); scr[kk * 33 + (lane & 31)] = W[(size_t)(k0 + kk) * N + n0 + (lane & 31)] * __shfl(ks, kk); }
    asm volatile("s_waitcnt lgkmcnt(0)" ::: "memory");
    const int c = lane & 7;
#pragma unroll
    for (int j = 0; j < 4; ++j) { const int n = (lane >> 3) + 8 * j; const LAS float* s = scr + (8 * c) * 33 + n;
        u32x4 o; o.x = pk2(s[0 * 33], s[1 * 33]); o.y = pk2(s[2 * 33], s[3 * 33]); o.z = pk2(s[4 * 33], s[5 * 33]); o.w = pk2(s[6 * 33], s[7 * 33]);
        *(u32x4*)(WT + (size_t)(drow0 + n) * K + k0 + 8 * c) = o; }
    asm volatile("s_waitcnt lgkmcnt(0)" ::: "memory");
}
__device__ __forceinline__ int win_dest_row(int n0) {
    if (n0 < 5120) return n0;
    if (n0 < 5152) return CDT + (n0 - 5120);
    if (n0 < 7200) { const int c = n0 - 5152; return CCF + 256 * (c >> 7) + (c & 127); }
    { const int c = n0 - 7200; return CCF + 256 * (c >> 7) + 128 + (c & 127); }
}
__device__ __forceinline__ void rms_row_to_bf16(const float* xrow, const float* w, bf16_t* orow, int lane) {
    f32x4 v[8], ww[8]; float s = 0.f;
#pragma unroll
    for (int j = 0; j < 8; ++j) { v[j] = *(const f32x4*)(xrow + (j * 64 + lane) * 4); ww[j] = *(const f32x4*)(w + (j * 64 + lane) * 4); }
#pragma unroll
    for (int j = 0; j < 8; ++j) s += (v[j].x * v[j].x + v[j].y * v[j].y) + (v[j].z * v[j].z + v[j].w * v[j].w);
    const float r = rsqrtf(wave_sum(s) * (1.f / DM) + EPS);
#pragma unroll
    for (int j = 0; j < 8; ++j) {
        u32x2 o; o.x = pk2(v[j].x * r * ww[j].x, v[j].y * r * ww[j].y); o.y = pk2(v[j].z * r * ww[j].z, v[j].w * r * ww[j].w);
        *(u32x2*)(orow + (j * 64 + lane) * 4) = o; }
}

template <int NT, bool SAMPLE>
__device__ __forceinline__ void ssdconv_item(const bf16_t* PROJ, int row0, bool has_hist, const float* st, int cgi, const float* w, const float* bias, bf16_t* XBC, float* state_out) {
    const int c0 = cgi * 8;
    float wv[4][8], bv[8], h0[8], h1[8], h2[8];
#pragma unroll
    for (int i = 0; i < 4; ++i) { const f32x4 a = *(const f32x4*)(w + i * XBCW + c0), b = *(const f32x4*)(w + i * XBCW + c0 + 4);
        wv[i][0] = a.x; wv[i][1] = a.y; wv[i][2] = a.z; wv[i][3] = a.w; wv[i][4] = b.x; wv[i][5] = b.y; wv[i][6] = b.z; wv[i][7] = b.w; }
    { const f32x4 a = *(const f32x4*)(bias + c0), b = *(const f32x4*)(bias + c0 + 4);
      bv[0] = a.x; bv[1] = a.y; bv[2] = a.z; bv[3] = a.w; bv[4] = b.x; bv[5] = b.y; bv[6] = b.z; bv[7] = b.w; }
    if (SAMPLE) {
#pragma unroll
        for (int e = 0; e < 8; ++e) { h0[e] = st[0 * XBCW + c0 + e]; h1[e] = st[1 * XBCW + c0 + e]; h2[e] = st[2 * XBCW + c0 + e]; }
    } else if (has_hist) {
        unpack8(*(const u32x4*)(PROJ + (size_t)(row0 - 3) * NPROJ + CXBC + c0), h0);
        unpack8(*(const u32x4*)(PROJ + (size_t)(row0 - 2) * NPROJ + CXBC + c0), h1);
        unpack8(*(const u32x4*)(PROJ + (size_t)(row0 - 1) * NPROJ + CXBC + c0), h2);
    } else {
#pragma unroll
        for (int e = 0; e < 8; ++e) { h0[e] = 0.f; h1[e] = 0.f; h2[e] = 0.f; }
    }
    u32x4 rows[NT];
#pragma unroll
    for (int t = 0; t < NT; ++t) rows[t] = *(const u32x4*)(PROJ + (size_t)(row0 + t) * NPROJ + CXBC + c0);
#pragma unroll
    for (int t = 0; t < NT; ++t) {
        float cur[8], o[8];
        unpack8(rows[t], cur);
#pragma unroll
        for (int e = 0; e < 8; ++e) { float v = h0[e] * wv[0][e] + h1[e] * wv[1][e] + h2[e] * wv[2][e] + cur[e] * wv[3][e] + bv[e]; o[e] = siluf_(v); h0[e] = h1[e]; h1[e] = h2[e]; h2[e] = cur[e]; }
        *(u32x4*)(XBC + (size_t)(row0 + t) * XBCW + c0) = pack8(o);
    }
    if (state_out) {
        *(f32x4*)(state_out + 0 * XBCW + c0) = (f32x4){h0[0], h0[1], h0[2], h0[3]}; *(f32x4*)(state_out + 0 * XBCW + c0 + 4) = (f32x4){h0[4], h0[5], h0[6], h0[7]};
        *(f32x4*)(state_out + 1 * XBCW + c0) = (f32x4){h1[0], h1[1], h1[2], h1[3]}; *(f32x4*)(state_out + 1 * XBCW + c0 + 4) = (f32x4){h1[4], h1[5], h1[6], h1[7]};
        *(f32x4*)(state_out + 2 * XBCW + c0) = (f32x4){h2[0], h2[1], h2[2], h2[3]}; *(f32x4*)(state_out + 2 * XBCW + c0 + 4) = (f32x4){h2[4], h2[5], h2[6], h2[7]};
    }
}

__device__ __forceinline__ void ssdconv_prompt_item(const bf16_t* PROJ, int row0, bool has_hist, int cgi, const float* w, const float* bias, bf16_t* XBC, float* state_out,
                                                    const float* DT, const float* CS, bf16_t* XT1, bf16_t* XT2, bf16_t* BT) {
    const int c0 = cgi * 8;
    float wv[4][8], bv[8], h0[8], h1[8], h2[8];
#pragma unroll
    for (int i = 0; i < 4; ++i) { const f32x4 a = *(const f32x4*)(w + i * XBCW + c0), b = *(const f32x4*)(w + i * XBCW + c0 + 4);
        wv[i][0] = a.x; wv[i][1] = a.y; wv[i][2] = a.z; wv[i][3] = a.w; wv[i][4] = b.x; wv[i][5] = b.y; wv[i][6] = b.z; wv[i][7] = b.w; }
    { const f32x4 a = *(const f32x4*)(bias + c0), b = *(const f32x4*)(bias + c0 + 4);
      bv[0] = a.x; bv[1] = a.y; bv[2] = a.z; bv[3] = a.w; bv[4] = b.x; bv[5] = b.y; bv[6] = b.z; bv[7] = b.w; }
    u32x4 rows[8], hr[3];
#pragma unroll
    for (int t = 0; t < 8; ++t) rows[t] = *(const u32x4*)(PROJ + (size_t)(row0 + t) * NPROJ + CXBC + c0);
    if (has_hist) {
#pragma unroll
        for (int i = 0; i < 3; ++i) hr[i] = *(const u32x4*)(PROJ + (size_t)(row0 - 3 + i) * NPROJ + CXBC + c0);
    } else {
#pragma unroll
        for (int i = 0; i < 3; ++i) hr[i] = (u32x4){0u, 0u, 0u, 0u};
    }
    const bool isx = cgi < 256, isb = (cgi >= 256 && cgi < 320);
    float f1[8], f2[8];
    if (isx) { const int h = cgi >> 3; const float csl = CS[(size_t)((row0 & ~127) + 127) * NH + h];
#pragma unroll
        for (int t = 0; t < 8; ++t) { const float d = DT[(size_t)(row0 + t) * NH + h]; const float c = CS[(size_t)(row0 + t) * NH + h]; f1[t] = d; f2[t] = d * __expf(csl - c); } }
    unpack8(hr[0], h0); unpack8(hr[1], h1); unpack8(hr[2], h2);
    float o[8][8];
#pragma unroll
    for (int t = 0; t < 8; ++t) {
        float cur[8];
        unpack8(rows[t], cur);
#pragma unroll
        for (int e = 0; e < 8; ++e) { float v = h0[e] * wv[0][e] + h1[e] * wv[1][e] + h2[e] * wv[2][e] + cur[e] * wv[3][e] + bv[e]; o[t][e] = siluf_(v); h0[e] = h1[e]; h1[e] = h2[e]; h2[e] = cur[e]; }
        *(u32x4*)(XBC + (size_t)(row0 + t) * XBCW + c0) = pack8(o[t]);
    }
    if (state_out) {
        *(f32x4*)(state_out + 0 * XBCW + c0) = (f32x4){h0[0], h0[1], h0[2], h0[3]}; *(f32x4*)(state_out + 0 * XBCW + c0 + 4) = (f32x4){h0[4], h0[5], h0[6], h0[7]};
        *(f32x4*)(state_out + 1 * XBCW + c0) = (f32x4){h1[0], h1[1], h1[2], h1[3]}; *(f32x4*)(state_out + 1 * XBCW + c0 + 4) = (f32x4){h1[4], h1[5], h1[6], h1[7]};
        *(f32x4*)(state_out + 2 * XBCW + c0) = (f32x4){h2[0], h2[1], h2[2], h2[3]}; *(f32x4*)(state_out + 2 * XBCW + c0 + 4) = (f32x4){h2[4], h2[5], h2[6], h2[7]};
    }
    const int chunk = row0 >> 7, jb = row0 & 127;
    if (isx) {
#pragma unroll
        for (int e = 0; e < 8; ++e) { u32x4 a, b2;
            a.x = pk2(o[0][e] * f1[0], o[1][e] * f1[1]); a.y = pk2(o[2][e] * f1[2], o[3][e] * f1[3]); a.z = pk2(o[4][e] * f1[4], o[5][e] * f1[5]); a.w = pk2(o[6][e] * f1[6], o[7][e] * f1[7]);
            b2.x = pk2(o[0][e] * f2[0], o[1][e] * f2[1]); b2.y = pk2(o[2][e] * f2[2], o[3][e] * f2[3]); b2.z = pk2(o[4][e] * f2[4], o[5][e] * f2[5]); b2.w = pk2(o[6][e] * f2[6], o[7][e] * f2[7]);
            const size_t off = ((size_t)chunk * DM + c0 + e) * 128 + jb;
            *(u32x4*)(XT1 + off) = a; *(u32x4*)(XT2 + off) = b2; }
    } else if (isb) {
#pragma unroll
        for (int e = 0; e < 8; ++e) { u32x4 a;
            a.x = pk2(o[0][e], o[1][e]); a.y = pk2(o[2][e], o[3][e]); a.z = pk2(o[4][e], o[5][e]); a.w = pk2(o[6][e], o[7][e]);
            *(u32x4*)(BT + ((size_t)chunk * 512 + (c0 - 2048) + e) * 128 + jb) = a; }
    }
}

__device__ __forceinline__ void cf_sample_item(const bf16_t* PROJ, int s, int c, const float* st, const float* cw, const float* cb, bf16_t* CONVOUT, float* state_out) {
    f32x2 xp[34], w[31];
    unsigned uv[4];
#pragma unroll
    for (int j = 0; j < 30; ++j) xp[j] = *(const f32x2*)(st + j * DM + c);
#pragma unroll
    for (int t = 0; t < 4; ++t) uv[t] = *(const unsigned*)(PROJ + (size_t)(MP + 4 * s + t) * NPROJ + CUCF + c);
#pragma unroll
    for (int i = 0; i < 31; ++i) w[i] = *(const f32x2*)(cw + i * DM + c);
    const f32x2 bias = *(const f32x2*)(cb + c);
#pragma unroll
    for (int t = 0; t < 4; ++t) { xp[30 + t].x = bf2f(uv[t] & 0xffffu); xp[30 + t].y = bf2f(uv[t] >> 16); }
#pragma unroll
    for (int t = 0; t < 4; ++t) { f32x2 acc = bias;
#pragma unroll
        for (int i = 0; i < 31; ++i) acc += xp[t + i] * w[i];
        *(unsigned*)(CONVOUT + (size_t)(MP + 4 * s + t) * DM + c) = pk2(acc.x, acc.y); }
#pragma unroll
    for (int i = 0; i < 30; ++i) *(f32x2*)(state_out + (size_t)i * DM + c) = xp[4 + i];
}

template <int J> struct CfLds {
    static __device__ __forceinline__ void run(float (&acc)[32], const float (&w)[31], const LAS float* us) {
        const float v = us[J * 512];
        constexpr int TLO = (J - 30 > 0) ? J - 30 : 0, THI = (J < 31) ? J : 31;
#pragma unroll
        for (int t = TLO; t <= THI; ++t) acc[t] += v * w[J - t];
        if constexpr (J + 1 < 62) CfLds<J + 1>::run(acc, w, us);
    }
};
__device__ __forceinline__ void cf_prompt_items(LAS unsigned char* lds, const bf16_t* PROJ, int it0, int itstride, int nitems, const float* cw, const float* cb, bf16_t* CONVOUT, float* pcfc) {
    const int tid = ltid(), w = __builtin_amdgcn_readfirstlane(tid >> 6), lane = tid & 63;
    LAS float* Us = (LAS float*)lds;
    if (it0 >= nitems) return;
    u32x4 av[8];
#define CF_LOAD(itx) do { const int r0_ = ((itx) >> 2) * 32, t0_ = r0_ % SEQ, cc_ = ((itx) & 3) * 512; \
        _Pragma("unroll") for (int i = 0; i < 8; ++i) { const int j = w + 8 * i, tt = j - 30; \
            if (j < 62 && t0_ + tt >= 0) av[i] = *(const u32x4*)(PROJ + (size_t)(r0_ + tt) * NPROJ + CUCF + cc_ + lane * 8); \
            else av[i] = (u32x4){0u, 0u, 0u, 0u}; } } while (0)
    CF_LOAD(it0);
    for (int it = it0; it < nitems; it += itstride) {
        const int row0 = (it >> 2) * 32, t0 = row0 % SEQ, b = row0 / SEQ, c0 = (it & 3) * 512;
        float* state_out = (t0 == SEQ - 32) ? pcfc + (size_t)b * 30 * DM : nullptr;
        float wv[31];
#pragma unroll
        for (int i = 0; i < 31; ++i) wv[i] = cw[i * DM + c0 + tid];
        const float bias = cb[c0 + tid];
#pragma unroll
        for (int i = 0; i < 8; ++i) { const int j = w + 8 * i;
            if (j < 62) { float a[8]; unpack8(av[i], a);
                const f32x4 u0 = (f32x4){a[0], a[1], a[2], a[3]}, u1 = (f32x4){a[4], a[5], a[6], a[7]};
                *(LAS f32x4*)(Us + j * 512 + lane * 8) = u0; *(LAS f32x4*)(Us + j * 512 + lane * 8 + 4) = u1;
                if (state_out && j >= 32) { float* sp = state_out + (size_t)(j - 32) * DM + c0 + lane * 8; *(f32x4*)sp = u0; *(f32x4*)(sp + 4) = u1; } } }
        LDS_BARRIER();
        if (it + itstride < nitems) CF_LOAD(it + itstride);
        float acc[32];
#pragma unroll
        for (int t = 0; t < 32; ++t) acc[t] = bias;
        CfLds<0>::run(acc, wv, Us + tid);
#pragma unroll
        for (int t = 0; t < 32; ++t) CONVOUT[(size_t)(row0 + t) * DM + c0 + tid] = (bf16_t)f2bf(acc[t]);
        LDS_BARRIER();
    }
#undef CF_LOAD
}

constexpr int LDP = 136;
constexpr int Q_B = 0, Q_BT = 34816, Q_X1 = 69632, Q_X2 = 87040, Q_H = 104448, Q_CS = 121856;

#define MFMA16(a, b, c) __builtin_amdgcn_mfma_f32_16x16x32_bf16((a), (b), (c), 0, 0, 0)

__device__ __forceinline__ void ssd_prompt(LAS unsigned char* lds, int b, int h, const bf16_t* XBC, const float* CS, const bf16_t* XT1, const bf16_t* XT2, const bf16_t* BT, bf16_t* MIX, float* p_ssm) {
    const int tid = ltid(), w = __builtin_amdgcn_readfirstlane(tid >> 6), lane = tid & 63, fr = lane & 15, fq = lane >> 4;
    const int g = h >> 3;
    const int rt = (w < 4) ? w : 11 - w;
    LAS bf16_t* Bs = (LAS bf16_t*)(lds + Q_B); LAS bf16_t* BTs = (LAS bf16_t*)(lds + Q_BT);
    LAS bf16_t* X1s = (LAS bf16_t*)(lds + Q_X1); LAS bf16_t* X2s = (LAS bf16_t*)(lds + Q_X2); LAS bf16_t* Hs = (LAS bf16_t*)(lds + Q_H);
    LAS float* css_all = (LAS float*)(lds + Q_CS);
    for (int i = tid; i < 64 * LDP / 2; i += 512) ((LAS unsigned*)Hs)[i] = 0u;
#pragma unroll
    for (int i = 0; i < 4; ++i) { const int j = tid + 512 * i; css_all[j] = CS[(size_t)(b * SEQ + j) * NH + h]; }
    f32x4 hacc[4];
#pragma unroll
    for (int pt = 0; pt < 4; ++pt) hacc[pt] = (f32x4){0.f, 0.f, 0.f, 0.f};
    u32x4 Bv[4], BTv[4], X1v[2], X2v[2]; bf16x8 afn[4];
#define SSD_PREFETCH(cidx) do { const int rb_ = b * SEQ + (cidx) * 128; const size_t ci_ = (size_t)(b * (SEQ / 128) + (cidx)); \
        _Pragma("unroll") for (int i = 0; i < 4; ++i) { const int idx = tid + 512 * i, rr = idx >> 4, ch = idx & 15; \
            Bv[i] = *(const u32x4*)(XBC + (size_t)(rb_ + rr) * XBCW + 2048 + g * 128 + ch * 8); BTv[i] = *(const u32x4*)(BT + (ci_ * 512 + g * 128 + rr) * 128 + ch * 8); } \
        _Pragma("unroll") for (int i = 0; i < 2; ++i) { const int idx = tid + 512 * i, rr = idx >> 4, ch = idx & 15; \
            X1v[i] = *(const u32x4*)(XT1 + (ci_ * DM + h * 64 + rr) * 128 + ch * 8); X2v[i] = *(const u32x4*)(XT2 + (ci_ * DM + h * 64 + rr) * 128 + ch * 8); } \
        _Pragma("unroll") for (int ks = 0; ks < 4; ++ks) afn[ks] = *(const bf16x8*)(XBC + (size_t)(rb_ + 16 * rt + fr) * XBCW + 2560 + g * 128 + ks * 32 + fq * 8); } while (0)
    SSD_PREFETCH(0);
    LDS_BARRIER();
    for (int c = 0; c < SEQ / 128; ++c) {
        const int rowbase = b * SEQ + c * 128;
        LAS float* css = css_all + c * 128;
        const float cs_last = css[127];
#pragma unroll
        for (int i = 0; i < 4; ++i) { const int idx = tid + 512 * i, rr = idx >> 4, ch = idx & 15;
            *(LAS u32x4*)(Bs + rr * LDP + ch * 8) = Bv[i]; *(LAS u32x4*)(BTs + rr * LDP + ch * 8) = BTv[i]; }
#pragma unroll
        for (int i = 0; i < 2; ++i) { const int idx = tid + 512 * i, rr = idx >> 4, ch = idx & 15;
            *(LAS u32x4*)(X1s + rr * LDP + ch * 8) = X1v[i]; *(LAS u32x4*)(X2s + rr * LDP + ch * 8) = X2v[i]; }
        bf16x8 afr[4];
#pragma unroll
        for (int ks = 0; ks < 4; ++ks) afr[ks] = afn[ks];
        if (c + 1 < SEQ / 128) SSD_PREFETCH(c + 1);
        LDS_BARRIER();
        u32x2 cbm[8];
        const float csi = css[16 * rt + fr];
#pragma unroll
        for (int jt = 0; jt < 8; ++jt) {
            cbm[jt] = (u32x2){0u, 0u};
            if (jt <= rt) {
                f32x4 a4 = (f32x4){0.f, 0.f, 0.f, 0.f};
#pragma unroll
                for (int ks = 0; ks < 4; ++ks) { const bf16x8 bb = *(const LAS bf16x8*)(Bs + (16 * jt + fr) * LDP + ks * 32 + fq * 8); a4 = MFMA16(bb, afr[ks], a4); }
                const f32x4 csj = *(const LAS f32x4*)(css + 16 * jt + 4 * fq);
                const int i = 16 * rt + fr, j0 = 16 * jt + 4 * fq;
#pragma unroll
                for (int r = 0; r < 4; ++r) a4[r] = (j0 + r <= i) ? a4[r] * __expf(csi - csj[r]) : 0.f;
                cbm[jt].x = pk2(a4[0], a4[1]); cbm[jt].y = pk2(a4[2], a4[3]);
            }
        }
        LDS_BARRIER();
        LAS bf16_t* Ms = Bs;
#pragma unroll
        for (int jt = 0; jt < 8; ++jt) if (jt <= (rt | 1)) {
            *(LAS u32x2*)(Ms + (16 * rt + fr) * LDP + 16 * jt + 4 * fq) = cbm[jt];
        }
        asm volatile("s_waitcnt lgkmcnt(0)" ::: "memory");
        f32x4 yacc[4];
#pragma unroll
        for (int pt = 0; pt < 4; ++pt) yacc[pt] = (f32x4){0.f, 0.f, 0.f, 0.f};
#pragma unroll
        for (int ks = 0; ks < 4; ++ks)
#pragma unroll
            for (int pt = 0; pt < 4; ++pt) { const bf16x8 bb = *(const LAS bf16x8*)(Hs + (16 * pt + fr) * LDP + ks * 32 + fq * 8); yacc[pt] = MFMA16(bb, afr[ks], yacc[pt]); }
        { const float e = __expf(csi);
#pragma unroll
          for (int pt = 0; pt < 4; ++pt) yacc[pt] *= e; }
#pragma unroll
        for (int ks = 0; ks < 4; ++ks) if (ks <= (rt >> 1)) {
            const bf16x8 am = *(const LAS bf16x8*)(Ms + (16 * rt + fr) * LDP + ks * 32 + fq * 8);
#pragma unroll
            for (int pt = 0; pt < 4; ++pt) { const bf16x8 bb = *(const LAS bf16x8*)(X1s + (16 * pt + fr) * LDP + ks * 32 + fq * 8); yacc[pt] = MFMA16(bb, am, yacc[pt]); }
        }
#pragma unroll
        for (int pt = 0; pt < 4; ++pt) { u32x2 pk; pk.x = pk2(yacc[pt][0], yacc[pt][1]); pk.y = pk2(yacc[pt][2], yacc[pt][3]);
            *(u32x2*)(MIX + (size_t)(rowbase + 16 * rt + fr) * DMIX + h * 64 + 16 * pt + 4 * fq) = pk; }
        { const float dl = __expf(cs_last);
#pragma unroll
          for (int pt = 0; pt < 4; ++pt) hacc[pt] *= dl; }
#pragma unroll
        for (int ks = 0; ks < 4; ++ks) { const bf16x8 bb = *(const LAS bf16x8*)(BTs + (16 * w + fr) * LDP + ks * 32 + fq * 8);
#pragma unroll
            for (int pt = 0; pt < 4; ++pt) { const bf16x8 aa = *(const LAS bf16x8*)(X2s + (16 * pt + fr) * LDP + ks * 32 + fq * 8); hacc[pt] = MFMA16(bb, aa, hacc[pt]); } }
        LDS_BARRIER();
#pragma unroll
        for (int pt = 0; pt < 4; ++pt) { u32x2 pk; pk.x = pk2(hacc[pt][0], hacc[pt][1]); pk.y = pk2(hacc[pt][2], hacc[pt][3]);
            *(LAS u32x2*)(Hs + (16 * pt + fr) * LDP + 16 * w + 4 * fq) = pk; }
    }
#undef SSD_PREFETCH
#pragma unroll
    for (int pt = 0; pt < 4; ++pt) *(f32x4*)(p_ssm + ((size_t)(b * NH + h) * HP + 16 * pt + fr) * NS + 16 * w + 4 * fq) = hacc[pt];
    LDS_BARRIER();
}

__device__ __forceinline__ void ssd_sample_items(LAS unsigned char* lds, int it0, int itstride, int nitems, const bf16_t* XBC, const float* DT, const float* a_log,
                                                 const float* state_in, bf16_t* MIX, float* s_ssm) {
    const int tid = ltid(), w = __builtin_amdgcn_readfirstlane(tid >> 6), lane = tid & 63, nl = lane & 31, half = lane >> 5;
    LAS float* Xs = (LAS float*)lds;
    if (it0 >= nitems) return;
    f32x4 nx[16];
    { const int b = it0 >> 2, g = it0 & 3, h = g * 8 + w; const float* sp = state_in + (size_t)(b * NH + h) * HP * NS;
#pragma unroll
      for (int k = 0; k < 16; ++k) nx[k] = *(const f32x4*)(sp + k * 256 + lane * 4); }
    for (int it = it0; it < nitems; it += itstride) {
        const int b = it >> 2, g = it & 3, h = g * 8 + w;
        u32x2 Bp[4], Cp[4]; float dtv[4];
#pragma unroll
        for (int t = 0; t < 4; ++t) { const size_t row = (size_t)(MP + 4 * b + t);
            Xs[t * 512 + tid] = bf2f(XBC[row * XBCW + g * 512 + tid]);
            Bp[t] = *(const u32x2*)(XBC + row * XBCW + 2048 + g * 128 + 4 * nl); Cp[t] = *(const u32x2*)(XBC + row * XBCW + 2560 + g * 128 + 4 * nl);
            dtv[t] = DT[row * NH + h]; }
        const float A = -__expf(a_log[h]);
        LDS_BARRIER();
#pragma unroll
        for (int hh = 0; hh < 2; ++hh) {
            f32x4 st[16];
#pragma unroll
            for (int k = 0; k < 16; ++k) st[k] = nx[k];
            {
                const int itn = it + itstride;
                if (hh == 0) { const float* sp = state_in + (size_t)(b * NH + h) * HP * NS + 4096;
#pragma unroll
                    for (int k = 0; k < 16; ++k) nx[k] = *(const f32x4*)(sp + k * 256 + lane * 4); }
                else if (itn < nitems) { const int bn = itn >> 2, gn = itn & 3; const float* sp = state_in + (size_t)(bn * NH + gn * 8 + w) * HP * NS;
#pragma unroll
                    for (int k = 0; k < 16; ++k) nx[k] = *(const f32x4*)(sp + k * 256 + lane * 4); }
            }
            float yv[4];
#pragma unroll
            for (int t = 0; t < 4; ++t) {
                const float dt = dtv[t]; const float da = __expf(dt * A);
                const f32x4 Bt = (f32x4){bf2f(Bp[t].x & 0xffffu), bf2f(Bp[t].x >> 16), bf2f(Bp[t].y & 0xffffu), bf2f(Bp[t].y >> 16)} * dt;
                const f32x4 Ct = (f32x4){bf2f(Cp[t].x & 0xffffu), bf2f(Cp[t].x >> 16), bf2f(Cp[t].y & 0xffffu), bf2f(Cp[t].y >> 16)};
                float part[8];
                { const bool up8 = (nl & 8) != 0;
#pragma unroll
                  for (int i = 0; i < 8; ++i) {
                    const float x0 = Xs[t * 512 + w * 64 + 32 * hh + 2 * i + half], x1 = Xs[t * 512 + w * 64 + 32 * hh + 2 * (i + 8) + half];
                    st[i] = st[i] * da + Bt * x0; st[i + 8] = st[i + 8] * da + Bt * x1;
                    const f32x4 q0 = Ct * st[i], q1 = Ct * st[i + 8];
                    const float p0 = (q0.x + q0.y) + (q0.z + q0.w), p1 = (q1.x + q1.y) + (q1.z + q1.w);
                    const float send = up8 ? p0 : p1, keep = up8 ? p1 : p0; part[i] = keep + __shfl_xor(send, 8); } }
#define BFLY(o) do { const bool up = (nl & (o)) != 0; _Pragma("unroll") for (int i = 0; i < (o); ++i) { \
                    const float send = up ? part[i] : part[i + (o)]; const float keep = up ? part[i + (o)] : part[i]; part[i] = keep + __shfl_xor(send, (o)); } } while (0)
                BFLY(4); BFLY(2); BFLY(1);
#undef BFLY
                yv[t] = part[0] + __shfl_xor(part[0], 16);
            }
            const int pout = 32 * hh + 2 * (nl & 15) + half;
            if ((nl & 16) == 0) {
#pragma unroll
                for (int t = 0; t < 4; ++t) MIX[(size_t)(MP + 4 * b + t) * DMIX + h * 64 + pout] = (bf16_t)f2bf(yv[t]);
            }
            float* op = s_ssm + (size_t)(b * NH + h) * HP * NS + hh * 4096;
#pragma unroll
            for (int k = 0; k < 16; ++k) *(f32x4*)(op + k * 256 + lane * 4) = st[k];
        }
        LDS_BARRIER();
    }
}

__device__ __forceinline__ void mix_finalize_ssd(size_t row, bf16_t* MIX, const bf16_t* XBC, const bf16_t* PROJ, const float* d_skip, const float* ssd_norm_w, int lane, bf16_t* ssd_dst) {
    bf16_t* mp = MIX + row * DMIX;
    {
        u32x4 yv[4], xv[4], zv[4]; float dsk[4];
#pragma unroll
        for (int k = 0; k < 4; ++k) { const int c = (k * 64 + lane) * 8;
            yv[k] = *(const u32x4*)(mp + c); xv[k] = *(const u32x4*)(XBC + row * XBCW + c); zv[k] = *(const u32x4*)(PROJ + row * NPROJ + CZ + c);
            dsk[k] = d_skip[c >> 6]; }
        float s = 0.f;
#pragma unroll
        for (int k = 0; k < 4; ++k) { float f[8], xf[8], zf[8]; unpack8(yv[k], f); unpack8(xv[k], xf); unpack8(zv[k], zf);
#pragma unroll
            for (int e = 0; e < 8; ++e) { f[e] = (f[e] + dsk[k] * xf[e]) * siluf_(zf[e]); s += f[e] * f[e]; }
            yv[k] = pack8(f); }
        const float r = rsqrtf(wave_sum(s) * (1.f / DM) + EPS);
#pragma unroll 1
        for (int k = 0; k < 4; ++k) { const int c = (k * 64 + lane) * 8;
            const f32x4 w0 = *(const f32x4*)(ssd_norm_w + c), w1 = *(const f32x4*)(ssd_norm_w + c + 4);
            const u32x4 yk = (k == 0) ? yv[0] : (k == 1) ? yv[1] : (k == 2) ? yv[2] : yv[3];
            float f[8]; unpack8(yk, f);
            float o[8]; o[0] = f[0] * r * w0.x; o[1] = f[1] * r * w0.y; o[2] = f[2] * r * w0.z; o[3] = f[3] * r * w0.w;
            o[4] = f[4] * r * w1.x; o[5] = f[5] * r * w1.y; o[6] = f[6] * r * w1.z; o[7] = f[7] * r * w1.w;
            *(u32x4*)(ssd_dst + c) = pack8(o); }
    }
}
__device__ __forceinline__ void mix_finalize_conformer(size_t row, bf16_t* MIX, const bf16_t* CONVOUT, const float* ln_w, const float* ln_b, int lane) {
    bf16_t* mp = MIX + row * DMIX;
    {
        const bf16_t* cp = CONVOUT + row * DM;
        f32x4 v[8], ww[8], bb[8];
#pragma unroll
        for (int k = 0; k < 8; ++k) { const u32x2 cv = *(const u32x2*)(cp + (k * 64 + lane) * 4); v[k] = (f32x4){bf2f(cv.x & 0xffffu), bf2f(cv.x >> 16), bf2f(cv.y & 0xffffu), bf2f(cv.y >> 16)};
            ww[k] = *(const f32x4*)(ln_w + (k * 64 + lane) * 4); bb[k] = *(const f32x4*)(ln_b + (k * 64 + lane) * 4); }
        float s = 0.f;
#pragma unroll
        for (int k = 0; k < 8; ++k) s += (v[k].x + v[k].y) + (v[k].z + v[k].w);
        const float mean = wave_sum(s) * (1.f / DM); float q = 0.f;
#pragma unroll
        for (int k = 0; k < 8; ++k) { v[k] = v[k] - mean; q += (v[k].x * v[k].x + v[k].y * v[k].y) + (v[k].z * v[k].z + v[k].w * v[k].w); }
        const float rstd = rsqrtf(wave_sum(q) * (1.f / DM) + EPS);
#pragma unroll
        for (int k = 0; k < 8; ++k) {
            const f32x4 o = v[k] * rstd * ww[k] + bb[k];
            u32x2 pk; pk.x = pk2(siluf_(o.x), siluf_(o.y)); pk.y = pk2(siluf_(o.z), siluf_(o.w));
            *(u32x2*)(mp + DM + (k * 64 + lane) * 4) = pk; }
    }
}

template <int NT, bool SAMPLE>
__device__ __forceinline__ void ffn_item(const bf16_t* U, int row0, bool has_hist, const float* st, int cgi, const float* w, const float* bias, bf16_t* ACT, float* state_out) {
    const int c0 = cgi * 8;
    float wg[3][8], wv[3][8], bg[8], bvv[8], g0[8], g1[8], v0[8], v1[8];
#define LD8(dst, ptr) do { const f32x4 a_ = *(const f32x4*)(ptr), b_ = *(const f32x4*)((ptr) + 4); dst[0] = a_.x; dst[1] = a_.y; dst[2] = a_.z; dst[3] = a_.w; dst[4] = b_.x; dst[5] = b_.y; dst[6] = b_.z; dst[7] = b_.w; } while (0)
#pragma unroll
    for (int i = 0; i < 3; ++i) { LD8(wg[i], w + i * FF2 + c0); LD8(wv[i], w + i * FF2 + FF + c0); }
    LD8(bg, bias + c0); LD8(bvv, bias + FF + c0);
    if (SAMPLE) {
        LD8(g0, st + 0 * FF2 + c0); LD8(g1, st + 1 * FF2 + c0); LD8(v0, st + 0 * FF2 + FF + c0); LD8(v1, st + 1 * FF2 + FF + c0);
    } else if (has_hist) {
        unpack8(*(const u32x4*)(U + (size_t)(row0 - 2) * FF2 + c0), g0); unpack8(*(const u32x4*)(U + (size_t)(row0 - 1) * FF2 + c0), g1);
        unpack8(*(const u32x4*)(U + (size_t)(row0 - 2) * FF2 + FF + c0), v0); unpack8(*(const u32x4*)(U + (size_t)(row0 - 1) * FF2 + FF + c0), v1);
    } else {
#pragma unroll
        for (int e = 0; e < 8; ++e) { g0[e] = 0.f; g1[e] = 0.f; v0[e] = 0.f; v1[e] = 0.f; }
    }
#undef LD8
    u32x4 rg[NT], rv[NT];
#pragma unroll
    for (int t = 0; t < NT; ++t) { rg[t] = *(const u32x4*)(U + (size_t)(row0 + t) * FF2 + c0); rv[t] = *(const u32x4*)(U + (size_t)(row0 + t) * FF2 + FF + c0); }
#pragma unroll
    for (int t = 0; t < NT; ++t) {
        float cg_[8], cv_[8], o[8];
        unpack8(rg[t], cg_); unpack8(rv[t], cv_);
#pragma unroll
        for (int e = 0; e < 8; ++e) {
            const float gg = g0[e] * wg[0][e] + g1[e] * wg[1][e] + cg_[e] * wg[2][e] + bg[e];
            const float vv = v0[e] * wv[0][e] + v1[e] * wv[1][e] + cv_[e] * wv[2][e] + bvv[e];
            o[e] = siluf_(gg) * vv; g0[e] = g1[e]; g1[e] = cg_[e]; v0[e] = v1[e]; v1[e] = cv_[e]; }
        *(u32x4*)(ACT + (size_t)(row0 + t) * FF + c0) = pack8(o);
    }
    if (state_out) {
#define ST8(ptr, src) do { *(f32x4*)(ptr) = (f32x4){src[0], src[1], src[2], src[3]}; *(f32x4*)((ptr) + 4) = (f32x4){src[4], src[5], src[6], src[7]}; } while (0)
        ST8(state_out + 0 * FF2 + c0, g0); ST8(state_out + 1 * FF2 + c0, g1); ST8(state_out + 0 * FF2 + FF + c0, v0); ST8(state_out + 1 * FF2 + FF + c0, v1);
#undef ST8
    }
}


#define XB_TMO      128
#define XB_XCNT(j)  (256  + 64 * (j))
#define XB_XSUB(j)  (1280 + 64 * (j))
#define XB_XGEN(j)  (2304 + 64 * (j))
#define XB_TOP      3328
#define XB_TOPGEN   3392
#define XCD_BAR_WORDS 3456
#define XB_SPIN_CAP (1u << 18)
__device__ __forceinline__ unsigned xb_ld(unsigned* p)              { return __hip_atomic_load(p, __ATOMIC_RELAXED, __HIP_MEMORY_SCOPE_AGENT); }
__device__ __forceinline__ unsigned xb_add(unsigned* p, unsigned v) { return __hip_atomic_fetch_add(p, v, __ATOMIC_RELAXED, __HIP_MEMORY_SCOPE_AGENT); }
__device__ __forceinline__ unsigned xb_xcc_id() { return (unsigned)__builtin_amdgcn_s_getreg((3 << 11) | 20) & 0xFu; }
#define XB_SPIN(cond, bar) do { unsigned _sp = 0; while (cond) { __builtin_amdgcn_s_sleep(1); \
    if ((++_sp & 255u) == 0u) { if (xb_ld(&(bar)[XB_TMO])) break; if (_sp > XB_SPIN_CAP) { atomicAdd(&(bar)[XB_TMO], 1u); break; } } } } while (0)
struct XcdBarrier { unsigned* bar; unsigned x; volatile LAS unsigned* st; };
__device__ __forceinline__ XcdBarrier xcd_barrier_post(unsigned* bar, volatile LAS unsigned* st) {
    XcdBarrier b; b.bar = bar; b.x = xb_xcc_id(); b.st = st;
    if (threadIdx.x == 0) (void)xb_add(&bar[XB_XCNT(b.x)], 1u);
    return b;
}
__device__ __forceinline__ void xcd_barrier_complete(unsigned* bar, unsigned x, unsigned& nloc, unsigned& nx) {
    const unsigned G = gridDim.x * gridDim.y * gridDim.z;
    unsigned sum, cnt, mine, sp = 0u;
    for (;;) {
        sum = 0u; cnt = 0u; mine = 0u;
#pragma unroll
        for (unsigned j = 0; j < 16; ++j) { const unsigned c = xb_ld(&bar[XB_XCNT(j)]); sum += c; cnt += (c > 0u) ? 1u : 0u; mine = (j == x) ? c : mine; }
        if (sum == G) break;
        __builtin_amdgcn_s_sleep(1);
        if ((++sp & 255u) == 0u) { if (xb_ld(&bar[XB_TMO])) break; if (sp > XB_SPIN_CAP) { atomicAdd(&bar[XB_TMO], 1u); break; } }
    }
    nloc = mine > 0u ? mine : 1u; nx = cnt > 0u ? cnt : 1u;
}
__device__ __forceinline__ void xcd_barrier(const XcdBarrier& b) {
    asm volatile("s_waitcnt vmcnt(0)" ::: "memory");
    __syncthreads();
    if (threadIdx.x == 0) {
        unsigned* bar = b.bar;
        __builtin_amdgcn_s_waitcnt(0);
        unsigned nloc = b.st[0], nx = b.st[1];
        if (nloc == 0u) { xcd_barrier_complete(bar, b.x, nloc, nx); b.st[0] = nloc; b.st[1] = nx; }
        const unsigned old = xb_add(&bar[XB_XSUB(b.x)], 1u);
        const unsigned gen = old / nloc;
        if (old + 1u == (gen + 1u) * nloc) {
            __builtin_amdgcn_fence(__ATOMIC_RELEASE, "agent");
            asm volatile("s_waitcnt vmcnt(0)" ::: "memory");
            const unsigned og = xb_add(&bar[XB_TOP], 1u);
            const unsigned tg = og / nx;
            if (og + 1u == (tg + 1u) * nx) xb_add(&bar[XB_TOPGEN], 1u);
            else XB_SPIN(xb_ld(&bar[XB_TOPGEN]) == tg, bar);
            __builtin_amdgcn_fence(__ATOMIC_ACQUIRE, "agent");
            xb_add(&bar[XB_XGEN(b.x)], 1u);
            asm volatile("s_waitcnt vmcnt(0)" ::: "memory");
        } else {
            XB_SPIN(xb_ld(&bar[XB_XGEN(b.x)]) == gen, bar);
            __builtin_amdgcn_fence(__ATOMIC_ACQUIRE, "agent");
            asm volatile("s_waitcnt vmcnt(0)" ::: "memory");
        }
    }
    __syncthreads();
}

struct Args { const float* in[25]; float* out_p; unsigned char* ws_p; int ph_lo, ph_hi, li, pad; };
constexpr int N_PHASES = 11;
typedef const __attribute__((address_space(4))) Args* KArgs;
__device__ __forceinline__ KArgs ka_get() { KArgs p = (KArgs)__builtin_amdgcn_kernarg_segment_ptr(); asm volatile("" : "+s"(p)); return p; }

__global__ void __launch_bounds__(512, 2) mk_fwd(Args args) {
    extern __shared__ __attribute__((aligned(16))) unsigned char lds_raw[];
    LAS unsigned char* lds = (LAS unsigned char*)lds_raw;
    const int tid = ltid(), lane = tid & 63, wave = __builtin_amdgcn_readfirstlane(tid >> 6);
    const int G = gridDim.x, bx = blockIdx.x;
    const int lo = args.ph_lo, hi = args.ph_hi;
#define x_prompt ((const float*)KA->in[0])
#define x_sample ((const float*)KA->in[1])
#define state_ssm ((const float*)KA->in[2])
#define state_ssdc ((const float*)KA->in[3])
#define state_cfc ((const float*)KA->in[4])
#define state_ffc ((const float*)KA->in[5])
#define norm_mix_w ((const float*)KA->in[6])
#define w_in ((const float*)KA->in[7])
#define ssd_conv_w ((const float*)KA->in[8])
#define ssd_conv_b ((const float*)KA->in[9])
#define dt_bias ((const float*)KA->in[10])
#define a_log ((const float*)KA->in[11])
#define d_skip ((const float*)KA->in[12])
#define ssd_norm_w ((const float*)KA->in[13])
#define cf_conv_w ((const float*)KA->in[14])
#define cf_conv_b ((const float*)KA->in[15])
#define cf_ln_w ((const float*)KA->in[16])
#define cf_ln_b ((const float*)KA->in[17])
#define w_out ((const float*)KA->in[18])
#define norm_ffn_w ((const float*)KA->in[19])
#define w_up ((const float*)KA->in[20])
#define ffn_conv_w ((const float*)KA->in[21])
#define ffn_conv_b ((const float*)KA->in[22])
#define w_down ((const float*)KA->in[23])
#define norm_final_w ((const float*)KA->in[24])
#define out ((float*)KA->out_p)
#define ws ((unsigned char*)KA->ws_p)
#define WinT ((bf16_t*)(ws + WS_WIN))
#define WoutT ((bf16_t*)(ws + WS_WOUT))
#define WupT ((bf16_t*)(ws + WS_WUP))
#define WdnT ((bf16_t*)(ws + WS_WDN))
#define XN ((bf16_t*)(ws + WS_XN))
#define DT ((float*)(ws + WS_DT))
#define PROJ ((bf16_t*)(ws + WS_PROJ))
#define XBC ((bf16_t*)(ws + WS_XBC))
#define U ((bf16_t*)(ws + WS_U))
#define CONVOUT ((bf16_t*)(ws + WS_CONV))
#define MIX ((bf16_t*)(ws + WS_MIX))
#define ACT ((bf16_t*)(ws + WS_ACT))
#define PART ((float*)(ws + WS_RA))
    constexpr int S2 = 8, S4 = 7;

#ifndef PHASE_MASK
#define PHASE_MASK 0x7ff
#endif
#define IN(k) (((PHASE_MASK >> (k)) & 1) && lo <= (k) && (k) < hi)
    volatile LAS unsigned* bst = (volatile LAS unsigned*)(lds + LDS_BYTES - 64);
    if (tid < 2) bst[tid] = 0u;
    __syncthreads();
    const KArgs KA0 = ka_get();
    const XcdBarrier gbar = xcd_barrier_post((unsigned*)((unsigned char*)KA0->ws_p + WS_CTL) + (args.li & 0xff) * XCD_BAR_WORDS, bst);
    const int psel = args.li >> 8;
    if (args.pad != 0) cg::this_grid().sync();
#define SEAM(k) do { if (IN(k) && IN((k) + 1)) xcd_barrier(gbar); } while (0)

    if (IN(0)) { const KArgs KA = ka_get(); const int tid = ltid(), lane = tid & 63, wave = __builtin_amdgcn_readfirstlane(tid >> 6); (void)lane; (void)wave;
        LAS float* scr = (LAS float*)(lds + wave * 16384);
        const int gw = bx * 8 + wave, NGW = G * 8;
        constexpr int I_IN = (DM / 64) * (9248 / 32), I_OUT = (DMIX / 64) * (DM / 32), I_UP = (DM / 64) * (FF2 / 32), I_DN = (FF / 64) * (DM / 32);
        constexpr int n_items0 = I_IN + I_OUT + I_UP + I_DN;
        for (int it = gw; it < n_items0; it += NGW) {
            int r = it;
            if (r < I_IN) { const int nblk = 9248 / 32, kb = r / nblk, nb = r % nblk; p0_transpose_item(w_in, DM, 9248, WinT, 64 * kb, 32 * nb, win_dest_row(32 * nb), scr, lane); continue; } r -= I_IN;
            if (r < I_OUT) { const int nblk = DM / 32, kb = r / nblk, nb = r % nblk; p0_transpose_item(w_out, DMIX, DM, WoutT, 64 * kb, 32 * nb, 32 * nb, scr, lane); continue; } r -= I_OUT;
            if (r < I_UP) { const int nblk = FF2 / 32, kb = r / nblk, nb = r % nblk; p0_transpose_item(w_up, DM, FF2, WupT, 64 * kb, 32 * nb, 32 * nb, scr, lane, norm_ffn_w); continue; } r -= I_UP;
            { const int nblk = DM / 32, kb = r / nblk, nb = r % nblk; p0_transpose_item(w_down, FF, DM, WdnT, 64 * kb, 32 * nb, 32 * nb, scr, lane); }
        }
        const int gr = (gw + NGW - (n_items0 % NGW)) % NGW;
        for (int m = gr; m < MT; m += NGW) { const float* xr = (m < MP) ? x_prompt + (size_t)m * DM : x_sample + (size_t)(m - MP) * DM; rms_row_to_bf16(xr, norm_mix_w, XN + (size_t)m * DM, lane); }
    }
    SEAM(0);
    if (IN(1)) { const KArgs KA = ka_get(); const int tid = ltid(), lane = tid & 63, wave = __builtin_amdgcn_readfirstlane(tid >> 6); (void)lane; (void)wave;
        pg8::Gemm g{XN, WinT, MT, NPROJ, DM}; pg8::StaticOrder S; S.init(MT, NPROJ, G, bx, DM);
        pg8::EpiBf16 E{PROJ, NPROJ, nullptr, CCF / 256, CUCF};
        pg8::gemm_phase<pg8::EpiBf16, pg8::StaticOrder, true, true>(lds, g, S, E);
    }
    SEAM(1);
    if (IN(2)) { const KArgs KA = ka_get(); const int tid = ltid(), lane = tid & 63, wave = __builtin_amdgcn_readfirstlane(tid >> 6); (void)lane; (void)wave;
        bf16_t* XT1 = (bf16_t*)(ws + WS_XT1); bf16_t* XT2 = (bf16_t*)((unsigned char*)out + OS_XT2); bf16_t* BT = (bf16_t*)((unsigned char*)out + OS_BT); float* CS = (float*)((unsigned char*)out + OS_CS);
        {   const int gw = bx * 8 + wave, NGW = G * 8;
            for (int it = gw; it < 64 * NH + (MS * NH) / 64; it += NGW) {
                if (it < 64 * NH) { const int ci = it >> 5, h = it & 31, rb = ci * 128;
                    const float bias = dt_bias[h], A = -__expf(a_log[h]);
                    const float v0 = bf2f(PROJ[(size_t)(rb + 2 * lane) * NPROJ + CDT + h]) + bias, v1 = bf2f(PROJ[(size_t)(rb + 2 * lane + 1) * NPROJ + CDT + h]) + bias;
                    const float d0 = fmaxf(v0, 0.f) + log1pf(__expf(-fabsf(v0))), d1 = fmaxf(v1, 0.f) + log1pf(__expf(-fabsf(v1)));
                    const float a1 = d1 * A; float sc = d0 * A + a1;
#pragma unroll
                    for (int o = 1; o < 64; o <<= 1) { const float t = __shfl_up(sc, o); if (lane >= o) sc += t; }
                    DT[(size_t)(rb + 2 * lane) * NH + h] = d0; DT[(size_t)(rb + 2 * lane + 1) * NH + h] = d1;
                    CS[(size_t)(rb + 2 * lane) * NH + h] = sc - a1; CS[(size_t)(rb + 2 * lane + 1) * NH + h] = sc; }
                else { const int e = (it - 64 * NH) * 64 + lane, row = MP + (e >> 5), h = e & 31;
                    const float v = bf2f(PROJ[(size_t)row * NPROJ + CDT + h]) + dt_bias[h];
                    DT[(size_t)row * NH + h] = fmaxf(v, 0.f) + log1pf(__expf(-fabsf(v))); }
            }
        }
        if (psel != 1) {
            cf_prompt_items(lds, PROJ, bx, G, 1024, cf_conv_w, cf_conv_b, CONVOUT, out + O_PCFC);
            for (int it2 = bx; it2 < 256; it2 += G) { const int s = it2 >> 1, c = (it2 & 1) * 1024 + tid * 2;
                cf_sample_item(PROJ, s, c, state_cfc + (size_t)s * 30 * DM, cf_conv_w, cf_conv_b, CONVOUT, out + O_SCFC + (size_t)s * 30 * DM); }
        }
        xcd_barrier(gbar);
        const int gt = bx * 512 + tid, NGT = G * 512;
        if (psel != 2) for (int it = gt; it < (MP / 8) * 384; it += NGT) {
            const int cq = it & 7, tgl = (it >> 3) & 7, rest = it >> 6; const int cgi = (rest % 48) * 8 + cq, tg = (rest / 48) * 8 + tgl; const int row0 = tg * 8, t0 = row0 % SEQ, b = row0 / SEQ;
            ssdconv_prompt_item(PROJ, row0, t0 > 0, cgi, ssd_conv_w, ssd_conv_b, XBC, (t0 == SEQ - 8) ? out + O_PSSDC + (size_t)b * 3 * XBCW : nullptr, DT, CS, XT1, XT2, BT); }
        for (int it = gt; it < DB * 384; it += NGT) { const int cgi = it % 384, s = it / 384;
            ssdconv_item<4, true>(PROJ, MP + 4 * s, true, state_ssdc + (size_t)s * 3 * XBCW, cgi, ssd_conv_w, ssd_conv_b, XBC, out + O_SSSDC + (size_t)s * 3 * XBCW); }
    }
    SEAM(2);
    if (IN(3)) { const KArgs KA = ka_get(); const int tid = ltid(), lane = tid & 63, wave = __builtin_amdgcn_readfirstlane(tid >> 6); (void)lane; (void)wave;
        const bf16_t* XT1 = (const bf16_t*)(ws + WS_XT1); const bf16_t* XT2 = (const bf16_t*)((unsigned char*)out + OS_XT2); const bf16_t* BT = (const bf16_t*)((unsigned char*)out + OS_BT); const float* CS = (const float*)((unsigned char*)out + OS_CS);
        const int npb = (G >= 256) ? 128 : (G / 2 > 0 ? G / 2 : 1);
        if (bx < npb) { if (psel != 2) for (int it = bx; it < NB * NH; it += npb) ssd_prompt(lds, it >> 5, it & 31, XBC, CS, XT1, XT2, BT, MIX, out + O_PSSM); }
        else { if (psel != 1) ssd_sample_items(lds, bx - npb, G - npb, DB * NG, XBC, DT, a_log, state_ssm, MIX, out + O_SSSM);
            if (psel == 0) for (int m = (bx - npb) * 8 + wave; m < MT; m += (G - npb) * 8) mix_finalize_conformer((size_t)m, MIX, CONVOUT, cf_ln_w, cf_ln_b, lane); }
    }
    SEAM(3);
    if (IN(4)) { const KArgs KA = ka_get(); const int tid = ltid(), lane = tid & 63, wave = __builtin_amdgcn_readfirstlane(tid >> 6); (void)lane; (void)wave;
        for (int m = bx * 8 + wave; m < MP; m += G * 8) mix_finalize_ssd((size_t)m, MIX, XBC, PROJ, d_skip, ssd_norm_w, lane, (psel == 3) ? XN + (size_t)m * DM : MIX + (size_t)m * DMIX);
        LAS float* red = (LAS float*)lds;
        for (int m0 = MP + 2 * bx; m0 < MT; m0 += 2 * G) {
            const size_t m = (size_t)(m0 + (wave >> 2)); const int q = wave & 3, c = q * 512 + lane * 8;
            bf16_t* mp = MIX + m * DMIX;
            const u32x4 yv = *(const u32x4*)(mp + c), xv = *(const u32x4*)(XBC + m * XBCW + c), zv = *(const u32x4*)(PROJ + m * NPROJ + CZ + c);
            const float dsk = d_skip[c >> 6]; const f32x4 w0 = *(const f32x4*)(ssd_norm_w + c), w1 = *(const f32x4*)(ssd_norm_w + c + 4);
            float f[8], xf[8], zf[8]; unpack8(yv, f); unpack8(xv, xf); unpack8(zv, zf);
            float sq = 0.f;
#pragma unroll
            for (int e = 0; e < 8; ++e) { f[e] = (f[e] + dsk * xf[e]) * siluf_(zf[e]); sq += f[e] * f[e]; }
            sq = wave_sum(sq);
            if (lane == 0) red[wave] = sq;
            LDS_BARRIER();
            const float tot = red[(wave & 4) + 0] + red[(wave & 4) + 1] + red[(wave & 4) + 2] + red[(wave & 4) + 3];
            const float r = rsqrtf(tot * (1.f / DM) + EPS);
            float o[8]; o[0] = f[0] * r * w0.x; o[1] = f[1] * r * w0.y; o[2] = f[2] * r * w0.z; o[3] = f[3] * r * w0.w; o[4] = f[4] * r * w1.x; o[5] = f[5] * r * w1.y; o[6] = f[6] * r * w1.z; o[7] = f[7] * r * w1.w;
            bf16_t* dst = (psel == 3) ? XN + m * DM : mp;
            *(u32x4*)(dst + c) = pack8(o);
            LDS_BARRIER();
        }
    }
    SEAM(4);
    if (IN(5)) { const KArgs KA = ka_get(); const int tid = ltid(), lane = tid & 63, wave = __builtin_amdgcn_readfirstlane(tid >> 6); (void)lane; (void)wave;
        pg8::Gemm g{MIX, WoutT, MT, DM, DMIX}; pg8::SplitOrder S; S.init(DMIX, G, bx, S2, 8);
        pg8::EpiX1 E{x_prompt, XN, (float*)(ws + WS_CTL + CTL_SSQ1), PART, psel == 3};
        pg8::gemm_phase<pg8::EpiX1, pg8::SplitOrder, true, true>(lds, g, S, E);
    }
    SEAM(5);
    if (IN(6)) { const KArgs KA = ka_get(); const int tid = ltid(), lane = tid & 63, wave = __builtin_amdgcn_readfirstlane(tid >> 6); (void)lane; (void)wave;
        float* SSQ1 = (float*)(ws + WS_CTL + CTL_SSQ1);
        for (int m = MP + bx * 8 + wave; m < MT; m += G * 8) {
            const float* base = x_sample + (size_t)(m - MP) * DM; const float* part = PART + (size_t)(m - MP) * DM;
            f32x4 v[8];
#pragma unroll
            for (int j = 0; j < 8; ++j) v[j] = *(const f32x4*)(base + (j * 64 + lane) * 4);
            for (int sp = 0; sp < S2; ++sp) {
#pragma unroll
                for (int j = 0; j < 8; ++j) v[j] += *(const f32x4*)(part + (size_t)sp * MS * DM + (j * 64 + lane) * 4); }
            float sq = 0.f;
#pragma unroll
            for (int j = 0; j < 8; ++j) sq += (v[j].x * v[j].x + v[j].y * v[j].y) + (v[j].z * v[j].z + v[j].w * v[j].w);
            sq = wave_sum(sq);
            if (lane == 0) SSQ1[m] = sq;
#pragma unroll
            for (int j = 0; j < 8; ++j) { u32x2 o; o.x = pk2(v[j].x, v[j].y); o.y = pk2(v[j].z, v[j].w); *(u32x2*)(XN + (size_t)m * DM + (j * 64 + lane) * 4) = o; }
        }
    }
    SEAM(6);
    if (IN(7)) { const KArgs KA = ka_get(); const int tid = ltid(), lane = tid & 63, wave = __builtin_amdgcn_readfirstlane(tid >> 6); (void)lane; (void)wave;
        pg8::Gemm g{XN, WupT, MT, FF2, DM}; pg8::StaticOrder S; S.init(MT, FF2, G, bx, DM);
        pg8::EpiBf16 E{U, FF2, (const float*)(ws + WS_CTL + CTL_SSQ1), -1, 0};
        pg8::gemm_phase<pg8::EpiBf16, pg8::StaticOrder, true, true>(lds, g, S, E);
    }
    SEAM(7);
    if (IN(8)) { const KArgs KA = ka_get(); const int tid = ltid(), lane = tid & 63, wave = __builtin_amdgcn_readfirstlane(tid >> 6); (void)lane; (void)wave;
        const int gt = bx * 512 + tid, NGT = G * 512;
        for (int it = gt; it < (MP / 8) * 688; it += NGT) { const int cgi = it % 688, tg = it / 688; const int row0 = tg * 8, t0 = row0 % SEQ, b = row0 / SEQ;
            ffn_item<8, false>(U, row0, t0 > 0, nullptr, cgi, ffn_conv_w, ffn_conv_b, ACT, (t0 == SEQ - 8) ? out + O_PFFC + (size_t)b * 2 * FF2 : nullptr); }
        for (int it = gt; it < DB * 688; it += NGT) { const int cgi = it % 688, s = it / 688;
            ffn_item<4, true>(U, MP + 4 * s, true, state_ffc + (size_t)s * 2 * FF2, cgi, ffn_conv_w, ffn_conv_b, ACT, out + O_SFFC + (size_t)s * 2 * FF2); }
    }
    SEAM(8);
    if (IN(9)) { const KArgs KA = ka_get(); const int tid = ltid(), lane = tid & 63, wave = __builtin_amdgcn_readfirstlane(tid >> 6); (void)lane; (void)wave;
        pg8::Gemm g{ACT, WdnT, MT, DM, FF}; pg8::SplitOrder S; S.init(FF, G, bx, S4, 12);
        pg8::EpiResF32 E{XN, out + O_Y, PART, psel == 3};
        pg8::gemm_phase<pg8::EpiResF32, pg8::SplitOrder, true, true>(lds, g, S, E);
    }
    SEAM(9);
    if (IN(10)) { const KArgs KA = ka_get(); const int tid = ltid(), lane = tid & 63, wave = __builtin_amdgcn_readfirstlane(tid >> 6); (void)lane; (void)wave;
        for (int m = bx * 8 + wave; m < MP; m += G * 8) {
            float* xr = out + O_Y + (size_t)m * DM;
            f32x4 v[8], ww[8];
#pragma unroll
            for (int j = 0; j < 8; ++j) { const u32x2 b = *(const u32x2*)(XN + (size_t)m * DM + (j * 64 + lane) * 4); v[j] = (f32x4){bf2f(b.x & 0xffffu), bf2f(b.x >> 16), bf2f(b.y & 0xffffu), bf2f(b.y >> 16)};
                ww[j] = *(const f32x4*)(norm_final_w + (j * 64 + lane) * 4); }
            float s = 0.f;
#pragma unroll
            for (int j = 0; j < 8; ++j) s += (v[j].x * v[j].x + v[j].y * v[j].y) + (v[j].z * v[j].z + v[j].w * v[j].w);
            const float r = rsqrtf(wave_sum(s) * (1.f / DM) + EPS);
#pragma unroll
            for (int j = 0; j < 8; ++j) *(f32x4*)(xr + (j * 64 + lane) * 4) = v[j] * r * ww[j];
        }
        LAS float* red = (LAS float*)lds;
        for (int m0 = MP + 2 * bx; m0 < MT; m0 += 2 * G) {
            const size_t m = (size_t)(m0 + (wave >> 2)); const int q = wave & 3, c = q * 512 + lane * 8;
            const u32x4 b = *(const u32x4*)(XN + m * DM + c);
            const f32x4 w0 = *(const f32x4*)(norm_final_w + c), w1 = *(const f32x4*)(norm_final_w + c + 4);
            float f[8]; unpack8(b, f);
            f32x4 v0 = (f32x4){f[0], f[1], f[2], f[3]}, v1 = (f32x4){f[4], f[5], f[6], f[7]};
            const float* part = PART + (m - MP) * DM + c;
            for (int sp = 0; sp < S4; ++sp) { v0 += *(const f32x4*)(part + (size_t)sp * MS * DM); v1 += *(const f32x4*)(part + (size_t)sp * MS * DM + 4); }
            float sq = (v0.x * v0.x + v0.y * v0.y) + (v0.z * v0.z + v0.w * v0.w) + (v1.x * v1.x + v1.y * v1.y) + (v1.z * v1.z + v1.w * v1.w);
            sq = wave_sum(sq);
            if (lane == 0) red[wave] = sq;
            LDS_BARRIER();
            const float tot = red[(wave & 4) + 0] + red[(wave & 4) + 1] + red[(wave & 4) + 2] + red[(wave & 4) + 3];
            const float r = rsqrtf(tot * (1.f / DM) + EPS);
            float* xr = out + O_Y + m * DM + c;
            *(f32x4*)xr = v0 * r * w0; *(f32x4*)(xr + 4) = v1 * r * w1;
            LDS_BARRIER();
        }
    }
#undef IN
#undef SEAM
}
#undef x_prompt
#undef x_sample
#undef state_ssm
#undef state_ssdc
#undef state_cfc
#undef state_ffc
#undef norm_mix_w
#undef w_in
#undef ssd_conv_w
#undef ssd_conv_b
#undef dt_bias
#undef a_log
#undef d_skip
#undef ssd_norm_w
#undef cf_conv_w
#undef cf_conv_b
#undef cf_ln_w
#undef cf_ln_b
#undef w_out
#undef norm_ffn_w
#undef w_up
#undef ffn_conv_w
#undef ffn_conv_b
#undef w_down
#undef norm_final_w
#undef out
#undef ws
#undef WinT
#undef WoutT
#undef WupT
#undef WdnT
#undef XN
#undef DT
#undef PROJ
#undef XBC
#undef U
#undef CONVOUT
#undef MIX
#undef ACT
#undef PART


extern "C" void kernel_launch(void* const* d_in, const int* in_sizes, int n_in, void* d_out, int out_size, void* d_ws, size_t ws_size, hipStream_t stream) {
    static int grid = 0;
    if (grid == 0) {
        if (n_in != 25 || (size_t)out_size != O_END || ws_size < WS_END) {
            fprintf(stderr, "kernel_launch: shape mismatch: n_in %d out %d (want %zu) ws %zu (need %zu)\n", n_in, out_size, (size_t)O_END, ws_size, (size_t)WS_END); grid = -1; return; }
        int dev = 0, cus = 0, per_cu = 0;
        hipGetDevice(&dev);
        hipDeviceGetAttribute(&cus, hipDeviceAttributeMultiprocessorCount, dev);
        if (hipFuncSetAttribute((const void*)mk_fwd, hipFuncAttributeMaxDynamicSharedMemorySize, LDS_BYTES) != hipSuccess) { fprintf(stderr, "kernel_launch: hipFuncSetAttribute failed\n"); grid = -1; return; }
        if (hipOccupancyMaxActiveBlocksPerMultiprocessor(&per_cu, (const void*)mk_fwd, 512, LDS_BYTES) != hipSuccess || per_cu < 1) { fprintf(stderr, "kernel_launch: occupancy query %d\n", per_cu); per_cu = 1; }
        (void)hipGetLastError();
        grid = cus * per_cu;
    }
    if (grid < 0) return;
    Args a{};
    for (int i = 0; i < 25; ++i) a.in[i] = (const float*)d_in[i];
    a.out_p = (float*)d_out; a.ws_p = (unsigned char*)d_ws;
#ifndef PROBE_SEL
#define PROBE_SEL 0
#endif
#ifndef PROBE_PHASE
#define PROBE_PHASE -1
#endif
    int ranges[3][2]; int nr = 0;
    if (PROBE_PHASE < 0) { ranges[0][0] = 0; ranges[0][1] = N_PHASES; nr = 1; }
    else { ranges[0][0] = 0; ranges[0][1] = PROBE_PHASE + 1; ranges[1][0] = PROBE_PHASE; ranges[1][1] = PROBE_PHASE + 1; nr = 2;
           if (PROBE_PHASE + 1 < N_PHASES) { ranges[2][0] = PROBE_PHASE + 1; ranges[2][1] = N_PHASES; nr = 3; } }
    if (hipMemsetAsync((char*)d_ws + WS_CTL, 0, CTL_BYTES, stream) != hipSuccess) { fprintf(stderr, "kernel_launch: memset failed\n"); return; }
    for (int i = 0; i < nr; ++i) {
        a.ph_lo = ranges[i][0]; a.ph_hi = ranges[i][1]; a.li = i | ((i == 1) ? (PROBE_SEL << 8) : 0);
        void* kargs[] = {&a};
        hipError_t e = hipLaunchCooperativeKernel((const void*)mk_fwd, dim3(grid), dim3(512), kargs, LDS_BYTES, stream);
        if (e != hipSuccess) fprintf(stderr, "kernel_launch: cooperative launch failed: %s (grid %d)\n", hipGetErrorString(e), grid);
    }
}
```

```cpp
#include <hip/hip_runtime.h>
#include <hip/hip_cooperative_groups.h>
#include <cstdio>
#include <cstdint>
namespace cg = cooperative_groups;

#ifndef MK_N_LAUNCHES
#define MK_N_LAUNCHES 1
#endif

#define LAS __attribute__((address_space(3)))
typedef unsigned short bf16_t;
typedef short bf16x8 __attribute__((ext_vector_type(8)));
typedef float f32x4 __attribute__((ext_vector_type(4)));
typedef float f32x2 __attribute__((ext_vector_type(2)));
typedef unsigned u32x4 __attribute__((ext_vector_type(4)));
typedef unsigned u32x2 __attribute__((ext_vector_type(2)));

constexpr int DM = 2048;
constexpr int MP = 8192, MS = 512, MT = MP + MS;
constexpr int SEQ = 2048, NB = 4, DB = 128, DSEQ = 4;
constexpr int NH = 32, HP = 64, NS = 128, NG = 4;
constexpr int XBCW = 3072;
constexpr int NPROJ = 9472;
constexpr int CZ = 0, CXBC = 2048, CCF = 5120, CDT = 9216;
constexpr int CUCF = 5120;
constexpr int DMIX = 4096, FF = 5504, FF2 = 11008;
constexpr float EPS = 1e-5f;

constexpr size_t O_Y = 0;
constexpr size_t O_PSSM = (size_t)MT * DM;
constexpr size_t O_PSSDC = O_PSSM + (size_t)NB * NH * HP * NS;
constexpr size_t O_PCFC = O_PSSDC + (size_t)NB * 3 * XBCW;
constexpr size_t O_PFFC = O_PCFC + (size_t)NB * 30 * DM;
constexpr size_t O_SSSM = O_PFFC + (size_t)NB * 2 * FF2;
constexpr size_t O_SSSDC = O_SSSM + (size_t)DB * NH * HP * NS;
constexpr size_t O_SCFC = O_SSSDC + (size_t)DB * 3 * XBCW;
constexpr size_t O_SFFC = O_SCFC + (size_t)DB * 30 * DM;
constexpr size_t O_END = O_SFFC + (size_t)DB * 2 * FF2;

constexpr size_t al256(size_t x) { return (x + 255) & ~(size_t)255; }
constexpr size_t WS_WIN = 0;
constexpr size_t WS_WOUT = WS_WIN + al256((size_t)NPROJ * DM * 2);
constexpr size_t WS_WUP = WS_WOUT + al256((size_t)DM * DMIX * 2);
constexpr size_t WS_WDN = WS_WUP + al256((size_t)FF2 * DM * 2);
constexpr size_t WS_XN = WS_WDN + al256((size_t)DM * FF * 2);
constexpr size_t WS_DT = WS_XN + al256((size_t)MT * DM * 2);
constexpr size_t WS_RA = WS_DT + al256((size_t)MT * NH * 4);
constexpr size_t WS_PROJ = WS_RA;
constexpr size_t WS_XBC = WS_PROJ + al256((size_t)MT * NPROJ * 2);
constexpr size_t WS_U = WS_RA;
constexpr size_t WS_RB = WS_XBC + al256((size_t)MT * XBCW * 2);
constexpr size_t WS_CONV = WS_RB;
constexpr size_t WS_MIX = WS_CONV + al256((size_t)MT * DM * 4);
constexpr size_t WS_ACT = WS_RB;
constexpr size_t WS_CTL = WS_MIX + al256((size_t)MT * DMIX * 2);
constexpr size_t CTL_BYTES = 131072;
constexpr size_t CTL_SSQ1 = 65536;
constexpr size_t WS_END = WS_CTL + CTL_BYTES;
static_assert((size_t)MT * FF2 * 2 <= WS_RB - WS_RA, "U overlay");
static_assert((size_t)MT * FF * 2 <= WS_END - WS_RB, "ACT overlay");

constexpr size_t WS_XT1 = WS_XN;
constexpr size_t OS_XT2 = 0, OS_BT = OS_XT2 + (size_t)MP * DM * 2, OS_CS = OS_BT + (size_t)64 * 512 * 128 * 2;
static_assert((size_t)MP * DM * 2 <= (size_t)MT * DM * 2 && OS_CS + (size_t)MP * NH * 4 <= (size_t)MT * DM * 4, "ssd scratch maps");
constexpr int LDS_BYTES = 147456;

__device__ __forceinline__ int ltid() { int t = threadIdx.x; asm volatile("" : "+v"(t)); return t; }
__device__ __forceinline__ float bf2f(unsigned h) { return __uint_as_float(h << 16); }
__device__ __forceinline__ unsigned f2bf(float f) { unsigned u = __float_as_uint(f); return (u + 0x7fffu + ((u >> 16) & 1u)) >> 16; }
__device__ __forceinline__ unsigned pk2(float lo, float hi) { unsigned r; asm("v_cvt_pk_bf16_f32 %0, %1, %2" : "=v"(r) : "v"(lo), "v"(hi)); return r; }
__device__ __forceinline__ float sigmoidf_(float x) { return __builtin_amdgcn_rcpf(1.f + __expf(-x)); }
__device__ __forceinline__ float siluf_(float x) { return x * __builtin_amdgcn_rcpf(1.f + __expf(-x)); }
#define LDS_BARRIER() do { asm volatile("s_waitcnt lgkmcnt(0)" ::: "memory"); __builtin_amdgcn_s_barrier(); asm volatile("" ::: "memory"); } while (0)
__device__ __forceinline__ float wave_sum(float v) {
#pragma unroll
    for (int o = 1; o < 64; o <<= 1) v += __shfl_xor(v, o);
    return v;
}
__device__ __forceinline__ void unpack8(const u32x4 v, float (&o)[8]) {
    o[0] = bf2f(v.x & 0xffffu); o[1] = bf2f(v.x >> 16); o[2] = bf2f(v.y & 0xffffu); o[3] = bf2f(v.y >> 16);
    o[4] = bf2f(v.z & 0xffffu); o[5] = bf2f(v.z >> 16); o[6] = bf2f(v.w & 0xffffu); o[7] = bf2f(v.w >> 16);
}
__device__ __forceinline__ u32x4 pack8(const float (&o)[8]) {
    u32x4 v; v.x = pk2(o[0], o[1]); v.y = pk2(o[2], o[3]); v.z = pk2(o[4], o[5]); v.w = pk2(o[6], o[7]); return v;
}

namespace pg8 {
#define PG8_LAS __attribute__((address_space(3)))
constexpr int BM = 256, BK = 64, HALF = 128, HTB = HALF * BK * 2, STAGE_BYTES = 8 * HTB, NXCD = 8, WGM = 8;
__host__ __device__ __forceinline__ int lds_byte(int r, int c) { const int st = (r >> 4) * 2 + (c >> 5), rr = r & 15, cc = c & 31, ob = rr * 64 + cc * 2; return st * 1024 + (ob ^ (((ob >> 9) & 1) << 5)); }
__host__ __device__ __forceinline__ void stage_rc(int b, int& R, int& C) { const int st = b / 1024, sb = b % 1024, swz = sb ^ (((sb >> 9) & 1) << 5); R = (st >> 1) * 16 + swz / 64; C = (st & 1) * 32 + (swz % 64) / 2; }
__host__ __device__ __forceinline__ int perm32(int rho) { const int n = rho >> 4, i = rho & 15; return 8 * (i >> 2) + 4 * n + (i & 3); }

struct Unit { int pm, pn, kt0, nkt, split; };
struct Gemm { const bf16_t* A; const bf16_t* Bt; int M, N, K; };
__host__ __device__ __forceinline__ unsigned long long pack_fields(int pm, int pn, int kt0, int nkt, int split) {
    return (unsigned long long)pm | ((unsigned long long)pn << 8) | ((unsigned long long)kt0 << 16) | ((unsigned long long)nkt << 24) | ((unsigned long long)(split + 1) << 32) | (1ull << 40); }
__host__ __device__ __forceinline__ unsigned long long pack_unit(const Unit& u) { return pack_fields(u.pm, u.pn, u.kt0, u.nkt, u.split); }
#define UP_PM(p) ((int)((p) & 0xff))
#define UP_PN(p) ((int)(((p) >> 8) & 0xff))
#define UP_KT0(p) ((int)(((p) >> 16) & 0xff))
#define UP_NKT(p) ((int)(((p) >> 24) & 0xff))
#define UP_SPLIT(p) ((int)(((p) >> 32) & 0xff) - 1)

struct StaticOrder {
    int nM, nN, nwg, G, c, nkt;
    __host__ __device__ void init(int M, int N, int G_, int c_, int K) { nM = M / BM; nN = N / BM; nwg = nM * nN; G = G_; c = c_; nkt = K / BK; }
    __host__ __device__ __forceinline__ bool next(int i, Unit& u) const {
        const long L = (long)i * G + c; if (L >= nwg) return false;
        int wgid = (int)L; { const int q = nwg / NXCD, r = nwg % NXCD, xcd = wgid % NXCD, off = wgid / NXCD; wgid = (xcd < r ? xcd * (q + 1) : r * (q + 1) + (xcd - r) * q) + off; }
        const int nig = WGM * nN, gid = wgid / nig, fm = gid * WGM, gsz = (nM - fm) < WGM ? (nM - fm) : WGM;
        u.pm = fm + ((wgid % nig) % gsz); u.pn = (wgid % nig) / gsz; u.kt0 = 0; u.nkt = nkt; u.split = -1; return true;
    }
    __host__ __device__ __forceinline__ unsigned long long nextp(int i) const { Unit u; if (!next(i, u)) return 0ull; return pack_unit(u); }
    __device__ __forceinline__ void a_ready(const Unit&) const {}
    __device__ __forceinline__ void done(const Unit&) const {}
};
struct SplitOrder {
    StaticOrder P; int G, c, S, base, total;
    __host__ __device__ void init(int K, int G_, int c_, int S_, int base_) { P.init(MP, DM, G_, c_, K); G = G_; c = c_; S = S_; base = base_; total = K / BK; }
    __host__ __device__ __forceinline__ bool next(int i, Unit& u) const {
        const long L = (long)i * G + c;
        if (L < P.nwg) {
            int wgid = (int)L; { const int q = P.nwg / NXCD, r = P.nwg % NXCD, xcd = wgid % NXCD, off = wgid / NXCD; wgid = (xcd < r ? xcd * (q + 1) : r * (q + 1) + (xcd - r) * q) + off; }
            const int nig = WGM * P.nN, gid = wgid / nig, fm = gid * WGM, gsz = (P.nM - fm) < WGM ? (P.nM - fm) : WGM;
            u.pm = fm + ((wgid % nig) % gsz); u.pn = (wgid % nig) / gsz; u.kt0 = 0; u.nkt = total; u.split = -1; return true;
        }
        const int l2 = (int)(L - P.nwg); if (l2 >= 16 * S) return false;
        u.pn = l2 & 7; u.pm = MP / BM + ((l2 >> 3) & 1); u.split = l2 >> 4; u.kt0 = u.split * base; u.nkt = (u.split == S - 1) ? total - base * (S - 1) : base; return true;
    }
    __host__ __device__ __forceinline__ unsigned long long nextp(int i) const {
        const long L = (long)i * G + c;
        if (L < P.nwg) {
            int wgid = (int)L; { const int q = P.nwg / NXCD, r = P.nwg % NXCD, xcd = wgid % NXCD, off = wgid / NXCD; wgid = (xcd < r ? xcd * (q + 1) : r * (q + 1) + (xcd - r) * q) + off; }
            const int nig = WGM * P.nN, gid = wgid / nig, fm = gid * WGM, gsz = (P.nM - fm) < WGM ? (P.nM - fm) : WGM;
            return pack_fields(fm + ((wgid % nig) % gsz), (wgid % nig) / gsz, 0, total, -1);
        }
        const int l2 = (int)(L - P.nwg); if (l2 >= 16 * S) return 0ull;
        const int sp = l2 >> 4;
        return pack_fields(MP / BM + ((l2 >> 3) & 1), l2 & 7, sp * base, (sp == S - 1) ? total - base * (S - 1) : base, sp);
    }
    __device__ __forceinline__ void a_ready(const Unit&) const {}
    __device__ __forceinline__ void done(const Unit&) const {}
};

__device__ __forceinline__ unsigned cvt_pk_bf16(float lo, float hi) { unsigned r; asm volatile("v_cvt_pk_bf16_f32 %0, %1, %2" : "=v"(r) : "v"(lo), "v"(hi)); return r; }

struct EpiBf16 {
    static constexpr bool PERM = true, AFTER_DRAIN = false;
    bf16_t* O; int ldc; const float* ssq; int glu0, glu_col;
    __device__ __forceinline__ void operator()(const f32x4 (&acc)[2][2][4][2], const Unit& u, int wr, int wc, int fr, int fq) const {
        const int row0 = u.pm * BM + wr * 64 + fr;
        if (glu0 >= 0 && u.pn >= glu0 && u.pn < glu0 + 16) {
            const int col0 = glu_col + 128 * (u.pn - glu0) + wc * 32 + 8 * fq;
#pragma unroll
            for (int ai = 0; ai < 2; ++ai)
#pragma unroll
                for (int m = 0; m < 4; ++m) { float o[8];
#pragma unroll
                    for (int n = 0; n < 2; ++n)
#pragma unroll
                        for (int j = 0; j < 4; ++j) { const float a = acc[ai][0][m][n][j], g = acc[ai][1][m][n][j]; o[4 * n + j] = a * __builtin_amdgcn_rcpf(1.f + __expf(-g)); }
                    u32x4 w; w.x = cvt_pk_bf16(o[0], o[1]); w.y = cvt_pk_bf16(o[2], o[3]); w.z = cvt_pk_bf16(o[4], o[5]); w.w = cvt_pk_bf16(o[6], o[7]);
                    *(u32x4*)(O + (size_t)(row0 + ai * HALF + m * 16) * ldc + col0) = w; }
            return;
        }
        const int col0 = u.pn * BM + wc * 32 + 8 * fq;
        float rs[2][4];
#pragma unroll
        for (int ai = 0; ai < 2; ++ai)
#pragma unroll
            for (int m = 0; m < 4; ++m) rs[ai][m] = ssq ? rsqrtf(ssq[row0 + ai * HALF + m * 16] * (1.f / DM) + EPS) : 1.f;
#pragma unroll
        for (int ai = 0; ai < 2; ++ai)
#pragma unroll
            for (int m = 0; m < 4; ++m) { bf16_t* rowp = O + (size_t)(row0 + ai * HALF + m * 16) * ldc + col0;
#pragma unroll
                for (int bj = 0; bj < 2; ++bj) { const f32x4 v0 = acc[ai][bj][m][0] * rs[ai][m], v1 = acc[ai][bj][m][1] * rs[ai][m];
                    u32x4 w; w.x = cvt_pk_bf16(v0[0], v0[1]); w.y = cvt_pk_bf16(v0[2], v0[3]); w.z = cvt_pk_bf16(v1[0], v1[1]); w.w = cvt_pk_bf16(v1[2], v1[3]);
                    *(u32x4*)(rowp + bj * HALF) = w; } }
    }
};
struct EpiX1 {
    static constexpr bool PERM = true, AFTER_DRAIN = false;
    const float* baseP; bf16_t* X1B; float* ssq; float* part; int probe_repeat;
    __device__ __forceinline__ void operator()(const f32x4 (&acc)[2][2][4][2], const Unit& u, int wr, int wc, int fr, int fq) const {
        const int row0 = u.pm * BM + wr * 64 + fr; const int col0 = u.pn * BM + wc * 32 + 8 * fq;
        if (u.split >= 0) {
            float* pp = part + ((size_t)u.split * MS + (row0 - MP)) * DM;
#pragma unroll
            for (int ai = 0; ai < 2; ++ai)
#pragma unroll
                for (int m = 0; m < 4; ++m) { const size_t ro = (size_t)(ai * HALF + m * 16) * DM + col0;
#pragma unroll
                    for (int bj = 0; bj < 2; ++bj) { *(f32x4*)(pp + ro + bj * HALF) = acc[ai][bj][m][0]; *(f32x4*)(pp + ro + bj * HALF + 4) = acc[ai][bj][m][1]; } }
            return;
        }
        const float* bp = baseP + (size_t)row0 * DM;
        bf16_t* op = X1B + (size_t)row0 * DM;
#pragma unroll
        for (int ai = 0; ai < 2; ++ai)
#pragma unroll
            for (int mp = 0; mp < 2; ++mp) {
                f32x4 bv[2][2][2];
#pragma unroll
                for (int mm = 0; mm < 2; ++mm)
#pragma unroll
                    for (int bj = 0; bj < 2; ++bj) { const size_t ro = (size_t)(ai * HALF + (2 * mp + mm) * 16) * DM + col0 + bj * HALF;
                        bv[mm][bj][0] = *(const f32x4*)(bp + ro); bv[mm][bj][1] = *(const f32x4*)(bp + ro + 4); }
#pragma unroll
                for (int mm = 0; mm < 2; ++mm) { float sq = 0.f;
#pragma unroll
                    for (int bj = 0; bj < 2; ++bj) { const size_t ro = (size_t)(ai * HALF + (2 * mp + mm) * 16) * DM + col0 + bj * HALF;
                        const f32x4 v0 = bv[mm][bj][0] + acc[ai][bj][2 * mp + mm][0], v1 = bv[mm][bj][1] + acc[ai][bj][2 * mp + mm][1];
                        sq += (v0[0] * v0[0] + v0[1] * v0[1]) + (v0[2] * v0[2] + v0[3] * v0[3]) + (v1[0] * v1[0] + v1[1] * v1[1]) + (v1[2] * v1[2] + v1[3] * v1[3]);
                        u32x4 w; w.x = cvt_pk_bf16(v0[0], v0[1]); w.y = cvt_pk_bf16(v0[2], v0[3]); w.z = cvt_pk_bf16(v1[0], v1[1]); w.w = cvt_pk_bf16(v1[2], v1[3]);
                        *(u32x4*)(op + ro) = w; }
                    sq += __shfl_xor(sq, 16); sq += __shfl_xor(sq, 32);
                    if (fq == 0 && !probe_repeat) atomicAdd(ssq + row0 + ai * HALF + (2 * mp + mm) * 16, sq); }
                asm volatile("" ::: "memory"); }
    }
};
struct EpiResF32 {
    static constexpr bool PERM = true, AFTER_DRAIN = false;
    bf16_t* X1B; float* out; float* part; int probe_repeat;
    __device__ __forceinline__ void operator()(const f32x4 (&acc)[2][2][4][2], const Unit& u, int wr, int wc, int fr, int fq) const {
        const int row0 = u.pm * BM + wr * 64 + fr; const int col0 = u.pn * BM + wc * 32 + 8 * fq;
        if (u.split >= 0) {
            float* pp = part + ((size_t)u.split * MS + (row0 - MP)) * DM;
#pragma unroll
            for (int ai = 0; ai < 2; ++ai)
#pragma unroll
                for (int m = 0; m < 4; ++m) { const size_t ro = (size_t)(ai * HALF + m * 16) * DM + col0;
#pragma unroll
                    for (int bj = 0; bj < 2; ++bj) { *(f32x4*)(pp + ro + bj * HALF) = acc[ai][bj][m][0]; *(f32x4*)(pp + ro + bj * HALF + 4) = acc[ai][bj][m][1]; } }
            return;
        }
        bf16_t* bp = X1B + (size_t)row0 * DM;
        bf16_t* wp = probe_repeat ? (bf16_t*)out + (size_t)row0 * DM : bp;
#pragma unroll
        for (int ai = 0; ai < 2; ++ai) {
            u32x4 bv[4][2];
#pragma unroll
            for (int m = 0; m < 4; ++m)
#pragma unroll
                for (int bj = 0; bj < 2; ++bj) bv[m][bj] = *(const u32x4*)(bp + (size_t)(ai * HALF + m * 16) * DM + col0 + bj * HALF);
#pragma unroll
            for (int m = 0; m < 4; ++m)
#pragma unroll
                for (int bj = 0; bj < 2; ++bj) { const size_t ro = (size_t)(ai * HALF + m * 16) * DM + col0 + bj * HALF; float b[8]; unpack8(bv[m][bj], b);
                    const f32x4 v0 = (f32x4){b[0], b[1], b[2], b[3]} + acc[ai][bj][m][0], v1 = (f32x4){b[4], b[5], b[6], b[7]} + acc[ai][bj][m][1];
                    u32x4 w; w.x = cvt_pk_bf16(v0[0], v0[1]); w.y = cvt_pk_bf16(v0[2], v0[3]); w.z = cvt_pk_bf16(v1[0], v1[1]); w.w = cvt_pk_bf16(v1[2], v1[3]);
                    *(u32x4*)(wp + ro) = w; }
            asm volatile("" ::: "memory"); }
    }
};

template <class Epi, class Sched, bool ALIGN_EPI = false, bool SP2 = false>
__device__ __forceinline__ void gemm_phase(PG8_LAS unsigned char* lds, const Gemm g, const Sched& S, const Epi& E) {
    const int tid = ltid(), wid = __builtin_amdgcn_readfirstlane(tid >> 6), lane = tid & 63, wr = wid >> 2, wc = wid & 3, fr = lane & 15, fq = lane >> 4;
    const int K = g.K;
    unsigned voffA[2], voffB[2];
#pragma unroll
    for (int i = 0; i < 2; ++i) { int R, C; stage_rc(tid * 16 + i * 8192, R, C); const int Rb = Epi::PERM ? ((R & ~31) + perm32(R & 31)) : R;
        voffA[i] = (unsigned)(R * K + C) * 2u; voffB[i] = (unsigned)(Rb * K + C) * 2u; }
    const size_t kstep = (size_t)(BK * 2);
    const size_t hstep = (size_t)HALF * K * 2;
    const size_t tstep = 2 * hstep;
    const unsigned ldsw = (unsigned)wid * 1024u;
    const int aoff = lds_byte(wr * 64 + fr, fq * 8), boff = lds_byte(wc * 32 + fr, fq * 8);
#define PG8_SA(b, h) (((b) * 2 + (h)) * HTB)
#define PG8_SB(b, h) ((4 + (b) * 2 + (h)) * HTB)
#define PG8_STAGE(bufoff, gbase, voff) do { _Pragma("unroll") for (int _i = 0; _i < 2; ++_i) \
        __builtin_amdgcn_global_load_lds((const unsigned*)((const char*)(gbase) + (voff)[_i]), (PG8_LAS unsigned*)(lds + (bufoff) + ldsw + _i * 8192), 16, 0, 0); } while (0)
#define PG8_LDA(dst, b, h) do { _Pragma("unroll") for (int m = 0; m < 4; ++m) _Pragma("unroll") for (int k = 0; k < 2; ++k) dst[m][k] = *(const PG8_LAS bf16x8*)(lds + PG8_SA(b, h) + aoff + m * 2048 + k * 1024); } while (0)
#define PG8_LDB(dst, b, h) do { _Pragma("unroll") for (int n = 0; n < 2; ++n) _Pragma("unroll") for (int k = 0; k < 2; ++k) dst[n][k] = *(const PG8_LAS bf16x8*)(lds + PG8_SB(b, h) + boff + n * 2048 + k * 1024); } while (0)
#define PG8_MMA(ai, bj, At, Bt) do { __builtin_amdgcn_s_setprio(1); _Pragma("unroll") for (int m = 0; m < 4; ++m) _Pragma("unroll") for (int n = 0; n < 2; ++n) _Pragma("unroll") for (int k = 0; k < 2; ++k) \
        acc[ai][bj][m][n] = __builtin_amdgcn_mfma_f32_16x16x32_bf16(Bt[n][k], At[m][k], acc[ai][bj][m][n], 0, 0, 0); __builtin_amdgcn_s_setprio(0); } while (0)
#define PG8_WAIT_V(n) asm volatile("s_waitcnt vmcnt(" #n ")" ::: "memory")
#define PG8_WAIT_L(n) asm volatile("s_waitcnt lgkmcnt(" #n ")" ::: "memory")
#define PG8_BAR __builtin_amdgcn_s_barrier()
#define PG8_SCHED __builtin_amdgcn_sched_barrier(0)
    unsigned long long cur = S.nextp(0), nxt; int ui = 0;
    if (!cur) return;
    f32x4 acc[2][2][4][2];
#pragma unroll
    for (int a = 0; a < 2; ++a)
#pragma unroll
        for (int b = 0; b < 2; ++b)
#pragma unroll
            for (int m = 0; m < 4; ++m)
#pragma unroll
                for (int n = 0; n < 2; ++n) acc[a][b][m][n] = (f32x4){0.f, 0.f, 0.f, 0.f};
    bf16x8 At[4][2], B0[2][2], B1[2][2];
    const char* cA = (const char*)g.A + (size_t)UP_PM(cur) * tstep + (size_t)UP_KT0(cur) * kstep; const char* cB = (const char*)g.Bt + (size_t)UP_PN(cur) * tstep + (size_t)UP_KT0(cur) * kstep;
    if constexpr (SP2) {
        PG8_STAGE(PG8_SB(0, 0), cB, voffB); PG8_STAGE(PG8_SB(0, 1), cB + hstep, voffB); PG8_STAGE(PG8_SA(0, 0), cA, voffA); PG8_STAGE(PG8_SA(0, 1), cA + hstep, voffA);
        if (wr == 1) PG8_BAR;
        PG8_WAIT_V(2); PG8_BAR;
        PG8_STAGE(PG8_SB(1, 0), cB + kstep, voffB); PG8_STAGE(PG8_SA(1, 0), cA + kstep, voffA); PG8_STAGE(PG8_SB(1, 1), cB + hstep + kstep, voffB);
        PG8_WAIT_V(6); PG8_BAR;
    } else {
        PG8_STAGE(PG8_SB(0, 0), cB, voffB); PG8_STAGE(PG8_SA(0, 0), cA, voffA); PG8_STAGE(PG8_SB(0, 1), cB + hstep, voffB); PG8_STAGE(PG8_SA(0, 1), cA + hstep, voffA);
        if (wr == 1) PG8_BAR;
        PG8_WAIT_V(4); PG8_BAR;
        PG8_STAGE(PG8_SB(1, 0), cB + kstep, voffB); PG8_STAGE(PG8_SA(1, 0), cA + kstep, voffA); PG8_STAGE(PG8_SB(1, 1), cB + hstep + kstep, voffB);
        PG8_WAIT_V(6); PG8_BAR;
    }
    for (;;) {
        nxt = S.nextp(ui + 1); const bool has_next = (nxt != 0ull);
        const char* nA = has_next ? (const char*)g.A + (size_t)UP_PM(nxt) * tstep + (size_t)UP_KT0(nxt) * kstep : cA; const char* nB = has_next ? (const char*)g.Bt + (size_t)UP_PN(nxt) * tstep + (size_t)UP_KT0(nxt) * kstep : cB;
        const int nt = UP_NKT(cur);
        for (int t = 0; t < nt; t += 2) {
            const bool last = (t == nt - 2);
            const char* a1 = cA + (size_t)(t + 1) * kstep;
            const char* a2 = last ? nA : cA + (size_t)(t + 2) * kstep; const char* b2 = last ? nB : cB + (size_t)(t + 2) * kstep;
            const char* a3 = a2 + kstep; const char* b3 = b2 + kstep;
            if constexpr (SP2) {
            PG8_LDB(B0, 0, 0); PG8_LDB(B1, 0, 1); PG8_SCHED; PG8_LDA(At, 0, 0); PG8_STAGE(PG8_SA(1, 1), a1 + hstep, voffA);
            PG8_WAIT_V(8); PG8_WAIT_L(0); PG8_BAR; PG8_MMA(0, 0, At, B0); PG8_MMA(0, 1, At, B1); PG8_BAR; PG8_SCHED;
            PG8_LDA(At, 0, 1); PG8_STAGE(PG8_SB(0, 0), b2, voffB); PG8_STAGE(PG8_SB(0, 1), b2 + hstep, voffB); PG8_STAGE(PG8_SA(0, 0), a2, voffA);
            PG8_WAIT_V(8); PG8_WAIT_L(0); PG8_BAR; PG8_MMA(1, 0, At, B0); PG8_MMA(1, 1, At, B1); PG8_BAR; PG8_SCHED;
            PG8_LDB(B0, 1, 0); PG8_LDB(B1, 1, 1); PG8_SCHED; PG8_LDA(At, 1, 0); PG8_STAGE(PG8_SA(0, 1), a2 + hstep, voffA);
            PG8_WAIT_V(8); PG8_WAIT_L(0); PG8_BAR; PG8_MMA(0, 0, At, B0); PG8_MMA(0, 1, At, B1); PG8_BAR; PG8_SCHED;
            PG8_LDA(At, 1, 1); PG8_STAGE(PG8_SB(1, 0), b3, voffB); PG8_STAGE(PG8_SB(1, 1), b3 + hstep, voffB); PG8_STAGE(PG8_SA(1, 0), a3, voffA);
            PG8_WAIT_V(8); PG8_WAIT_L(0); PG8_BAR; PG8_MMA(1, 0, At, B0); PG8_MMA(1, 1, At, B1); PG8_BAR; PG8_SCHED;
            } else {
            PG8_LDB(B0, 0, 0); PG8_SCHED; PG8_LDA(At, 0, 0); PG8_STAGE(PG8_SA(1, 1), a1 + hstep, voffA);
            PG8_WAIT_L(8); PG8_BAR; PG8_WAIT_L(0); PG8_MMA(0, 0, At, B0); PG8_BAR; PG8_SCHED;
            PG8_LDB(B1, 0, 1); PG8_STAGE(PG8_SB(0, 0), b2, voffB);
            PG8_BAR; PG8_WAIT_L(0); PG8_MMA(0, 1, At, B1); PG8_BAR;
            PG8_LDA(At, 0, 1); PG8_STAGE(PG8_SA(0, 0), a2, voffA);
            PG8_BAR; PG8_WAIT_L(0); PG8_MMA(1, 0, At, B0); PG8_BAR; PG8_SCHED;
            PG8_STAGE(PG8_SB(0, 1), b2 + hstep, voffB);
            PG8_WAIT_V(6); PG8_BAR; PG8_MMA(1, 1, At, B1); PG8_BAR;
            PG8_LDB(B0, 1, 0); PG8_SCHED; PG8_LDA(At, 1, 0); PG8_STAGE(PG8_SA(0, 1), a2 + hstep, voffA);
            PG8_WAIT_L(8); PG8_BAR; PG8_WAIT_L(0); PG8_MMA(0, 0, At, B0); PG8_BAR; PG8_SCHED;
            PG8_LDB(B1, 1, 1); PG8_STAGE(PG8_SB(1, 0), b3, voffB);
            PG8_BAR; PG8_WAIT_L(0); PG8_MMA(0, 1, At, B1); PG8_BAR;
            PG8_LDA(At, 1, 1); PG8_STAGE(PG8_SA(1, 0), a3, voffA);
            PG8_BAR; PG8_WAIT_L(0); PG8_MMA(1, 0, At, B0); PG8_BAR; PG8_SCHED;
            PG8_STAGE(PG8_SB(1, 1), b3 + hstep, voffB);
            PG8_WAIT_V(6); PG8_BAR; PG8_MMA(1, 1, At, B1); PG8_BAR;
            }
        }
        if constexpr (ALIGN_EPI) { if (wr == 0) PG8_BAR; }
        { Unit cu; cu.pm = UP_PM(cur); cu.pn = UP_PN(cur); cu.kt0 = UP_KT0(cur); cu.nkt = UP_NKT(cur); cu.split = UP_SPLIT(cur); E(acc, cu, wr, wc, fr, fq); }
        if (!has_next) break;
#pragma unroll
        for (int a = 0; a < 2; ++a)
#pragma unroll
            for (int b = 0; b < 2; ++b)
#pragma unroll
                for (int m = 0; m < 4; ++m)
#pragma unroll
                    for (int n = 0; n < 2; ++n) acc[a][b][m][n] = (f32x4){0.f, 0.f, 0.f, 0.f};
        cur = nxt; cA = nA; cB = nB; ++ui;
        if constexpr (ALIGN_EPI) { if (wr == 1) PG8_BAR; }
    }
    PG8_WAIT_V(0);
    if constexpr (!ALIGN_EPI) { if (wr == 0) PG8_BAR; }
    PG8_BAR;
#undef PG8_SA
#undef PG8_SB
#undef PG8_STAGE
#undef PG8_LDA
#undef PG8_LDB
#undef PG8_MMA
#undef PG8_WAIT_V
#undef PG8_WAIT_L
#undef PG8_BAR
#undef PG8_SCHED
}
}

__device__ __forceinline__ void p0_transpose_item(const float* W, int K, int N, bf16_t* WT, int k0, int n0, int drow0, LAS float* scr, int lane, const float* kscale = nullptr) {
    const float ks = kscale ? kscale[k0 + lane] : 1.f;
#pragma unroll 8
    for (int i = 0; i < 32; ++i) { const int kk = 2 * i + (lane >> 5); scr[kk * 33 + (lane & 31)] = W[(size_t)(k0 + kk) * N + n0 + (lane & 31)] * __shfl(ks, kk); }
    asm volatile("s_waitcnt lgkmcnt(0)" ::: "memory");
    const int c = lane & 7;
#pragma unroll
    for (int j = 0; j < 4; ++j) { const int n = (lane >> 3) + 8 * j; const LAS float* s = scr + (8 * c) * 33 + n;
        u32x4 o; o.x = pk2(s[0 * 33], s[1 * 33]); o.y = pk2(s[2 * 33], s[3 * 33]); o.z = pk2(s[4 * 33], s[5 * 33]); o.w = pk2(s[6 * 33], s[7 * 33]);
        *(u32x4*)(WT + (size_t)(drow0 + n) * K + k0 + 8 * c) = o; }
    asm volatile("s_waitcnt lgkmcnt(0)" ::: "memory");
}
__device__ __forceinline__ int win_dest_row(int n0) {
    if (n0 < 5120) return n0;
    if (n0 < 5152) return CDT + (n0 - 5120);
    if (n0 < 7200) { const int c = n0 - 5152; return CCF + 256 * (c >> 7) + (c & 127); }
    { const int c = n0 - 7200; return CCF + 256 * (c >> 7) + 128 + (c & 127); }
}
__device__ __forceinline__ void rms_row_to_bf16(const float* xrow, const float* w, bf16_t* orow, int lane) {
    f32x4 v[8], ww[8]; float s = 0.f;
#pragma unroll
    for (int j = 0; j < 8; ++j) { v[j] = *(const f32x4*)(xrow + (j * 64 + lane) * 4); ww[j] = *(const f32x4*)(w + (j * 64 + lane) * 4); }
#pragma unroll
    for (int j = 0; j < 8; ++j) s += (v[j].x * v[j].x + v[j].y * v[j].y) + (v[j].z * v[j].z + v[j].w * v[j].w);
    const float r = rsqrtf(wave_sum(s) * (1.f / DM) + EPS);
#pragma unroll
    for (int j = 0; j < 8; ++j) {
        u32x2 o; o.x = pk2(v[j].x * r * ww[j].x, v[j].y * r * ww[j].y); o.y = pk2(v[j].z * r * ww[j].z, v[j].w * r * ww[j].w);
        *(u32x2*)(orow + (j * 64 + lane) * 4) = o; }
}

template <int NT, bool SAMPLE>
__device__ __forceinline__ void ssdconv_item(const bf16_t* PROJ, int row0, bool has_hist, const float* st, int cgi, const float* w, const float* bias, bf16_t* XBC, float* state_out) {
    const int c0 = cgi * 8;
    float wv[4][8], bv[8], h0[8], h1[8], h2[8];
#pragma unroll
    for (int i = 0; i < 4; ++i) { const f32x4 a = *(const f32x4*)(w + i * XBCW + c0), b = *(const f32x4*)(w + i * XBCW + c0 + 4);
        wv[i][0] = a.x; wv[i][1] = a.y; wv[i][2] = a.z; wv[i][3] = a.w; wv[i][4] = b.x; wv[i][5] = b.y; wv[i][6] = b.z; wv[i][7] = b.w; }
    { const f32x4 a = *(const f32x4*)(bias + c0), b = *(const f32x4*)(bias + c0 + 4);
      bv[0] = a.x; bv[1] = a.y; bv[2] = a.z; bv[3] = a.w; bv[4] = b.x; bv[5] = b.y; bv[6] = b.z; bv[7] = b.w; }
    if (SAMPLE) {
#pragma unroll
        for (int e = 0; e < 8; ++e) { h0[e] = st[0 * XBCW + c0 + e]; h1[e] = st[1 * XBCW + c0 + e]; h2[e] = st[2 * XBCW + c0 + e]; }
    } else if (has_hist) {
        unpack8(*(const u32x4*)(PROJ + (size_t)(row0 - 3) * NPROJ + CXBC + c0), h0);
        unpack8(*(const u32x4*)(PROJ + (size_t)(row0 - 2) * NPROJ + CXBC + c0), h1);
        unpack8(*(const u32x4*)(PROJ + (size_t)(row0 - 1) * NPROJ + CXBC + c0), h2);
    } else {
#pragma unroll
        for (int e = 0; e < 8; ++e) { h0[e] = 0.f; h1[e] = 0.f; h2[e] = 0.f; }
    }
    u32x4 rows[NT];
#pragma unroll
    for (int t = 0; t < NT; ++t) rows[t] = *(const u32x4*)(PROJ + (size_t)(row0 + t) * NPROJ + CXBC + c0);
#pragma unroll
    for (int t = 0; t < NT; ++t) {
        float cur[8], o[8];
        unpack8(rows[t], cur);
#pragma unroll
        for (int e = 0; e < 8; ++e) { float v = h0[e] * wv[0][e] + h1[e] * wv[1][e] + h2[e] * wv[2][e] + cur[e] * wv[3][e] + bv[e]; o[e] = siluf_(v); h0[e] = h1[e]; h1[e] = h2[e]; h2[e] = cur[e]; }
        *(u32x4*)(XBC + (size_t)(row0 + t) * XBCW + c0) = pack8(o);
    }
    if (state_out) {
        *(f32x4*)(state_out + 0 * XBCW + c0) = (f32x4){h0[0], h0[1], h0[2], h0[3]}; *(f32x4*)(state_out + 0 * XBCW + c0 + 4) = (f32x4){h0[4], h0[5], h0[6], h0[7]};
        *(f32x4*)(state_out + 1 * XBCW + c0) = (f32x4){h1[0], h1[1], h1[2], h1[3]}; *(f32x4*)(state_out + 1 * XBCW + c0 + 4) = (f32x4){h1[4], h1[5], h1[6], h1[7]};
        *(f32x4*)(state_out + 2 * XBCW + c0) = (f32x4){h2[0], h2[1], h2[2], h2[3]}; *(f32x4*)(state_out + 2 * XBCW + c0 + 4) = (f32x4){h2[4], h2[5], h2[6], h2[7]};
    }
}

__device__ __forceinline__ void ssdconv_prompt_item(const bf16_t* PROJ, int row0, bool has_hist, int cgi, const float* w, const float* bias, bf16_t* XBC, float* state_out,
                                                    const float* DT, const float* CS, bf16_t* XT1, bf16_t* XT2, bf16_t* BT) {
    const int c0 = cgi * 8;
    float wv[4][8], bv[8], h0[8], h1[8], h2[8];
#pragma unroll
    for (int i = 0; i < 4; ++i) { const f32x4 a = *(const f32x4*)(w + i * XBCW + c0), b = *(const f32x4*)(w + i * XBCW + c0 + 4);
        wv[i][0] = a.x; wv[i][1] = a.y; wv[i][2] = a.z; wv[i][3] = a.w; wv[i][4] = b.x; wv[i][5] = b.y; wv[i][6] = b.z; wv[i][7] = b.w; }
    { const f32x4 a = *(const f32x4*)(bias + c0), b = *(const f32x4*)(bias + c0 + 4);
      bv[0] = a.x; bv[1] = a.y; bv[2] = a.z; bv[3] = a.w; bv[4] = b.x; bv[5] = b.y; bv[6] = b.z; bv[7] = b.w; }
    u32x4 rows[8], hr[3];
#pragma unroll
    for (int t = 0; t < 8; ++t) rows[t] = *(const u32x4*)(PROJ + (size_t)(row0 + t) * NPROJ + CXBC + c0);
    if (has_hist) {
#pragma unroll
        for (int i = 0; i < 3; ++i) hr[i] = *(const u32x4*)(PROJ + (size_t)(row0 - 3 + i) * NPROJ + CXBC + c0);
    } else {
#pragma unroll
        for (int i = 0; i < 3; ++i) hr[i] = (u32x4){0u, 0u, 0u, 0u};
    }
    const bool isx = cgi < 256, isb = (cgi >= 256 && cgi < 320);
    float f1[8], f2[8];
    if (isx) { const int h = cgi >> 3; const float csl = CS[(size_t)((row0 & ~127) + 127) * NH + h];
#pragma unroll
        for (int t = 0; t < 8; ++t) { const float d = DT[(size_t)(row0 + t) * NH + h]; const float c = CS[(size_t)(row0 + t) * NH + h]; f1[t] = d; f2[t] = d * __expf(csl - c); } }
    unpack8(hr[0], h0); unpack8(hr[1], h1); unpack8(hr[2], h2);
    float o[8][8];
#pragma unroll
    for (int t = 0; t < 8; ++t) {
        float cur[8];
        unpack8(rows[t], cur);
#pragma unroll
        for (int e = 0; e < 8; ++e) { float v = h0[e] * wv[0][e] + h1[e] * wv[1][e] + h2[e] * wv[2][e] + cur[e] * wv[3][e] + bv[e]; o[t][e] = siluf_(v); h0[e] = h1[e]; h1[e] = h2[e]; h2[e] = cur[e]; }
        *(u32x4*)(XBC + (size_t)(row0 + t) * XBCW + c0) = pack8(o[t]);
    }
    if (state_out) {
        *(f32x4*)(state_out + 0 * XBCW + c0) = (f32x4){h0[0], h0[1], h0[2], h0[3]}; *(f32x4*)(state_out + 0 * XBCW + c0 + 4) = (f32x4){h0[4], h0[5], h0[6], h0[7]};
        *(f32x4*)(state_out + 1 * XBCW + c0) = (f32x4){h1[0], h1[1], h1[2], h1[3]}; *(f32x4*)(state_out + 1 * XBCW + c0 + 4) = (f32x4){h1[4], h1[5], h1[6], h1[7]};
        *(f32x4*)(state_out + 2 * XBCW + c0) = (f32x4){h2[0], h2[1], h2[2], h2[3]}; *(f32x4*)(state_out + 2 * XBCW + c0 + 4) = (f32x4){h2[4], h2[5], h2[6], h2[7]};
    }
    const int chunk = row0 >> 7, jb = row0 & 127;
    if (isx) {
#pragma unroll
        for (int e = 0; e < 8; ++e) { u32x4 a, b2;
            a.x = pk2(o[0][e] * f1[0], o[1][e] * f1[1]); a.y = pk2(o[2][e] * f1[2], o[3][e] * f1[3]); a.z = pk2(o[4][e] * f1[4], o[5][e] * f1[5]); a.w = pk2(o[6][e] * f1[6], o[7][e] * f1[7]);
            b2.x = pk2(o[0][e] * f2[0], o[1][e] * f2[1]); b2.y = pk2(o[2][e] * f2[2], o[3][e] * f2[3]); b2.z = pk2(o[4][e] * f2[4], o[5][e] * f2[5]); b2.w = pk2(o[6][e] * f2[6], o[7][e] * f2[7]);
            const size_t off = ((size_t)chunk * DM + c0 + e) * 128 + jb;
            *(u32x4*)(XT1 + off) = a; *(u32x4*)(XT2 + off) = b2; }
    } else if (isb) {
#pragma unroll
        for (int e = 0; e < 8; ++e) { u32x4 a;
            a.x = pk2(o[0][e], o[1][e]); a.y = pk2(o[2][e], o[3][e]); a.z = pk2(o[4][e], o[5][e]); a.w = pk2(o[6][e], o[7][e]);
            *(u32x4*)(BT + ((size_t)chunk * 512 + (c0 - 2048) + e) * 128 + jb) = a; }
    }
}

__device__ __forceinline__ void cf_sample_item(const bf16_t* PROJ, int s, int c, const float* st, const float* cw, const float* cb, bf16_t* CONVOUT, float* state_out) {
    f32x2 xp[34], w[31];
    unsigned uv[4];
#pragma unroll
    for (int j = 0; j < 30; ++j) xp[j] = *(const f32x2*)(st + j * DM + c);
#pragma unroll
    for (int t = 0; t < 4; ++t) uv[t] = *(const unsigned*)(PROJ + (size_t)(MP + 4 * s + t) * NPROJ + CUCF + c);
#pragma unroll
    for (int i = 0; i < 31; ++i) w[i] = *(const f32x2*)(cw + i * DM + c);
    const f32x2 bias = *(const f32x2*)(cb + c);
#pragma unroll
    for (int t = 0; t < 4; ++t) { xp[30 + t].x = bf2f(uv[t] & 0xffffu); xp[30 + t].y = bf2f(uv[t] >> 16); }
#pragma unroll
    for (int t = 0; t < 4; ++t) { f32x2 acc = bias;
#pragma unroll
        for (int i = 0; i < 31; ++i) acc += xp[t + i] * w[i];
        *(unsigned*)(CONVOUT + (size_t)(MP + 4 * s + t) * DM + c) = pk2(acc.x, acc.y); }
#pragma unroll
    for (int i = 0; i < 30; ++i) *(f32x2*)(state_out + (size_t)i * DM + c) = xp[4 + i];
}

template <int J> struct CfLds {
    static __device__ __forceinline__ void run(float (&acc)[32], const float (&w)[31], const LAS float* us) {
        const float v = us[J * 512];
        constexpr int TLO = (J - 30 > 0) ? J - 30 : 0, THI = (J < 31) ? J : 31;
#pragma unroll
        for (int t = TLO; t <= THI; ++t) acc[t] += v * w[J - t];
        if constexpr (J + 1 < 62) CfLds<J + 1>::run(acc, w, us);
    }
};
__device__ __forceinline__ void cf_prompt_items(LAS unsigned char* lds, const bf16_t* PROJ, int it0, int itstride, int nitems, const float* cw, const float* cb, bf16_t* CONVOUT, float* pcfc) {
    const int tid = ltid(), w = __builtin_amdgcn_readfirstlane(tid >> 6), lane = tid & 63;
    LAS float* Us = (LAS float*)lds;
    if (it0 >= nitems) return;
    u32x4 av[8];
#define CF_LOAD(itx) do { const int r0_ = ((itx) >> 2) * 32, t0_ = r0_ % SEQ, cc_ = ((itx) & 3) * 512; \
        _Pragma("unroll") for (int i = 0; i < 8; ++i) { const int j = w + 8 * i, tt = j - 30; \
            if (j < 62 && t0_ + tt >= 0) av[i] = *(const u32x4*)(PROJ + (size_t)(r0_ + tt) * NPROJ + CUCF + cc_ + lane * 8); \
            else av[i] = (u32x4){0u, 0u, 0u, 0u}; } } while (0)
    CF_LOAD(it0);
    for (int it = it0; it < nitems; it += itstride) {
        const int row0 = (it >> 2) * 32, t0 = row0 % SEQ, b = row0 / SEQ, c0 = (it & 3) * 512;
        float* state_out = (t0 == SEQ - 32) ? pcfc + (size_t)b * 30 * DM : nullptr;
        float wv[31];
#pragma unroll
        for (int i = 0; i < 31; ++i) wv[i] = cw[i * DM + c0 + tid];
        const float bias = cb[c0 + tid];
#pragma unroll
        for (int i = 0; i < 8; ++i) { const int j = w + 8 * i;
            if (j < 62) { float a[8]; unpack8(av[i], a);
                const f32x4 u0 = (f32x4){a[0], a[1], a[2], a[3]}, u1 = (f32x4){a[4], a[5], a[6], a[7]};
                *(LAS f32x4*)(Us + j * 512 + lane * 8) = u0; *(LAS f32x4*)(Us + j * 512 + lane * 8 + 4) = u1;
                if (state_out && j >= 32) { float* sp = state_out + (size_t)(j - 32) * DM + c0 + lane * 8; *(f32x4*)sp = u0; *(f32x4*)(sp + 4) = u1; } } }
        LDS_BARRIER();
        if (it + itstride < nitems) CF_LOAD(it + itstride);
        float acc[32];
#pragma unroll
        for (int t = 0; t < 32; ++t) acc[t] = bias;
        CfLds<0>::run(acc, wv, Us + tid);
#pragma unroll
        for (int t = 0; t < 32; ++t) CONVOUT[(size_t)(row0 + t) * DM + c0 + tid] = (bf16_t)f2bf(acc[t]);
        LDS_BARRIER();
    }
#undef CF_LOAD
}

constexpr int LDP = 136;
constexpr int Q_B = 0, Q_BT = 34816, Q_X1 = 69632, Q_X2 = 87040, Q_H = 104448, Q_CS = 121856;

#define MFMA16(a, b, c) __builtin_amdgcn_mfma_f32_16x16x32_bf16((a), (b), (c), 0, 0, 0)

__device__ __forceinline__ void ssd_prompt(LAS unsigned char* lds, int b, int h, const bf16_t* XBC, const float* CS, const bf16_t* XT1, const bf16_t* XT2, const bf16_t* BT, bf16_t* MIX, float* p_ssm) {
    const int tid = ltid(), w = __builtin_amdgcn_readfirstlane(tid >> 6), lane = tid & 63, fr = lane & 15, fq = lane >> 4;
    const int g = h >> 3;
    const int rt = (w < 4) ? w : 11 - w;
    LAS bf16_t* Bs = (LAS bf16_t*)(lds + Q_B); LAS bf16_t* BTs = (LAS bf16_t*)(lds + Q_BT);
    LAS bf16_t* X1s = (LAS bf16_t*)(lds + Q_X1); LAS bf16_t* X2s = (LAS bf16_t*)(lds + Q_X2); LAS bf16_t* Hs = (LAS bf16_t*)(lds + Q_H);
    LAS float* css_all = (LAS float*)(lds + Q_CS);
    for (int i = tid; i < 64 * LDP / 2; i += 512) ((LAS unsigned*)Hs)[i] = 0u;
#pragma unroll
    for (int i = 0; i < 4; ++i) { const int j = tid + 512 * i; css_all[j] = CS[(size_t)(b * SEQ + j) * NH + h]; }
    f32x4 hacc[4];
#pragma unroll
    for (int pt = 0; pt < 4; ++pt) hacc[pt] = (f32x4){0.f, 0.f, 0.f, 0.f};
    u32x4 Bv[4], BTv[4], X1v[2], X2v[2]; bf16x8 afn[4];
#define SSD_PREFETCH(cidx) do { const int rb_ = b * SEQ + (cidx) * 128; const size_t ci_ = (size_t)(b * (SEQ / 128) + (cidx)); \
        _Pragma("unroll") for (int i = 0; i < 4; ++i) { const int idx = tid + 512 * i, rr = idx >> 4, ch = idx & 15; \
            Bv[i] = *(const u32x4*)(XBC + (size_t)(rb_ + rr) * XBCW + 2048 + g * 128 + ch * 8); BTv[i] = *(const u32x4*)(BT + (ci_ * 512 + g * 128 + rr) * 128 + ch * 8); } \
        _Pragma("unroll") for (int i = 0; i < 2; ++i) { const int idx = tid + 512 * i, rr = idx >> 4, ch = idx & 15; \
            X1v[i] = *(const u32x4*)(XT1 + (ci_ * DM + h * 64 + rr) * 128 + ch * 8); X2v[i] = *(const u32x4*)(XT2 + (ci_ * DM + h * 64 + rr) * 128 + ch * 8); } \
        _Pragma("unroll") for (int ks = 0; ks < 4; ++ks) afn[ks] = *(const bf16x8*)(XBC + (size_t)(rb_ + 16 * rt + fr) * XBCW + 2560 + g * 128 + ks * 32 + fq * 8); } while (0)
    SSD_PREFETCH(0);
    LDS_BARRIER();
    for (int c = 0; c < SEQ / 128; ++c) {
        const int rowbase = b * SEQ + c * 128;
        LAS float* css = css_all + c * 128;
        const float cs_last = css[127];
#pragma unroll
        for (int i = 0; i < 4; ++i) { const int idx = tid + 512 * i, rr = idx >> 4, ch = idx & 15;
            *(LAS u32x4*)(Bs + rr * LDP + ch * 8) = Bv[i]; *(LAS u32x4*)(BTs + rr * LDP + ch * 8) = BTv[i]; }
#pragma unroll
        for (int i = 0; i < 2; ++i) { const int idx = tid + 512 * i, rr = idx >> 4, ch = idx & 15;
            *(LAS u32x4*)(X1s + rr * LDP + ch * 8) = X1v[i]; *(LAS u32x4*)(X2s + rr * LDP + ch * 8) = X2v[i]; }
        bf16x8 afr[4];
#pragma unroll
        for (int ks = 0; ks < 4; ++ks) afr[ks] = afn[ks];
        if (c + 1 < SEQ / 128) SSD_PREFETCH(c + 1);
        LDS_BARRIER();
        u32x2 cbm[8];
        const float csi = css[16 * rt + fr];
#pragma unroll
        for (int jt = 0; jt < 8; ++jt) {
            cbm[jt] = (u32x2){0u, 0u};
            if (jt <= rt) {
                f32x4 a4 = (f32x4){0.f, 0.f, 0.f, 0.f};
#pragma unroll
                for (int ks = 0; ks < 4; ++ks) { const bf16x8 bb = *(const LAS bf16x8*)(Bs + (16 * jt + fr) * LDP + ks * 32 + fq * 8); a4 = MFMA16(bb, afr[ks], a4); }
                const f32x4 csj = *(const LAS f32x4*)(css + 16 * jt + 4 * fq);
                const int i = 16 * rt + fr, j0 = 16 * jt + 4 * fq;
#pragma unroll
                for (int r = 0; r < 4; ++r) a4[r] = (j0 + r <= i) ? a4[r] * __expf(csi - csj[r]) : 0.f;
                cbm[jt].x = pk2(a4[0], a4[1]); cbm[jt].y = pk2(a4[2], a4[3]);
            }
        }
        LDS_BARRIER();
        LAS bf16_t* Ms = Bs;
#pragma unroll
        for (int jt = 0; jt < 8; ++jt) if (jt <= (rt | 1)) {
            *(LAS u32x2*)(Ms + (16 * rt + fr) * LDP + 16 * jt + 4 * fq) = cbm[jt];
        }
        asm volatile("s_waitcnt lgkmcnt(0)" ::: "memory");
        f32x4 yacc[4];
#pragma unroll
        for (int pt = 0; pt < 4; ++pt) yacc[pt] = (f32x4){0.f, 0.f, 0.f, 0.f};
#pragma unroll
        for (int ks = 0; ks < 4; ++ks)
#pragma unroll
            for (int pt = 0; pt < 4; ++pt) { const bf16x8 bb = *(const LAS bf16x8*)(Hs + (16 * pt + fr) * LDP + ks * 32 + fq * 8); yacc[pt] = MFMA16(bb, afr[ks], yacc[pt]); }
        { const float e = __expf(csi);
#pragma unroll
          for (int pt = 0; pt < 4; ++pt) yacc[pt] *= e; }
#pragma unroll
        for (int ks = 0; ks < 4; ++ks) if (ks <= (rt >> 1)) {
            const bf16x8 am = *(const LAS bf16x8*)(Ms + (16 * rt + fr) * LDP + ks * 32 + fq * 8);
#pragma unroll
            for (int pt = 0; pt < 4; ++pt) { const bf16x8 bb = *(const LAS bf16x8*)(X1s + (16 * pt + fr) * LDP + ks * 32 + fq * 8); yacc[pt] = MFMA16(bb, am, yacc[pt]); }
        }
#pragma unroll
        for (int pt = 0; pt < 4; ++pt) { u32x2 pk; pk.x = pk2(yacc[pt][0], yacc[pt][1]); pk.y = pk2(yacc[pt][2], yacc[pt][3]);
            *(u32x2*)(MIX + (size_t)(rowbase + 16 * rt + fr) * DMIX + h * 64 + 16 * pt + 4 * fq) = pk; }
        { const float dl = __expf(cs_last);
#pragma unroll
          for (int pt = 0; pt < 4; ++pt) hacc[pt] *= dl; }
#pragma unroll
        for (int ks = 0; ks < 4; ++ks) { const bf16x8 bb = *(const LAS bf16x8*)(BTs + (16 * w + fr) * LDP + ks * 32 + fq * 8);
#pragma unroll
            for (int pt = 0; pt < 4; ++pt) { const bf16x8 aa = *(const LAS bf16x8*)(X2s + (16 * pt + fr) * LDP + ks * 32 + fq * 8); hacc[pt] = MFMA16(bb, aa, hacc[pt]); } }
        LDS_BARRIER();
#pragma unroll
        for (int pt = 0; pt < 4; ++pt) { u32x2 pk; pk.x = pk2(hacc[pt][0], hacc[pt][1]); pk.y = pk2(hacc[pt][2], hacc[pt][3]);
            *(LAS u32x2*)(Hs + (16 * pt + fr) * LDP + 16 * w + 4 * fq) = pk; }
    }
#undef SSD_PREFETCH
#pragma unroll
    for (int pt = 0; pt < 4; ++pt) *(f32x4*)(p_ssm + ((size_t)(b * NH + h) * HP + 16 * pt + fr) * NS + 16 * w + 4 * fq) = hacc[pt];
    LDS_BARRIER();
}

__device__ __forceinline__ void ssd_sample_items(LAS unsigned char* lds, int it0, int itstride, int nitems, const bf16_t* XBC, const float* DT, const float* a_log,
                                                 const float* state_in, bf16_t* MIX, float* s_ssm) {
    const int tid = ltid(), w = __builtin_amdgcn_readfirstlane(tid >> 6), lane = tid & 63, nl = lane & 31, half = lane >> 5;
    LAS float* Xs = (LAS float*)lds;
    if (it0 >= nitems) return;
    f32x4 nx[16];
    { const int b = it0 >> 2, g = it0 & 3, h = g * 8 + w; const float* sp = state_in + (size_t)(b * NH + h) * HP * NS;
#pragma unroll
      for (int k = 0; k < 16; ++k) nx[k] = *(const f32x4*)(sp + k * 256 + lane * 4); }
    for (int it = it0; it < nitems; it += itstride) {
        const int b = it >> 2, g = it & 3, h = g * 8 + w;
        u32x2 Bp[4], Cp[4]; float dtv[4];
#pragma unroll
        for (int t = 0; t < 4; ++t) { const size_t row = (size_t)(MP + 4 * b + t);
            Xs[t * 512 + tid] = bf2f(XBC[row * XBCW + g * 512 + tid]);
            Bp[t] = *(const u32x2*)(XBC + row * XBCW + 2048 + g * 128 + 4 * nl); Cp[t] = *(const u32x2*)(XBC + row * XBCW + 2560 + g * 128 + 4 * nl);
            dtv[t] = DT[row * NH + h]; }
        const float A = -__expf(a_log[h]);
        LDS_BARRIER();
#pragma unroll
        for (int hh = 0; hh < 2; ++hh) {
            f32x4 st[16];
#pragma unroll
            for (int k = 0; k < 16; ++k) st[k] = nx[k];
            {
                const int itn = it + itstride;
                if (hh == 0) { const float* sp = state_in + (size_t)(b * NH + h) * HP * NS + 4096;
#pragma unroll
                    for (int k = 0; k < 16; ++k) nx[k] = *(const f32x4*)(sp + k * 256 + lane * 4); }
                else if (itn < nitems) { const int bn = itn >> 2, gn = itn & 3; const float* sp = state_in + (size_t)(bn * NH + gn * 8 + w) * HP * NS;
#pragma unroll
                    for (int k = 0; k < 16; ++k) nx[k] = *(const f32x4*)(sp + k * 256 + lane * 4); }
            }
            float yv[4];
#pragma unroll
            for (int t = 0; t < 4; ++t) {
                const float dt = dtv[t]; const float da = __expf(dt * A);
                const f32x4 Bt = (f32x4){bf2f(Bp[t].x & 0xffffu), bf2f(Bp[t].x >> 16), bf2f(Bp[t].y & 0xffffu), bf2f(Bp[t].y >> 16)} * dt;
                const f32x4 Ct = (f32x4){bf2f(Cp[t].x & 0xffffu), bf2f(Cp[t].x >> 16), bf2f(Cp[t].y & 0xffffu), bf2f(Cp[t].y >> 16)};
                float part[8];
                { const bool up8 = (nl & 8) != 0;
#pragma unroll
                  for (int i = 0; i < 8; ++i) {
                    const float x0 = Xs[t * 512 + w * 64 + 32 * hh + 2 * i + half], x1 = Xs[t * 512 + w * 64 + 32 * hh + 2 * (i + 8) + half];
                    st[i] = st[i] * da + Bt * x0; st[i + 8] = st[i + 8] * da + Bt * x1;
                    const f32x4 q0 = Ct * st[i], q1 = Ct * st[i + 8];
                    const float p0 = (q0.x + q0.y) + (q0.z + q0.w), p1 = (q1.x + q1.y) + (q1.z + q1.w);
                    const float send = up8 ? p0 : p1, keep = up8 ? p1 : p0; part[i] = keep + __shfl_xor(send, 8); } }
#define BFLY(o) do { const bool up = (nl & (o)) != 0; _Pragma("unroll") for (int i = 0; i < (o); ++i) { \
                    const float send = up ? part[i] : part[i + (o)]; const float keep = up ? part[i + (o)] : part[i]; part[i] = keep + __shfl_xor(send, (o)); } } while (0)
                BFLY(4); BFLY(2); BFLY(1);
#undef BFLY
                yv[t] = part[0] + __shfl_xor(part[0], 16);
            }
            const int pout = 32 * hh + 2 * (nl & 15) + half;
            if ((nl & 16) == 0) {
#pragma unroll
                for (int t = 0; t < 4; ++t) MIX[(size_t)(MP + 4 * b + t) * DMIX + h * 64 + pout] = (bf16_t)f2bf(yv[t]);
            }
            float* op = s_ssm + (size_t)(b * NH + h) * HP * NS + hh * 4096;
#pragma unroll
            for (int k = 0; k < 16; ++k) *(f32x4*)(op + k * 256 + lane * 4) = st[k];
        }
        LDS_BARRIER();
    }
}

__device__ __forceinline__ void mix_finalize_ssd(size_t row, bf16_t* MIX, const bf16_t* XBC, const bf16_t* PROJ, const float* d_skip, const float* ssd_norm_w, int lane, bf16_t* ssd_dst) {
    bf16_t* mp = MIX + row * DMIX;
    {
        u32x4 yv[4], xv[4], zv[4]; float dsk[4];
#pragma unroll
        for (int k = 0; k < 4; ++k) { const int c = (k * 64 + lane) * 8;
            yv[k] = *(const u32x4*)(mp + c); xv[k] = *(const u32x4*)(XBC + row * XBCW + c); zv[k] = *(const u32x4*)(PROJ + row * NPROJ + CZ + c);
            dsk[k] = d_skip[c >> 6]; }
        float s = 0.f;
#pragma unroll
        for (int k = 0; k < 4; ++k) { float f[8], xf[8], zf[8]; unpack8(yv[k], f); unpack8(xv[k], xf); unpack8(zv[k], zf);
#pragma unroll
            for (int e = 0; e < 8; ++e) { f[e] = (f[e] + dsk[k] * xf[e]) * siluf_(zf[e]); s += f[e] * f[e]; }
            yv[k] = pack8(f); }
        const float r = rsqrtf(wave_sum(s) * (1.f / DM) + EPS);
#pragma unroll 1
        for (int k = 0; k < 4; ++k) { const int c = (k * 64 + lane) * 8;
            const f32x4 w0 = *(const f32x4*)(ssd_norm_w + c), w1 = *(const f32x4*)(ssd_norm_w + c + 4);
            const u32x4 yk = (k == 0) ? yv[0] : (k == 1) ? yv[1] : (k == 2) ? yv[2] : yv[3];
            float f[8]; unpack8(yk, f);
            float o[8]; o[0] = f[0] * r * w0.x; o[1] = f[1] * r * w0.y; o[2] = f[2] * r * w0.z; o[3] = f[3] * r * w0.w;
            o[4] = f[4] * r * w1.x; o[5] = f[5] * r * w1.y; o[6] = f[6] * r * w1.z; o[7] = f[7] * r * w1.w;
            *(u32x4*)(ssd_dst + c) = pack8(o); }
    }
}
__device__ __forceinline__ void mix_finalize_conformer(size_t row, bf16_t* MIX, const bf16_t* CONVOUT, const float* ln_w, const float* ln_b, int lane) {
    bf16_t* mp = MIX + row * DMIX;
    {
        const bf16_t* cp = CONVOUT + row * DM;
        f32x4 v[8], ww[8], bb[8];
#pragma unroll
        for (int k = 0; k < 8; ++k) { const u32x2 cv = *(const u32x2*)(cp + (k * 64 + lane) * 4); v[k] = (f32x4){bf2f(cv.x & 0xffffu), bf2f(cv.x >> 16), bf2f(cv.y & 0xffffu), bf2f(cv.y >> 16)};
            ww[k] = *(const f32x4*)(ln_w + (k * 64 + lane) * 4); bb[k] = *(const f32x4*)(ln_b + (k * 64 + lane) * 4); }
        float s = 0.f;
#pragma unroll
        for (int k = 0; k < 8; ++k) s += (v[k].x + v[k].y) + (v[k].z + v[k].w);
        const float mean = wave_sum(s) * (1.f / DM); float q = 0.f;
#pragma unroll
        for (int k = 0; k < 8; ++k) { v[k] = v[k] - mean; q += (v[k].x * v[k].x + v[k].y * v[k].y) + (v[k].z * v[k].z + v[k].w * v[k].w); }
        const float rstd = rsqrtf(wave_sum(q) * (1.f / DM) + EPS);
#pragma unroll
        for (int k = 0; k < 8; ++k) {
            const f32x4 o = v[k] * rstd * ww[k] + bb[k];
            u32x2 pk; pk.x = pk2(siluf_(o.x), siluf_(o.y)); pk.y = pk2(siluf_(o.z), siluf_(o.w));
            *(u32x2*)(mp + DM + (k * 64 + lane) * 4) = pk; }
    }
}

template <int NT, bool SAMPLE>
__device__ __forceinline__ void ffn_item(const bf16_t* U, int row0, bool has_hist, const float* st, int cgi, const float* w, const float* bias, bf16_t* ACT, float* state_out) {
    const int c0 = cgi * 8;
    float wg[3][8], wv[3][8], bg[8], bvv[8], g0[8], g1[8], v0[8], v1[8];
#define LD8(dst, ptr) do { const f32x4 a_ = *(const f32x4*)(ptr), b_ = *(const f32x4*)((ptr) + 4); dst[0] = a_.x; dst[1] = a_.y; dst[2] = a_.z; dst[3] = a_.w; dst[4] = b_.x; dst[5] = b_.y; dst[6] = b_.z; dst[7] = b_.w; } while (0)
#pragma unroll
    for (int i = 0; i < 3; ++i) { LD8(wg[i], w + i * FF2 + c0); LD8(wv[i], w + i * FF2 + FF + c0); }
    LD8(bg, bias + c0); LD8(bvv, bias + FF + c0);
    if (SAMPLE) {
        LD8(g0, st + 0 * FF2 + c0); LD8(g1, st + 1 * FF2 + c0); LD8(v0, st + 0 * FF2 + FF + c0); LD8(v1, st + 1 * FF2 + FF + c0);
    } else if (has_hist) {
        unpack8(*(const u32x4*)(U + (size_t)(row0 - 2) * FF2 + c0), g0); unpack8(*(const u32x4*)(U + (size_t)(row0 - 1) * FF2 + c0), g1);
        unpack8(*(const u32x4*)(U + (size_t)(row0 - 2) * FF2 + FF + c0), v0); unpack8(*(const u32x4*)(U + (size_t)(row0 - 1) * FF2 + FF + c0), v1);
    } else {
#pragma unroll
        for (int e = 0; e < 8; ++e) { g0[e] = 0.f; g1[e] = 0.f; v0[e] = 0.f; v1[e] = 0.f; }
    }
#undef LD8
    u32x4 rg[NT], rv[NT];
#pragma unroll
    for (int t = 0; t < NT; ++t) { rg[t] = *(const u32x4*)(U + (size_t)(row0 + t) * FF2 + c0); rv[t] = *(const u32x4*)(U + (size_t)(row0 + t) * FF2 + FF + c0); }
#pragma unroll
    for (int t = 0; t < NT; ++t) {
        float cg_[8], cv_[8], o[8];
        unpack8(rg[t], cg_); unpack8(rv[t], cv_);
#pragma unroll
        for (int e = 0; e < 8; ++e) {
            const float gg = g0[e] * wg[0][e] + g1[e] * wg[1][e] + cg_[e] * wg[2][e] + bg[e];
            const float vv = v0[e] * wv[0][e] + v1[e] * wv[1][e] + cv_[e] * wv[2][e] + bvv[e];
            o[e] = siluf_(gg) * vv; g0[e] = g1[e]; g1[e] = cg_[e]; v0[e] = v1[e]; v1[e] = cv_[e]; }
        *(u32x4*)(ACT + (size_t)(row0 + t) * FF + c0) = pack8(o);
    }
    if (state_out) {
#define ST8(ptr, src) do { *(f32x4*)(ptr) = (f32x4){src[0], src[1], src[2], src[3]}; *(f32x4*)((ptr) + 4) = (f32x4){src[4], src[5], src[6], src[7]}; } while (0)
        ST8(state_out + 0 * FF2 + c0, g0); ST8(state_out + 1 * FF2 + c0, g1); ST8(state_out + 0 * FF2 + FF + c0, v0); ST8(state_out + 1 * FF2 + FF + c0, v1);
#undef ST8
    }
}


#define XB_TMO      128
#define XB_XCNT(j)  (256  + 64 * (j))
#define XB_XSUB(j)  (1280 + 64 * (j))
#define XB_XGEN(j)  (2304 + 64 * (j))
#define XB_TOP      3328
#define XB_TOPGEN   3392
#define XCD_BAR_WORDS 3456
#define XB_SPIN_CAP (1u << 18)
__device__ __forceinline__ unsigned xb_ld(unsigned* p)              { return __hip_atomic_load(p, __ATOMIC_RELAXED, __HIP_MEMORY_SCOPE_AGENT); }
__device__ __forceinline__ unsigned xb_add(unsigned* p, unsigned v) { return __hip_atomic_fetch_add(p, v, __ATOMIC_RELAXED, __HIP_MEMORY_SCOPE_AGENT); }
__device__ __forceinline__ unsigned xb_xcc_id() { return (unsigned)__builtin_amdgcn_s_getreg((3 << 11) | 20) & 0xFu; }
#define XB_SPIN(cond, bar) do { unsigned _sp = 0; while (cond) { __builtin_amdgcn_s_sleep(1); \
    if ((++_sp & 255u) == 0u) { if (xb_ld(&(bar)[XB_TMO])) break; if (_sp > XB_SPIN_CAP) { atomicAdd(&(bar)[XB_TMO], 1u); break; } } } } while (0)
struct XcdBarrier { unsigned* bar; unsigned x; volatile LAS unsigned* st; };
__device__ __forceinline__ XcdBarrier xcd_barrier_post(unsigned* bar, volatile LAS unsigned* st) {
    XcdBarrier b; b.bar = bar; b.x = xb_xcc_id(); b.st = st;
    if (threadIdx.x == 0) (void)xb_add(&bar[XB_XCNT(b.x)], 1u);
    return b;
}
__device__ __forceinline__ void xcd_barrier_complete(unsigned* bar, unsigned x, unsigned& nloc, unsigned& nx) {
    const unsigned G = gridDim.x * gridDim.y * gridDim.z;
    unsigned sum, cnt, mine, sp = 0u;
    for (;;) {
        sum = 0u; cnt = 0u; mine = 0u;
#pragma unroll
        for (unsigned j = 0; j < 16; ++j) { const unsigned c = xb_ld(&bar[XB_XCNT(j)]); sum += c; cnt += (c > 0u) ? 1u : 0u; mine = (j == x) ? c : mine; }
        if (sum == G) break;
        __builtin_amdgcn_s_sleep(1);
        if ((++sp & 255u) == 0u) { if (xb_ld(&bar[XB_TMO])) break; if (sp > XB_SPIN_CAP) { atomicAdd(&bar[XB_TMO], 1u); break; } }
    }
    nloc = mine > 0u ? mine : 1u; nx = cnt > 0u ? cnt : 1u;
}
__device__ __forceinline__ void xcd_barrier(const XcdBarrier& b) {
    asm volatile("s_waitcnt vmcnt(0)" ::: "memory");
    __syncthreads();
    if (threadIdx.x == 0) {
        unsigned* bar = b.bar;
        __builtin_amdgcn_s_waitcnt(0);
        unsigned nloc = b.st[0], nx = b.st[1];
        if (nloc == 0u) { xcd_barrier_complete(bar, b.x, nloc, nx); b.st[0] = nloc; b.st[1] = nx; }
        const unsigned old = xb_add(&bar[XB_XSUB(b.x)], 1u);
        const unsigned gen = old / nloc;
        if (old + 1u == (gen + 1u) * nloc) {
            __builtin_amdgcn_fence(__ATOMIC_RELEASE, "agent");
            asm volatile("s_waitcnt vmcnt(0)" ::: "memory");
            const unsigned og = xb_add(&bar[XB_TOP], 1u);
            const unsigned tg = og / nx;
            if (og + 1u == (tg + 1u) * nx) xb_add(&bar[XB_TOPGEN], 1u);
            else XB_SPIN(xb_ld(&bar[XB_TOPGEN]) == tg, bar);
            __builtin_amdgcn_fence(__ATOMIC_ACQUIRE, "agent");
            xb_add(&bar[XB_XGEN(b.x)], 1u);
            asm volatile("s_waitcnt vmcnt(0)" ::: "memory");
        } else {
            XB_SPIN(xb_ld(&bar[XB_XGEN(b.x)]) == gen, bar);
            __builtin_amdgcn_fence(__ATOMIC_ACQUIRE, "agent");
            asm volatile("s_waitcnt vmcnt(0)" ::: "memory");
        }
    }
    __syncthreads();
}

struct Args { const float* in[25]; float* out_p; unsigned char* ws_p; int ph_lo, ph_hi, li, pad; };
constexpr int N_PHASES = 11;
typedef const __attribute__((address_space(4))) Args* KArgs;
__device__ __forceinline__ KArgs ka_get() { KArgs p = (KArgs)__builtin_amdgcn_kernarg_segment_ptr(); asm volatile("" : "+s"(p)); return p; }

__global__ void __launch_bounds__(512, 2) mk_fwd(Args args) {
    extern __shared__ __attribute__((aligned(16))) unsigned char lds_raw[];
    LAS unsigned char* lds = (LAS unsigned char*)lds_raw;
    const int tid = ltid(), lane = tid & 63, wave = __builtin_amdgcn_readfirstlane(tid >> 6);
    const int G = gridDim.x, bx = blockIdx.x;
    const int vbx = (G % 8 == 0) ? (bx % 8) * (G / 8) + bx / 8 : bx;
    const int lo = args.ph_lo, hi = args.ph_hi;
#define x_prompt ((const float*)KA->in[0])
#define x_sample ((const float*)KA->in[1])
#define state_ssm ((const float*)KA->in[2])
#define state_ssdc ((const float*)KA->in[3])
#define state_cfc ((const float*)KA->in[4])
#define state_ffc ((const float*)KA->in[5])
#define norm_mix_w ((const float*)KA->in[6])
#define w_in ((const float*)KA->in[7])
#define ssd_conv_w ((const float*)KA->in[8])
#define ssd_conv_b ((const float*)KA->in[9])
#define dt_bias ((const float*)KA->in[10])
#define a_log ((const float*)KA->in[11])
#define d_skip ((const float*)KA->in[12])
#define ssd_norm_w ((const float*)KA->in[13])
#define cf_conv_w ((const float*)KA->in[14])
#define cf_conv_b ((const float*)KA->in[15])
#define cf_ln_w ((const float*)KA->in[16])
#define cf_ln_b ((const float*)KA->in[17])
#define w_out ((const float*)KA->in[18])
#define norm_ffn_w ((const float*)KA->in[19])
#define w_up ((const float*)KA->in[20])
#define ffn_conv_w ((const float*)KA->in[21])
#define ffn_conv_b ((const float*)KA->in[22])
#define w_down ((const float*)KA->in[23])
#define norm_final_w ((const float*)KA->in[24])
#define out ((float*)KA->out_p)
#define ws ((unsigned char*)KA->ws_p)
#define WinT ((bf16_t*)(ws + WS_WIN))
#define WoutT ((bf16_t*)(ws + WS_WOUT))
#define WupT ((bf16_t*)(ws + WS_WUP))
#define WdnT ((bf16_t*)(ws + WS_WDN))
#define XN ((bf16_t*)(ws + WS_XN))
#define DT ((float*)(ws + WS_DT))
#define PROJ ((bf16_t*)(ws + WS_PROJ))
#define XBC ((bf16_t*)(ws + WS_XBC))
#define U ((bf16_t*)(ws + WS_U))
#define CONVOUT ((bf16_t*)(ws + WS_CONV))
#define MIX ((bf16_t*)(ws + WS_MIX))
#define ACT ((bf16_t*)(ws + WS_ACT))
#define PART ((float*)(ws + WS_RA))
    constexpr int S2 = 8, S4 = 7;

#ifndef PHASE_MASK
#define PHASE_MASK 0x7ff
#endif
#define IN(k) (((PHASE_MASK >> (k)) & 1) && lo <= (k) && (k) < hi)
    volatile LAS unsigned* bst = (volatile LAS unsigned*)(lds + LDS_BYTES - 64);
    if (tid < 2) bst[tid] = 0u;
    __syncthreads();
    const KArgs KA0 = ka_get();
    const XcdBarrier gbar = xcd_barrier_post((unsigned*)((unsigned char*)KA0->ws_p + WS_CTL) + (args.li & 0xff) * XCD_BAR_WORDS, bst);
    const int psel = args.li >> 8;
    if (args.pad != 0) cg::this_grid().sync();
#define SEAM(k) do { if (IN(k) && IN((k) + 1)) xcd_barrier(gbar); } while (0)

    if (IN(0)) { const KArgs KA = ka_get(); const int tid = ltid(), lane = tid & 63, wave = __builtin_amdgcn_readfirstlane(tid >> 6); (void)lane; (void)wave;
        LAS float* scr = (LAS float*)(lds + wave * 16384);
        const int gw = bx * 8 + wave, NGW = G * 8;
        constexpr int I_IN = (DM / 64) * (9248 / 32), I_OUT = (DMIX / 64) * (DM / 32), I_UP = (DM / 64) * (FF2 / 32), I_DN = (FF / 64) * (DM / 32);
        constexpr int n_items0 = I_IN + I_OUT + I_UP + I_DN;
        for (int it = gw; it < n_items0; it += NGW) {
            int r = it;
            if (r < I_IN) { const int nblk = 9248 / 32, kb = r / nblk, nb = r % nblk; p0_transpose_item(w_in, DM, 9248, WinT, 64 * kb, 32 * nb, win_dest_row(32 * nb), scr, lane); continue; } r -= I_IN;
            if (r < I_OUT) { const int nblk = DM / 32, kb = r / nblk, nb = r % nblk; p0_transpose_item(w_out, DMIX, DM, WoutT, 64 * kb, 32 * nb, 32 * nb, scr, lane); continue; } r -= I_OUT;
            if (r < I_UP) { const int nblk = FF2 / 32, kb = r / nblk, nb = r % nblk; p0_transpose_item(w_up, DM, FF2, WupT, 64 * kb, 32 * nb, 32 * nb, scr, lane, norm_ffn_w); continue; } r -= I_UP;
            { const int nblk = DM / 32, kb = r / nblk, nb = r % nblk; p0_transpose_item(w_down, FF, DM, WdnT, 64 * kb, 32 * nb, 32 * nb, scr, lane); }
        }
        const int gr = (gw + NGW - (n_items0 % NGW)) % NGW;
        for (int m = gr; m < MT; m += NGW) { const float* xr = (m < MP) ? x_prompt + (size_t)m * DM : x_sample + (size_t)(m - MP) * DM; rms_row_to_bf16(xr, norm_mix_w, XN + (size_t)m * DM, lane); }
    }
    SEAM(0);
    if (IN(1)) { const KArgs KA = ka_get(); const int tid = ltid(), lane = tid & 63, wave = __builtin_amdgcn_readfirstlane(tid >> 6); (void)lane; (void)wave;
        pg8::Gemm g{XN, WinT, MT, NPROJ, DM}; pg8::StaticOrder S; S.init(MT, NPROJ, G, bx, DM);
        pg8::EpiBf16 E{PROJ, NPROJ, nullptr, CCF / 256, CUCF};
        pg8::gemm_phase<pg8::EpiBf16, pg8::StaticOrder, true, true>(lds, g, S, E);
    }
    SEAM(1);
    if (IN(2)) { const KArgs KA = ka_get(); const int tid = ltid(), lane = tid & 63, wave = __builtin_amdgcn_readfirstlane(tid >> 6); (void)lane; (void)wave;
        bf16_t* XT1 = (bf16_t*)(ws + WS_XT1); bf16_t* XT2 = (bf16_t*)((unsigned char*)out + OS_XT2); bf16_t* BT = (bf16_t*)((unsigned char*)out + OS_BT); float* CS = (float*)((unsigned char*)out + OS_CS);
        {   const int gw = bx * 8 + wave, NGW = G * 8;
            for (int it = gw; it < 64 * NH + (MS * NH) / 64; it += NGW) {
                if (it < 64 * NH) { const int ci = it >> 5, h = it & 31, rb = ci * 128;
                    const float bias = dt_bias[h], A = -__expf(a_log[h]);
                    const float v0 = bf2f(PROJ[(size_t)(rb + 2 * lane) * NPROJ + CDT + h]) + bias, v1 = bf2f(PROJ[(size_t)(rb + 2 * lane + 1) * NPROJ + CDT + h]) + bias;
                    const float d0 = fmaxf(v0, 0.f) + log1pf(__expf(-fabsf(v0))), d1 = fmaxf(v1, 0.f) + log1pf(__expf(-fabsf(v1)));
                    const float a1 = d1 * A; float sc = d0 * A + a1;
#pragma unroll
                    for (int o = 1; o < 64; o <<= 1) { const float t = __shfl_up(sc, o); if (lane >= o) sc += t; }
                    DT[(size_t)(rb + 2 * lane) * NH + h] = d0; DT[(size_t)(rb + 2 * lane + 1) * NH + h] = d1;
                    CS[(size_t)(rb + 2 * lane) * NH + h] = sc - a1; CS[(size_t)(rb + 2 * lane + 1) * NH + h] = sc; }
                else { const int e = (it - 64 * NH) * 64 + lane, row = MP + (e >> 5), h = e & 31;
                    const float v = bf2f(PROJ[(size_t)row * NPROJ + CDT + h]) + dt_bias[h];
                    DT[(size_t)row * NH + h] = fmaxf(v, 0.f) + log1pf(__expf(-fabsf(v))); }
            }
        }
        if (psel != 1) {
            cf_prompt_items(lds, PROJ, vbx, G, 1024, cf_conv_w, cf_conv_b, CONVOUT, out + O_PCFC);
            for (int it2 = bx; it2 < 256; it2 += G) { const int s = it2 >> 1, c = (it2 & 1) * 1024 + tid * 2;
                cf_sample_item(PROJ, s, c, state_cfc + (size_t)s * 30 * DM, cf_conv_w, cf_conv_b, CONVOUT, out + O_SCFC + (size_t)s * 30 * DM); }
        }
        xcd_barrier(gbar);
        const int gt = vbx * 512 + tid, NGT = G * 512;
        if (psel != 2) for (int it = gt; it < (MP / 8) * 384; it += NGT) {
            const int cq = it & 7, tgl = (it >> 3) & 7, rest = it >> 6; const int cgi = (rest % 48) * 8 + cq, tg = (rest / 48) * 8 + tgl; const int row0 = tg * 8, t0 = row0 % SEQ, b = row0 / SEQ;
            ssdconv_prompt_item(PROJ, row0, t0 > 0, cgi, ssd_conv_w, ssd_conv_b, XBC, (t0 == SEQ - 8) ? out + O_PSSDC + (size_t)b * 3 * XBCW : nullptr, DT, CS, XT1, XT2, BT); }
        for (int it = gt; it < DB * 384; it += NGT) { const int cgi = it % 384, s = it / 384;
            ssdconv_item<4, true>(PROJ, MP + 4 * s, true, state_ssdc + (size_t)s * 3 * XBCW, cgi, ssd_conv_w, ssd_conv_b, XBC, out + O_SSSDC + (size_t)s * 3 * XBCW); }
    }
    SEAM(2);
    if (IN(3)) { const KArgs KA = ka_get(); const int tid = ltid(), lane = tid & 63, wave = __builtin_amdgcn_readfirstlane(tid >> 6); (void)lane; (void)wave;
        const bf16_t* XT1 = (const bf16_t*)(ws + WS_XT1); const bf16_t* XT2 = (const bf16_t*)((unsigned char*)out + OS_XT2); const bf16_t* BT = (const bf16_t*)((unsigned char*)out + OS_BT); const float* CS = (const float*)((unsigned char*)out + OS_CS);
        const int npb = (G >= 256) ? 128 : (G / 2 > 0 ? G / 2 : 1);
        if (bx < npb) { if (psel != 2) for (int it = bx; it < NB * NH; it += npb) ssd_prompt(lds, it >> 5, it & 31, XBC, CS, XT1, XT2, BT, MIX, out + O_PSSM); }
        else { if (psel != 1) ssd_sample_items(lds, bx - npb, G - npb, DB * NG, XBC, DT, a_log, state_ssm, MIX, out + O_SSSM);
            if (psel == 0) for (int m = (bx - npb) * 8 + wave; m < MT; m += (G - npb) * 8) mix_finalize_conformer((size_t)m, MIX, CONVOUT, cf_ln_w, cf_ln_b, lane); }
    }
    SEAM(3);
    if (IN(4)) { const KArgs KA = ka_get(); const int tid = ltid(), lane = tid & 63, wave = __builtin_amdgcn_readfirstlane(tid >> 6); (void)lane; (void)wave;
        for (int m = bx * 8 + wave; m < MP; m += G * 8) mix_finalize_ssd((size_t)m, MIX, XBC, PROJ, d_skip, ssd_norm_w, lane, (psel == 3) ? XN + (size_t)m * DM : MIX + (size_t)m * DMIX);
        LAS float* red = (LAS float*)lds;
        for (int m0 = MP + 2 * bx; m0 < MT; m0 += 2 * G) {
            const size_t m = (size_t)(m0 + (wave >> 2)); const int q = wave & 3, c = q * 512 + lane * 8;
            bf16_t* mp = MIX + m * DMIX;
            const u32x4 yv = *(const u32x4*)(mp + c), xv = *(const u32x4*)(XBC + m * XBCW + c), zv = *(const u32x4*)(PROJ + m * NPROJ + CZ + c);
            const float dsk = d_skip[c >> 6]; const f32x4 w0 = *(const f32x4*)(ssd_norm_w + c), w1 = *(const f32x4*)(ssd_norm_w + c + 4);
            float f[8], xf[8], zf[8]; unpack8(yv, f); unpack8(xv, xf); unpack8(zv, zf);
            float sq = 0.f;
#pragma unroll
            for (int e = 0; e < 8; ++e) { f[e] = (f[e] + dsk * xf[e]) * siluf_(zf[e]); sq += f[e] * f[e]; }
            sq = wave_sum(sq);
            if (lane == 0) red[wave] = sq;
            LDS_BARRIER();
            const float tot = red[(wave & 4) + 0] + red[(wave & 4) + 1] + red[(wave & 4) + 2] + red[(wave & 4) + 3];
            const float r = rsqrtf(tot * (1.f / DM) + EPS);
            float o[8]; o[0] = f[0] * r * w0.x; o[1] = f[1] * r * w0.y; o[2] = f[2] * r * w0.z; o[3] = f[3] * r * w0.w; o[4] = f[4] * r * w1.x; o[5] = f[5] * r * w1.y; o[6] = f[6] * r * w1.z; o[7] = f[7] * r * w1.w;
            bf16_t* dst = (psel == 3) ? XN + m * DM : mp;
            *(u32x4*)(dst + c) = pack8(o);
            LDS_BARRIER();
        }
    }
    SEAM(4);
    if (IN(5)) { const KArgs KA = ka_get(); const int tid = ltid(), lane = tid & 63, wave = __builtin_amdgcn_readfirstlane(tid >> 6); (void)lane; (void)wave;
        pg8::Gemm g{MIX, WoutT, MT, DM, DMIX}; pg8::SplitOrder S; S.init(DMIX, G, bx, S2, 8);
        pg8::EpiX1 E{x_prompt, XN, (float*)(ws + WS_CTL + CTL_SSQ1), PART, psel == 3};
        pg8::gemm_phase<pg8::EpiX1, pg8::SplitOrder, true, true>(lds, g, S, E);
    }
    SEAM(5);
    if (IN(6)) { const KArgs KA = ka_get(); const int tid = ltid(), lane = tid & 63, wave = __builtin_amdgcn_readfirstlane(tid >> 6); (void)lane; (void)wave;
        float* SSQ1 = (float*)(ws + WS_CTL + CTL_SSQ1);
        for (int m = MP + bx * 8 + wave; m < MT; m += G * 8) {
            const float* base = x_sample + (size_t)(m - MP) * DM; const float* part = PART + (size_t)(m - MP) * DM;
            f32x4 v[8];
#pragma unroll
            for (int j = 0; j < 8; ++j) v[j] = *(const f32x4*)(base + (j * 64 + lane) * 4);
            for (int sp = 0; sp < S2; ++sp) {
#pragma unroll
                for (int j = 0; j < 8; ++j) v[j] += *(const f32x4*)(part + (size_t)sp * MS * DM + (j * 64 + lane) * 4); }
            float sq = 0.f;
#pragma unroll
            for (int j = 0; j < 8; ++j) sq += (v[j].x * v[j].x + v[j].y * v[j].y) + (v[j].z * v[j].z + v[j].w * v[j].w);
            sq = wave_sum(sq);
            if (lane == 0) SSQ1[m] = sq;
#pragma unroll
            for (int j = 0; j < 8; ++j) { u32x2 o; o.x = pk2(v[j].x, v[j].y); o.y = pk2(v[j].z, v[j].w); *(u32x2*)(XN + (size_t)m * DM + (j * 64 + lane) * 4) = o; }
        }
    }
    SEAM(6);
    if (IN(7)) { const KArgs KA = ka_get(); const int tid = ltid(), lane = tid & 63, wave = __builtin_amdgcn_readfirstlane(tid >> 6); (void)lane; (void)wave;
        pg8::Gemm g{XN, WupT, MT, FF2, DM}; pg8::StaticOrder S; S.init(MT, FF2, G, bx, DM);
        pg8::EpiBf16 E{U, FF2, (const float*)(ws + WS_CTL + CTL_SSQ1), -1, 0};
        pg8::gemm_phase<pg8::EpiBf16, pg8::StaticOrder, true, true>(lds, g, S, E);
    }
    SEAM(7);
    if (IN(8)) { const KArgs KA = ka_get(); const int tid = ltid(), lane = tid & 63, wave = __builtin_amdgcn_readfirstlane(tid >> 6); (void)lane; (void)wave;
        const int gt = vbx * 512 + tid, NGT = G * 512;
        for (int it = gt; it < (MP / 8) * 688; it += NGT) { const int cgi = it % 688, tg = it / 688; const int row0 = tg * 8, t0 = row0 % SEQ, b = row0 / SEQ;
            ffn_item<8, false>(U, row0, t0 > 0, nullptr, cgi, ffn_conv_w, ffn_conv_b, ACT, (t0 == SEQ - 8) ? out + O_PFFC + (size_t)b * 2 * FF2 : nullptr); }
        for (int it = gt; it < DB * 688; it += NGT) { const int cgi = it % 688, s = it / 688;
            ffn_item<4, true>(U, MP + 4 * s, true, state_ffc + (size_t)s * 2 * FF2, cgi, ffn_conv_w, ffn_conv_b, ACT, out + O_SFFC + (size_t)s * 2 * FF2); }
    }
    SEAM(8);
    if (IN(9)) { const KArgs KA = ka_get(); const int tid = ltid(), lane = tid & 63, wave = __builtin_amdgcn_readfirstlane(tid >> 6); (void)lane; (void)wave;
        pg8::Gemm g{ACT, WdnT, MT, DM, FF}; pg8::SplitOrder S; S.init(FF, G, bx, S4, 12);
        pg8::EpiResF32 E{XN, out + O_Y, PART, psel == 3};
        pg8::gemm_phase<pg8::EpiResF32, pg8::SplitOrder, true, true>(lds, g, S, E);
    }
    SEAM(9);
    if (IN(10)) { const KArgs KA = ka_get(); const int tid = ltid(), lane = tid & 63, wave = __builtin_amdgcn_readfirstlane(tid >> 6); (void)lane; (void)wave;
        for (int m = bx * 8 + wave; m < MP; m += G * 8) {
            float* xr = out + O_Y + (size_t)m * DM;
            f32x4 v[8], ww[8];
#pragma unroll
            for (int j = 0; j < 8; ++j) { const u32x2 b = *(const u32x2*)(XN + (size_t)m * DM + (j * 64 + lane) * 4); v[j] = (f32x4){bf2f(b.x & 0xffffu), bf2f(b.x >> 16), bf2f(b.y & 0xffffu), bf2f(b.y >> 16)};
                ww[j] = *(const f32x4*)(norm_final_w + (j * 64 + lane) * 4); }
            float s = 0.f;
#pragma unroll
            for (int j = 0; j < 8; ++j) s += (v[j].x * v[j].x + v[j].y * v[j].y) + (v[j].z * v[j].z + v[j].w * v[j].w);
            const float r = rsqrtf(wave_sum(s) * (1.f / DM) + EPS);
#pragma unroll
            for (int j = 0; j < 8; ++j) *(f32x4*)(xr + (j * 64 + lane) * 4) = v[j] * r * ww[j];
        }
        LAS float* red = (LAS float*)lds;
        for (int m0 = MP + 2 * bx; m0 < MT; m0 += 2 * G) {
            const size_t m = (size_t)(m0 + (wave >> 2)); const int q = wave & 3, c = q * 512 + lane * 8;
            const u32x4 b = *(const u32x4*)(XN + m * DM + c);
            const f32x4 w0 = *(const f32x4*)(norm_final_w + c), w1 = *(const f32x4*)(norm_final_w + c + 4);
            float f[8]; unpack8(b, f);
            f32x4 v0 = (f32x4){f[0], f[1], f[2], f[3]}, v1 = (f32x4){f[4], f[5], f[6], f[7]};
            const float* part = PART + (m - MP) * DM + c;
            for (int sp = 0; sp < S4; ++sp) { v0 += *(const f32x4*)(part + (size_t)sp * MS * DM); v1 += *(const f32x4*)(part + (size_t)sp * MS * DM + 4); }
            float sq = (v0.x * v0.x + v0.y * v0.y) + (v0.z * v0.z + v0.w * v0.w) + (v1.x * v1.x + v1.y * v1.y) + (v1.z * v1.z + v1.w * v1.w);
            sq = wave_sum(sq);
            if (lane == 0) red[wave] = sq;
            LDS_BARRIER();
            const float tot = red[(wave & 4) + 0] + red[(wave & 4) + 1] + red[(wave & 4) + 2] + red[(wave & 4) + 3];
            const float r = rsqrtf(tot * (1.f / DM) + EPS);
            float* xr = out + O_Y + m * DM + c;
            *(f32x4*)xr = v0 * r * w0; *(f32x4*)(xr + 4) = v1 * r * w1;
            LDS_BARRIER();
        }
    }
#undef IN
#undef SEAM
}
#undef x_prompt
#undef x_sample
#undef state_ssm
#undef state_ssdc
#undef state_cfc
#undef state_ffc
#undef norm_mix_w
#undef w_in
#undef ssd_conv_w
#undef ssd_conv_b
#undef dt_bias
#undef a_log
#undef d_skip
#undef ssd_norm_w
#undef cf_conv_w
#undef cf_conv_b
#undef cf_ln_w
#undef cf_ln_b
#undef w_out
#undef norm_ffn_w
#undef w_up
#undef ffn_conv_w
#undef ffn_conv_b
#undef w_down
#undef norm_final_w
#undef out
#undef ws
#undef WinT
#undef WoutT
#undef WupT
#undef WdnT
#undef XN
#undef DT
#undef PROJ
#undef XBC
#undef U
#undef CONVOUT
#undef MIX
#undef ACT
#undef PART


extern "C" void kernel_launch(void* const* d_in, const int* in_sizes, int n_in, void* d_out, int out_size, void* d_ws, size_t ws_size, hipStream_t stream) {
    static int grid = 0;
    if (grid == 0) {
        if (n_in != 25 || (size_t)out_size != O_END || ws_size < WS_END) {
            fprintf(stderr, "kernel_launch: shape mismatch: n_in %d out %d (want %zu) ws %zu (need %zu)\n", n_in, out_size, (size_t)O_END, ws_size, (size_t)WS_END); grid = -1; return; }
        int dev = 0, cus = 0, per_cu = 0;
        hipGetDevice(&dev);
        hipDeviceGetAttribute(&cus, hipDeviceAttributeMultiprocessorCount, dev);
        if (hipFuncSetAttribute((const void*)mk_fwd, hipFuncAttributeMaxDynamicSharedMemorySize, LDS_BYTES) != hipSuccess) { fprintf(stderr, "kernel_launch: hipFuncSetAttribute failed\n"); grid = -1; return; }
        if (hipOccupancyMaxActiveBlocksPerMultiprocessor(&per_cu, (const void*)mk_fwd, 512, LDS_BYTES) != hipSuccess || per_cu < 1) { fprintf(stderr, "kernel_launch: occupancy query %d\n", per_cu); per_cu = 1; }
        (void)hipGetLastError();
        grid = cus * per_cu;
    }
    if (grid < 0) return;
    Args a{};
    for (int i = 0; i < 25; ++i) a.in[i] = (const float*)d_in[i];
    a.out_p = (float*)d_out; a.ws_p = (unsigned char*)d_ws;
#ifndef PROBE_SEL
#define PROBE_SEL 0
#endif
#ifndef PROBE_PHASE
#define PROBE_PHASE -1
#endif
    int ranges[3][2]; int nr = 0;
    if (PROBE_PHASE < 0) { ranges[0][0] = 0; ranges[0][1] = N_PHASES; nr = 1; }
    else { ranges[0][0] = 0; ranges[0][1] = PROBE_PHASE + 1; ranges[1][0] = PROBE_PHASE; ranges[1][1] = PROBE_PHASE + 1; nr = 2;
           if (PROBE_PHASE + 1 < N_PHASES) { ranges[2][0] = PROBE_PHASE + 1; ranges[2][1] = N_PHASES; nr = 3; } }
    if (hipMemsetAsync((char*)d_ws + WS_CTL, 0, CTL_BYTES, stream) != hipSuccess) { fprintf(stderr, "kernel_launch: memset failed\n"); return; }
    for (int i = 0; i < nr; ++i) {
        a.ph_lo = ranges[i][0]; a.ph_hi = ranges[i][1]; a.li = i | ((i == 1) ? (PROBE_SEL << 8) : 0);
        void* kargs[] = {&a};
        hipError_t e = hipLaunchCooperativeKernel((const void*)mk_fwd, dim3(grid), dim3(512), kargs, LDS_BYTES, stream);
        if (e != hipSuccess) fprintf(stderr, "kernel_launch: cooperative launch failed: %s (grid %d)\n", hipGetErrorString(e), grid);
    }
}
```
